# Optimizing an MI355X kernel written in HIP

```python
import math
import jax, jax.numpy as jnp
from jax import lax
import numpy as np

D_MODEL = 1024
BATCH = 8
SEQ = 4096
DEPTH = 2

HEAD_DIM = 64
N_META = 16
BLOCK_Q = 128
SB_HEADS = 4
SP_HEADS = 4
IDX_HEADS = 8
IDX_DIM = 32
TOPK_MAX = 256
DF_HEADS = 4
N_BUCKETS = 32
MAX_DISTANCE = 128
N_BIAS_HEADS = SP_HEADS + DF_HEADS
D_FF = 2816
CONV_WIDTH = 3
EPS = 1e-6
NEG_INF = -1e30

SB_W = SB_HEADS * HEAD_DIM
SP_W = SP_HEADS * HEAD_DIM
DF_W = DF_HEADS * 2 * HEAD_DIM
SPLITS = (SB_W, SB_W, SB_W,
          SP_W, SP_W, SP_W,
          IDX_HEADS * IDX_DIM, IDX_DIM, IDX_HEADS,
          DF_W, DF_W, DF_W,
          D_MODEL, D_MODEL, D_MODEL)
D_IN = sum(SPLITS)

kernel_name = 'hybrid_gated_sb_dsa_diff_convglu'


def _rmsnorm(a, gain):
    af = a.astype(jnp.float32)
    af = af * lax.rsqrt(jnp.mean(af * af, axis=-1, keepdims=True) + EPS)
    return (af * gain.astype(jnp.float32)).astype(a.dtype)


def _split_cols(z):
    out, off = [], 0
    for w in SPLITS:
        out.append(z[..., off:off + w])
        off += w
    return out


def _to_blocks(a):
    b, tp = a.shape[:2]
    return jnp.moveaxis(a.reshape((b, tp // BLOCK_Q, BLOCK_Q) + a.shape[2:]), 1, 0)


def _from_blocks(a):
    nb, b = a.shape[:2]
    return jnp.moveaxis(a, 0, 1).reshape((b, nb * BLOCK_Q) + a.shape[3:])


def _t5_bucket(rel):
    n = jnp.maximum(rel, 0)
    max_exact = N_BUCKETS // 2
    nf = jnp.maximum(n, 1).astype(jnp.float32)
    large = max_exact + (jnp.log(nf / max_exact) / math.log(MAX_DISTANCE / max_exact)
                         * (N_BUCKETS - max_exact)).astype(jnp.int32)
    return jnp.where(n < max_exact, n, jnp.minimum(large, N_BUCKETS - 1))


def _stick_breaking(q, k, v):
    tp, dh = q.shape[1], q.shape[-1]
    scale = dh ** -0.5
    kf, vf = k.astype(jnp.float32), v.astype(jnp.float32)
    key_pos = jnp.arange(tp)

    def block(args):
        qb, start = args
        qpos = start + jnp.arange(BLOCK_Q)
        z = jnp.einsum('bqhd,bkhd->bhqk', qb.astype(jnp.float32), kf) * scale
        mask = key_pos[None, :] < qpos[:, None]
        log_1m_beta = jnp.where(mask, jax.nn.log_sigmoid(-z), 0.0)
        between = lax.cumsum(log_1m_beta, axis=3, reverse=True) - log_1m_beta
        w = jnp.where(mask, jnp.exp(jax.nn.log_sigmoid(z) + between), 0.0)
        return jnp.einsum('bhqk,bkhd->bqhd', w, vf)

    nb = tp // BLOCK_Q
    out = lax.map(block, (_to_blocks(q), jnp.arange(nb) * BLOCK_Q))
    return _from_blocks(out).astype(v.dtype)


def _indexed_sparse_attention(q, k, v, q_ix, k_ix, w_ix, bias_table, top_k):
    tp, h, dh = q.shape[1], q.shape[2], q.shape[3]
    scale = dh ** -0.5
    k_ixf = k_ix.astype(jnp.float32)
    key_pos = jnp.arange(tp)
    table = bias_table.astype(jnp.float32)

    def block(args):
        qb, qib, wb, start = args
        qpos = start + jnp.arange(BLOCK_Q)
        dots = jnp.einsum('bqjd,bkd->bqjk', qib.astype(jnp.float32), k_ixf)
        score = jnp.einsum('bqj,bqjk->bqk', wb.astype(jnp.float32), jax.nn.relu(dots))
        score = jnp.where((key_pos[None, :] <= qpos[:, None])[None], score, NEG_INF)
        _, sel = lax.top_k(score, top_k)
        rel = qpos[None, :, None] - sel
        valid = rel >= 0
        k_sel = jax.vmap(lambda kk, ii: kk[ii])(k, sel)
        v_sel = jax.vmap(lambda vv, ii: vv[ii])(v, sel)
        s = jnp.einsum('bqhd,bqkhd->bhqk', qb.astype(jnp.float32),
                       k_sel.astype(jnp.float32)) * scale
        s = s + jnp.moveaxis(table[_t5_bucket(rel)], -1, 1)
        s = jnp.where(valid[:, None], s, NEG_INF)
        p = jax.nn.softmax(s, axis=-1)
        return jnp.einsum('bhqk,bqkhd->bqhd', p, v_sel.astype(jnp.float32))

    nb = tp // BLOCK_Q
    out = lax.map(block, (_to_blocks(q), _to_blocks(q_ix), _to_blocks(w_ix),
                          jnp.arange(nb) * BLOCK_Q))
    return _from_blocks(out).astype(v.dtype)


def _differential_attention(q1, q2, k1, k2, v, lam, bias_table):
    tp, dh = q1.shape[1], q1.shape[-1]
    scale = dh ** -0.5
    k1f, k2f, vf = k1.astype(jnp.float32), k2.astype(jnp.float32), v.astype(jnp.float32)
    key_pos = jnp.arange(tp)
    table = bias_table.astype(jnp.float32)

    def block(args):
        q1b, q2b, start = args
        qpos = start + jnp.arange(BLOCK_Q)
        mask = key_pos[None, :] <= qpos[:, None]
        bias = jnp.moveaxis(table[_t5_bucket(qpos[:, None] - key_pos[None, :])], -1, 0)

        def attn_map(qb, kf):
            s = jnp.einsum('bqhd,bkhd->bhqk', qb.astype(jnp.float32), kf) * scale + bias
            return jax.nn.softmax(jnp.where(mask, s, NEG_INF), axis=-1)

        p = attn_map(q1b, k1f) - lam * attn_map(q2b, k2f)
        return jnp.einsum('bhqk,bkhd->bqhd', p, vf)

    nb = tp // BLOCK_Q
    out = lax.map(block, (_to_blocks(q1), _to_blocks(q2), jnp.arange(nb) * BLOCK_Q))
    return _from_blocks(out).astype(v.dtype)


def _mixer(u, layer, w_in, b_gate, q_norm_sp, k_norm_sp, q_norm_df, k_norm_df,
           lam_q1, lam_k1, lam_q2, lam_k2, subln_df, w_br_sb, w_br_sp, w_br_df, w_out,
           rel_bias, top_k):
    b, tp, _ = u.shape
    (q_sb, k_sb, v_sb, q_sp, k_sp, v_sp, q_ix, k_ix, w_ix,
     q_df, k_df, v_df, g_sb, g_sp, g_df) = _split_cols(u @ w_in)

    def hd(a, n):
        return a.reshape(b, tp, n, -1)

    y_sb = _stick_breaking(hd(q_sb, SB_HEADS), hd(k_sb, SB_HEADS), hd(v_sb, SB_HEADS))
    y_sp = _indexed_sparse_attention(_rmsnorm(hd(q_sp, SP_HEADS), q_norm_sp),
                                     _rmsnorm(hd(k_sp, SP_HEADS), k_norm_sp),
                                     hd(v_sp, SP_HEADS), hd(q_ix, IDX_HEADS), k_ix, w_ix,
                                     rel_bias[:, :SP_HEADS], top_k)
    q_df = _rmsnorm(q_df.reshape(b, tp, DF_HEADS, 2, HEAD_DIM), q_norm_df)
    k_df = _rmsnorm(k_df.reshape(b, tp, DF_HEADS, 2, HEAD_DIM), k_norm_df)
    lam_init = 0.8 - 0.6 * math.exp(-0.3 * layer)
    lam = (jnp.exp(jnp.sum(lam_q1.astype(jnp.float32) * lam_k1.astype(jnp.float32)))
           - jnp.exp(jnp.sum(lam_q2.astype(jnp.float32) * lam_k2.astype(jnp.float32)))
           + lam_init)
    y_df = _differential_attention(q_df[..., 0, :], q_df[..., 1, :], k_df[..., 0, :],
                                   k_df[..., 1, :], hd(v_df, DF_HEADS), lam,
                                   rel_bias[:, SP_HEADS:])
    y_df = _rmsnorm(y_df, subln_df) * (1.0 - lam_init)

    merged = (jax.nn.sigmoid(g_sb + b_gate[:D_MODEL]) * (y_sb.reshape(b, tp, -1) @ w_br_sb)
              + jax.nn.sigmoid(g_sp + b_gate[D_MODEL:2 * D_MODEL]) * (y_sp.reshape(b, tp, -1) @ w_br_sp)
              + jax.nn.sigmoid(g_df + b_gate[2 * D_MODEL:]) * (y_df.reshape(b, tp, -1) @ w_br_df))
    return merged @ w_out


def _conv_ffn(u, w_up, conv_w, conv_b, w_down):
    tp = u.shape[1]
    z = u @ w_up
    gate, val = z[..., :D_FF], z[..., D_FF:]
    gp = jnp.pad(gate, ((0, 0), (CONV_WIDTH - 1, 0), (0, 0)))
    conv = conv_b + sum(gp[:, i:i + tp] * conv_w[i] for i in range(CONV_WIDTH))
    return (jax.nn.silu(conv) * val) @ w_down


def setup_inputs(seed: int = 0) -> dict:
    key = jax.random.key(seed)
    ks = jax.random.split(key, 24)

    def n(k, shape, s):
        return jax.random.normal(k, shape, jnp.float32) * s

    return {
        'x': n(ks[0], (BATCH, SEQ, D_MODEL), 1.0),
        'meta_tokens': n(ks[1], (N_META, D_MODEL), 1.0),
        'rel_bias': n(ks[2], (N_BUCKETS, N_BIAS_HEADS), 0.5),
        'attn_norm': 1.0 + n(ks[3], (DEPTH, D_MODEL), 0.01),
        'w_in': n(ks[4], (DEPTH, D_MODEL, D_IN), D_MODEL ** -0.5),
        'b_gate': n(ks[5], (DEPTH, 3 * D_MODEL), 0.02),
        'q_norm_sp': 1.0 + n(ks[6], (DEPTH, HEAD_DIM), 0.01),
        'k_norm_sp': 1.0 + n(ks[7], (DEPTH, HEAD_DIM), 0.01),
        'q_norm_df': 1.0 + n(ks[8], (DEPTH, HEAD_DIM), 0.01),
        'k_norm_df': 1.0 + n(ks[9], (DEPTH, HEAD_DIM), 0.01),
        'lam_q1': n(ks[10], (DEPTH, HEAD_DIM), 0.1),
        'lam_k1': n(ks[11], (DEPTH, HEAD_DIM), 0.1),
        'lam_q2': n(ks[12], (DEPTH, HEAD_DIM), 0.1),
        'lam_k2': n(ks[13], (DEPTH, HEAD_DIM), 0.1),
        'subln_df': 1.0 + n(ks[14], (DEPTH, 2 * HEAD_DIM), 0.01),
        'w_br_sb': n(ks[15], (DEPTH, SB_W, D_MODEL), SB_W ** -0.5),
        'w_br_sp': n(ks[16], (DEPTH, SP_W, D_MODEL), SP_W ** -0.5),
        'w_br_df': n(ks[17], (DEPTH, DF_W, D_MODEL), DF_W ** -0.5),
        'w_out': n(ks[18], (DEPTH, D_MODEL, D_MODEL), D_MODEL ** -0.5),
        'ffn_norm': 1.0 + n(ks[19], (DEPTH, D_MODEL), 0.01),
        'w_up': n(ks[20], (DEPTH, D_MODEL, 2 * D_FF), D_MODEL ** -0.5),
        'conv_w': n(ks[21], (DEPTH, CONV_WIDTH, D_FF), CONV_WIDTH ** -0.5),
        'conv_b': n(ks[22], (DEPTH, D_FF), 0.02),
        'w_down': n(ks[23], (DEPTH, D_FF, D_MODEL), D_FF ** -0.5),
    }


def reference(x, meta_tokens, rel_bias, attn_norm, w_in, b_gate, q_norm_sp, k_norm_sp,
              q_norm_df, k_norm_df, lam_q1, lam_k1, lam_q2, lam_k2, subln_df, w_br_sb,
              w_br_sp, w_br_df, w_out, ffn_norm, w_up, conv_w, conv_b, w_down):
    b, s, d = x.shape
    t = N_META + s
    tp = -(-t // BLOCK_Q) * BLOCK_Q
    top_k = min(TOPK_MAX, t // 4)
    meta = jnp.broadcast_to(meta_tokens[None].astype(x.dtype), (b, N_META, d))
    h = jnp.concatenate([meta, x, jnp.zeros((b, tp - t, d), x.dtype)], axis=1)
    for l in range(DEPTH):
        h = h + _mixer(_rmsnorm(h, attn_norm[l]), l, w_in[l], b_gate[l], q_norm_sp[l],
                       k_norm_sp[l], q_norm_df[l], k_norm_df[l], lam_q1[l], lam_k1[l],
                       lam_q2[l], lam_k2[l], subln_df[l], w_br_sb[l], w_br_sp[l],
                       w_br_df[l], w_out[l], rel_bias, top_k)
        h = h + _conv_ffn(_rmsnorm(h, ffn_norm[l]), w_up[l], conv_w[l], conv_b[l], w_down[l])
    return h[:, N_META:t]
```

```cpp
#include <hip/hip_runtime.h>
#include <hip/hip_cooperative_groups.h>
#include <cstdio>
namespace cg = cooperative_groups;

#ifndef FUSED
#define FUSED 1
#endif

#define DI __device__ __forceinline__
typedef unsigned short u16;
typedef unsigned int u32;
using bf16x8 = __attribute__((ext_vector_type(8))) short;
using f32x4 = __attribute__((ext_vector_type(4))) float;
using f32x16 = __attribute__((ext_vector_type(16))) float;
using u32x4 = __attribute__((ext_vector_type(4))) unsigned;
using u32x2 = __attribute__((ext_vector_type(2))) unsigned;
typedef __bf16 bf2_t __attribute__((ext_vector_type(2)));
typedef float f2_t __attribute__((ext_vector_type(2)));

constexpr int NB = 8, SEQ = 4096, DM = 1024, TP = 4224, TREAL = 4112, NMETA = 16, R = NB * TP;
constexpr int DFF = 2816, DIN = 6440, MW = 132;
constexpr float EPS = 1e-6f;
constexpr float LOG2E = 1.4426950408889634f;
constexpr int HALF_BYTES = 75776;
constexpr int SMEM_BYTES = 2 * HALF_BYTES;
constexpr int LUT_OFF = 73728;
constexpr int SJOB_OFF = 75000;

constexpr int NWIN = 3584;
constexpr size_t OFF_WIN = 0, OFF_WG = OFF_WIN + (size_t)NWIN * 1024, OFF_BRSB = OFF_WG + (size_t)3072 * 1024, OFF_BRSP = OFF_BRSB + 262144,
                 OFF_BRDF = OFF_BRSP + 262144, OFF_OUT = OFF_BRDF + 524288, OFF_UP = OFF_OUT + 1048576, OFF_DOWN = OFF_UP + (size_t)5632 * 1024,
                 LAYER_W = OFF_DOWN + (size_t)1024 * 2816;

struct Params {
  const float *x, *meta, *rel_bias, *attn_norm, *w_in, *b_gate, *qn_sp, *kn_sp, *qn_df, *kn_df, *lq1, *lk1, *lq2, *lk2,
      *subln, *w_br_sb, *w_br_sp, *w_br_df, *w_out, *ffn_norm, *w_up, *conv_w, *conv_b, *w_down;
  float* out;
  u16* hb; float* rowss; float* side; u16* wts;
  u16 *qsb, *ksb, *qsp, *ksp, *qdf, *kdf, *vtsb, *vtsp, *vtdf, *qix, *kix; float* wix;
  u16 *ysb, *ysp, *ydf; u32* mask; u16* merged; u16* act; u32* ctr; u32* bar;
};

DI u32 pack2bf(float a, float b) {
  f2_t v = {a, b};
  bf2_t r = __builtin_convertvector(v, bf2_t);
  return __builtin_bit_cast(u32, r);
}
DI u16 f2bf(float a) { return (u16)(pack2bf(a, 0.f) & 0xffffu); }
DI float wave_sum(float v) {
#pragma unroll
  for (int o = 32; o; o >>= 1) v += __shfl_xor(v, o);
  return v;
}
DI f32x4 mfma16(bf16x8 a, bf16x8 b, f32x4 c) { return __builtin_amdgcn_mfma_f32_16x16x32_bf16(a, b, c, 0, 0, 0); }
DI f32x16 mfma32(bf16x8 a, bf16x8 b, f32x16 c) { return __builtin_amdgcn_mfma_f32_32x32x16_bf16(a, b, c, 0, 0, 0); }

DI int vblock() {
  int g = gridDim.x, b = blockIdx.x;
  if ((g & 7) == 0) return (b & 7) * (g >> 3) + (b >> 3);
  return b;
}

DI float* hrow_w(const Params& p, int gr) {
  int b = gr / TP, t = gr - b * TP;
  if (t >= NMETA && t < TREAL) return p.out + ((size_t)(b * SEQ + t - NMETA)) * DM;
  int s = t < NMETA ? t : t - TREAL + NMETA;
  return p.side + ((size_t)(b * 128 + s)) * DM;
}
DI const float* hrow_r(const Params& p, int layer, int gr) {
  int b = gr / TP, t = gr - b * TP;
  if (t >= NMETA && t < TREAL) {
    size_t o = ((size_t)(b * SEQ + t - NMETA)) * DM;
    return layer == 0 ? p.x + o : p.out + o;
  }
  int s = t < NMETA ? t : t - TREAL + NMETA;
  return p.side + ((size_t)(b * 128 + s)) * DM;
}

DI int wt_srccol(int kind, int n) {
  if (kind == 0) {
    if (n < 1536) return n;
    if (n < 3072) return 1832 + n - 1536;
    if (n < 3328) return 1536 + n - 3072;
    if (n < 3360) return 1792 + n - 3328;
    if (n < 3368) return 1824 + n - 3360;
    return -1;
  }
  if (kind == 1) return 3368 + n;
  if (kind == 6) {
    int j = n >> 8, w = n & 255, wn = w >> 7, ni = (w & 127) >> 4, c = w & 15;
    int ff = 128 * j + 64 * wn + 16 * (ni >> 1) + c;
    return (ni & 1) ? DFF + ff : ff;
  }
  return n;
}

DI void phase_prep(const Params& p, unsigned char* smem) {
  int tid_ = threadIdx.x; asm volatile("" : "+v"(tid_));
  const int tid = tid_, wave = tid >> 6, lane = tid & 63;
  for (int gr = blockIdx.x * 8 + wave; gr < R; gr += gridDim.x * 8) {
    int b = gr / TP, t = gr - b * TP;
    const float* src = nullptr;
    if (t < NMETA) src = p.meta + (size_t)t * DM;
    else if (t < TREAL) src = p.x + ((size_t)(b * SEQ + t - NMETA)) * DM;
    float4 v[4];
    float ss = 0.f;
#pragma unroll
    for (int i = 0; i < 4; ++i) {
      v[i] = src ? ((const float4*)src)[lane + 64 * i] : make_float4(0.f, 0.f, 0.f, 0.f);
      ss += v[i].x * v[i].x + v[i].y * v[i].y + v[i].z * v[i].z + v[i].w * v[i].w;
    }
    ss = wave_sum(ss);
#pragma unroll
    for (int i = 0; i < 4; ++i) {
      u32x2 pk = {pack2bf(v[i].x, v[i].y), pack2bf(v[i].z, v[i].w)};
      *(u32x2*)(p.hb + (size_t)gr * DM + (lane + 64 * i) * 4) = pk;
    }
    if (lane == 0) { p.rowss[gr] = ss; p.rowss[R + gr] = 0.f; p.rowss[2 * R + gr] = 0.f; p.rowss[3 * R + gr] = 0.f; }
    if (t < NMETA || t >= TREAL) {
      int s = t < NMETA ? t : t - TREAL + NMETA;
      float* d = p.side + ((size_t)(b * 128 + s)) * DM;
#pragma unroll
      for (int i = 0; i < 4; ++i) ((float4*)d)[lane + 64 * i] = v[i];
    }
  }
  if (blockIdx.x == 0 && tid < 64) p.ctr[tid] = 0;
  for (int i = blockIdx.x * 512 + tid; i < 2 * 256 * DM / 8; i += gridDim.x * 512) {
    const int hf = i / (256 * DM / 8), o = i - hf * (256 * DM / 8);
    u16* d = hf ? p.hb + (size_t)R * DM : p.hb - (size_t)256 * DM;
    *(u32x4*)(d + (size_t)o * 8) = u32x4{0u, 0u, 0u, 0u};
  }
  const int half = tid >> 8, t2 = tid & 255;
  float* tl = (float*)(smem + half * HALF_BYTES);
  constexpr int NK[8] = {NWIN, 3072, 1024, 1024, 1024, 1024, 5632, 1024};
  constexpr int KK[8] = {1024, 1024, 256, 256, 512, 1024, 1024, 2816};
  int total = 0;
  int cum[9];
  cum[0] = 0;
#pragma unroll
  for (int k = 0; k < 8; ++k) { total += (NK[k] / 64) * (KK[k] / 64); cum[k + 1] = total; }
  for (int jp = blockIdx.x; 2 * jp < 2 * total; jp += gridDim.x) {
    const int job = 2 * jp + half;
    const bool act = job < 2 * total;
    int layer = job >= total ? 1 : 0;
    int j = job - layer * total;
    int kind = 0;
#pragma unroll
    for (int k = 1; k < 8; ++k) if (j >= cum[k]) kind = k;
    int jj = j;
    int K = 1024, ld = 1024;
    const float* src = p.w_in; const float* gain = nullptr; u16* dst = p.wts + (size_t)layer * LAYER_W;
    switch (kind) {
      case 0: jj -= cum[0]; K = 1024; ld = DIN; src = p.w_in + (size_t)layer * DM * DIN; gain = p.attn_norm + layer * DM; dst += OFF_WIN; break;
      case 1: jj -= cum[1]; K = 1024; ld = DIN; src = p.w_in + (size_t)layer * DM * DIN; gain = p.attn_norm + layer * DM; dst += OFF_WG; break;
      case 2: jj -= cum[2]; K = 256; ld = 1024; src = p.w_br_sb + (size_t)layer * 256 * 1024; dst += OFF_BRSB; break;
      case 3: jj -= cum[3]; K = 256; ld = 1024; src = p.w_br_sp + (size_t)layer * 256 * 1024; dst += OFF_BRSP; break;
      case 4: jj -= cum[4]; K = 512; ld = 1024; src = p.w_br_df + (size_t)layer * 512 * 1024; dst += OFF_BRDF; break;
      case 5: jj -= cum[5]; K = 1024; ld = 1024; src = p.w_out + (size_t)layer * 1024 * 1024; dst += OFF_OUT; break;
      case 6: jj -= cum[6]; K = 1024; ld = 2 * DFF; src = p.w_up + (size_t)layer * DM * 2 * DFF; gain = p.ffn_norm + layer * DM; dst += OFF_UP; break;
      default: jj -= cum[7]; K = DFF; ld = 1024; src = p.w_down + (size_t)layer * DFF * 1024; dst += OFF_DOWN; break;
    }
    int nkt = K / 64;
    int n0 = (jj / nkt) * 64, k0 = (jj % nkt) * 64;
    if (act) {
      const int nn = t2 & 63, kq = t2 >> 6;
      const int col = wt_srccol(kind, n0 + nn);
      const float* sp = src + (size_t)(k0 + kq) * ld + (col >= 0 ? col : 0);
      float v[16];
#pragma unroll
      for (int i = 0; i < 16; ++i) v[i] = sp[(size_t)(4 * i) * ld];
#pragma unroll
      for (int i = 0; i < 16; ++i) {
        float x = col >= 0 ? v[i] : 0.f;
        if (gain) x *= gain[k0 + kq + 4 * i];
        tl[nn * 65 + kq + 4 * i] = x;
      }
    }
    __syncthreads();
    if (act) {
#pragma unroll
      for (int i = 0; i < 2; ++i) {
        int idx = t2 + 256 * i, nn = idx >> 3, c = idx & 7;
        const float* s = tl + nn * 65 + c * 8;
        u32x4 pk = {pack2bf(s[0], s[1]), pack2bf(s[2], s[3]), pack2bf(s[4], s[5]), pack2bf(s[6], s[7])};
        *(u32x4*)(dst + (size_t)(n0 + nn) * K + k0 + c * 8) = pk;
      }
    }
    __syncthreads();
  }
}

template <int MI, int NI>
DI void gemm_kloop(const u16* Au, int lda, const u16* Bu, int ldb, int K, f32x4 (&acc)[NI][MI], unsigned char* smem) {
  int tid_ = threadIdx.x; asm volatile("" : "+v"(tid_));
  const int tid = tid_, lane = tid & 63, wave = tid >> 6, wm = wave >> 1, wn = wave & 1;
  const int lr = tid >> 3, lc = tid & 7;
  const int voa = lr * lda + lc * 8, vob = lr * ldb + lc * 8;
  constexpr int NB2 = NI / 2;
  u32x4 ra[MI], rb[NB2];
  const int nk = K >> 6;
  const int fsw = (lane & 15) >> 1;
  const int fro0 = (lane & 15) * 128 + (((lane >> 4) ^ fsw) << 4);
  const int fro1 = (lane & 15) * 128 + ((((lane >> 4) + 4) ^ fsw) << 4);
  const int wof = lr * 128 + ((lc ^ ((lr >> 1) & 7)) << 4);
#define GLOAD(K0)                                                                                        \
  {                                                                                                      \
    _Pragma("unroll") for (int q = 0; q < MI; ++q) ra[q] = *(const u32x4*)((Au + (size_t)(q * 64) * lda + (K0)) + voa); \
    _Pragma("unroll") for (int q = 0; q < NB2; ++q) rb[q] = *(const u32x4*)((Bu + (size_t)(q * 64) * ldb + (K0)) + vob); \
  }
#define SWRITE(BUF)                                                                                      \
  {                                                                                                      \
    unsigned char* d_ = smem + (BUF) * 65536 + wof;                                                      \
    _Pragma("unroll") for (int q = 0; q < MI; ++q) *(u32x4*)(d_ + q * 8192) = ra[q];                     \
    _Pragma("unroll") for (int q = 0; q < NB2; ++q) *(u32x4*)(d_ + 32768 + q * 8192) = rb[q];            \
  }
  GLOAD(0);
  SWRITE(0);
  if (nk > 1) GLOAD(64);
  for (int kt = 0; kt < nk; ++kt) {
    __syncthreads();
    if (kt + 1 < nk) {
      SWRITE((kt + 1) & 1);
      if (kt + 2 < nk) GLOAD((kt + 2) << 6);
    }
    __builtin_amdgcn_sched_barrier(0);
    {
      const unsigned char* sa = smem + (kt & 1) * 65536;
      const unsigned char* sb = sa + 32768;
#pragma unroll
      for (int ks = 0; ks < 2; ++ks) {
        const int fo = ks ? fro1 : fro0;
        bf16x8 af[MI];
#pragma unroll
        for (int i = 0; i < MI; ++i) af[i] = *(const bf16x8*)(sa + (wm * 16 * MI + i * 16) * 128 + fo);
#pragma unroll
        for (int nh = 0; nh < NI; nh += 4) {
          bf16x8 wf[4];
#pragma unroll
          for (int i = 0; i < 4; ++i) wf[i] = *(const bf16x8*)(sb + (wn * 16 * NI + (nh + i) * 16) * 128 + fo);
#pragma unroll
          for (int ni = 0; ni < 4; ++ni)
#pragma unroll
            for (int mi = 0; mi < MI; ++mi) acc[nh + ni][mi] = mfma16(wf[ni], af[mi], acc[nh + ni][mi]);
        }
      }
    }
  }
  __syncthreads();
#undef GLOAD
#undef SWRITE
}

template <int MI, int NI>
DI void zero_acc(f32x4 (&acc)[NI][MI]) {
#pragma unroll
  for (int i = 0; i < NI; ++i)
#pragma unroll
    for (int j = 0; j < MI; ++j) acc[i][j] = f32x4{0.f, 0.f, 0.f, 0.f};
}

DI void phase_g1(const Params& p, int layer, unsigned char* smem) {
  int tid_ = threadIdx.x; asm volatile("" : "+v"(tid_));
  const int tid = tid_, lane = tid & 63, wave = tid >> 6, wm = wave >> 1, wn = wave & 1;
  const int lr = tid >> 3, lc = tid & 7, lm = lane & 15, lg = lane >> 4;
  const u16* W = p.wts + (size_t)layer * LAYER_W + OFF_WIN;
  const float* rowss = p.rowss + (size_t)(2 * layer) * R;
  constexpr int NT = 13, NTILES = 132 * NT;
  for (int it = vblock(); it < NTILES; it += gridDim.x) {
    const int g = it / (4 * NT), rem = it - g * (4 * NT), nt = rem >> 2, mt = g * 4 + (rem & 3);
    f32x4 acc[8][4];
    zero_acc<4, 8>(acc);
    gemm_kloop<4, 8>(p.hb + (size_t)(mt * 256) * DM, DM, W + (size_t)(nt * 256) * DM, DM, DM, acc, smem);
    int mrow[4];
#pragma unroll
    for (int mi = 0; mi < 4; ++mi) {
      mrow[mi] = mt * 256 + wm * 64 + mi * 16 + lm;
      float rs = rsqrtf(rowss[mrow[mi]] * (1.f / DM) + EPS);
#pragma unroll
      for (int ni = 0; ni < 8; ++ni) acc[ni][mi] *= rs;
    }
    int kind;
    u16* dst = nullptr; int ld = 256, col0 = 0, vrows = 256; const float* gn = nullptr;
    if (nt == 0) { kind = 0; dst = p.qsb; }
    else if (nt == 1) { kind = 0; dst = p.ksb; }
    else if (nt == 2) { kind = 2; dst = p.vtsb; vrows = 256; }
    else if (nt == 3) { kind = 1; dst = p.qsp; gn = p.qn_sp + layer * 64; }
    else if (nt == 4) { kind = 1; dst = p.ksp; gn = p.kn_sp + layer * 64; }
    else if (nt == 5) { kind = 2; dst = p.vtsp; vrows = 256; }
    else if (nt < 8) { kind = 1; dst = p.qdf; ld = 512; col0 = (nt - 6) * 256; gn = p.qn_df + layer * 64; }
    else if (nt < 10) { kind = 1; dst = p.kdf; ld = 512; col0 = (nt - 8) * 256; gn = p.kn_df + layer * 64; }
    else if (nt < 12) { kind = 2; dst = p.vtdf; col0 = (nt - 10) * 256; vrows = 512; }
    else { kind = 0; dst = p.qix; }
    if (kind == 1) {
#pragma unroll
      for (int mi = 0; mi < 4; ++mi)
#pragma unroll
        for (int hh = 0; hh < 2; ++hh) {
          float ss = 0.f;
#pragma unroll
          for (int n4 = 0; n4 < 4; ++n4)
#pragma unroll
            for (int r = 0; r < 4; ++r) ss += acc[hh * 4 + n4][mi][r] * acc[hh * 4 + n4][mi][r];
          ss += __shfl_xor(ss, 16);
          ss += __shfl_xor(ss, 32);
          float sc = rsqrtf(ss * (1.f / 64.f) + EPS);
#pragma unroll
          for (int n4 = 0; n4 < 4; ++n4)
#pragma unroll
            for (int r = 0; r < 4; ++r) acc[hh * 4 + n4][mi][r] *= sc * gn[n4 * 16 + lg * 4 + r];
        }
    }
    if (kind == 0 || kind == 1) {
#pragma unroll
      for (int mi = 0; mi < 4; ++mi)
#pragma unroll
        for (int ni = 0; ni < 8; ++ni) {
          u32x2 pk = {pack2bf(acc[ni][mi][0], acc[ni][mi][1]), pack2bf(acc[ni][mi][2], acc[ni][mi][3])};
          *(u32x2*)(dst + (size_t)mrow[mi] * ld + col0 + wn * 128 + ni * 16 + lg * 4) = pk;
        }
    } else if (kind == 2) {
#pragma unroll
      for (int mi = 0; mi < 4; ++mi) {
        int b = mrow[mi] / TP, t = mrow[mi] - b * TP;
#pragma unroll
        for (int ni = 0; ni < 8; ++ni)
#pragma unroll
          for (int r = 0; r < 4; ++r) {
            int row = col0 + wn * 128 + ni * 16 + lg * 4 + r;
            dst[((size_t)(b * vrows + row)) * TP + t] = f2bf(acc[ni][mi][r]);
          }
      }
    }
  }
  {
    const int v = vblock(), first = NTILES % gridDim.x, nfree = gridDim.x - first;
    if (v >= first) {
      for (int s = v - first; s < 132; s += nfree) {
        const int mt = s;
        f32x4 acc[4][4];
        zero_acc<4, 4>(acc);
        gemm_kloop<4, 4>(p.hb + (size_t)(mt * 256) * DM, DM, W + (size_t)(13 * 256) * DM, DM, DM, acc, smem);
        if (wn == 0) {
#pragma unroll
          for (int mi = 0; mi < 4; ++mi) {
            const int m = mt * 256 + wm * 64 + mi * 16 + lm;
            const float rs = rsqrtf(rowss[m] * (1.f / DM) + EPS);
#pragma unroll
            for (int ni = 0; ni < 2; ++ni) {
              u32x2 pk = {pack2bf(acc[ni][mi][0] * rs, acc[ni][mi][1] * rs), pack2bf(acc[ni][mi][2] * rs, acc[ni][mi][3] * rs)};
              *(u32x2*)(p.kix + (size_t)m * 32 + ni * 16 + lg * 4) = pk;
            }
            if (lg < 2) {
              float4 w4 = make_float4(acc[2][mi][0] * rs, acc[2][mi][1] * rs, acc[2][mi][2] * rs, acc[2][mi][3] * rs);
              *(float4*)(p.wix + (size_t)m * 8 + lg * 4) = w4;
            }
          }
        }
      }
    }
  }
}

template <int MI, int NI>
DI void resid_epilogue(const Params& p, int from_x, const f32x4 (&acc)[NI][MI], int row0, int n0, float* rowss_next, bool last, int lm, int lg) {
#pragma unroll
  for (int mi = 0; mi < MI; ++mi) {
    const int m = row0 + mi * 16 + lm;
    const float* hr = hrow_r(p, from_x ? 0 : 1, m);
    float* hw = hrow_w(p, m);
    float ss = 0.f;
#pragma unroll
    for (int ni = 0; ni < NI; ++ni) {
      const int n = n0 + ni * 16 + lg * 4;
      float4 h = *(const float4*)(hr + n);
      h.x += acc[ni][mi][0]; h.y += acc[ni][mi][1]; h.z += acc[ni][mi][2]; h.w += acc[ni][mi][3];
      *(float4*)(hw + n) = h;
      if (!last) {
        u32x2 pk = {pack2bf(h.x, h.y), pack2bf(h.z, h.w)};
        *(u32x2*)(p.hb + (size_t)m * DM + n) = pk;
        ss += h.x * h.x + h.y * h.y + h.z * h.z + h.w * h.w;
      }
    }
    if (!last) {
      ss += __shfl_xor(ss, 16);
      ss += __shfl_xor(ss, 32);
      if (lg == 0) atomicAdd(rowss_next + m, ss);
    }
  }
}

DI void phase_resid(const Params& p, int from_x, const u16* A, int K, const u16* W, float* rowss_next, bool last,
                    unsigned char* smem) {
  int tid_ = threadIdx.x; asm volatile("" : "+v"(tid_));
  const int tid = tid_, lane = tid & 63, wave = tid >> 6, wm = wave >> 1, wn = wave & 1;
  const int lm = lane & 15, lg = lane >> 4;
  constexpr int NT = 4, NTILES = 132 * NT;
  const int nfull = (NTILES / (int)gridDim.x) * (int)gridDim.x;
  for (int it = vblock(); it < nfull; it += gridDim.x) {
    const int g = it / (4 * NT), rem = it - g * (4 * NT), nt = rem >> 2, mt = g * 4 + (rem & 3);
    f32x4 acc[8][4];
    zero_acc<4, 8>(acc);
    gemm_kloop<4, 8>(A + (size_t)(mt * 256) * K, K, W + (size_t)(nt * 256) * K, K, K, acc, smem);
    resid_epilogue<4, 8>(p, from_x, acc, mt * 256 + wm * 64, nt * 256 + wn * 128, rowss_next, last, lm, lg);
  }
  for (int s = vblock(); s < 4 * (NTILES - nfull); s += gridDim.x) {
    const int it = nfull + (s >> 2), hm = s & 1, hn = (s >> 1) & 1;
    const int g = it / (4 * NT), rem = it - g * (4 * NT), nt = rem >> 2, mt = g * 4 + (rem & 3);
    f32x4 acc[4][2];
    zero_acc<2, 4>(acc);
    gemm_kloop<2, 4>(A + (size_t)(mt * 256 + hm * 128) * K, K, W + (size_t)(nt * 256 + hn * 128) * K, K, K, acc, smem);
    resid_epilogue<2, 4>(p, from_x, acc, mt * 256 + hm * 128 + wm * 32, nt * 256 + hn * 128 + wn * 64, rowss_next, last, lm, lg);
  }
}

template <int MI>
DI void merge_tile(const Params& p, int layer, int rowbase, int nt, unsigned char* smem) {
  int tid_ = threadIdx.x; asm volatile("" : "+v"(tid_));
  const int tid = tid_, lane = tid & 63, wave = tid >> 6, wm = wave >> 1, wn = wave & 1;
  const int lm = lane & 15, lg = lane >> 4;
  const u16* WL = p.wts + (size_t)layer * LAYER_W;
  const float* rowss = p.rowss + (size_t)(2 * layer) * R;
  const float* bg = p.b_gate + layer * 3 * DM;
  u32 mp[4][MI][2];
#pragma unroll
  for (int ni = 0; ni < 4; ++ni)
#pragma unroll
    for (int mi = 0; mi < MI; ++mi) { mp[ni][mi][0] = 0u; mp[ni][mi][1] = 0u; }
#pragma unroll 1
  for (int br = 0; br < 3; ++br) {
    const u16* Y = br == 0 ? p.ysb : (br == 1 ? p.ysp : p.ydf);
    const int Kb = br == 2 ? 512 : 256;
    const u16* Wb = WL + (br == 0 ? OFF_BRSB : (br == 1 ? OFF_BRSP : OFF_BRDF));
    f32x4 acc[4][MI];
    zero_acc<MI, 4>(acc);
    gemm_kloop<MI, 4>(Y + (size_t)rowbase * Kb, Kb, Wb + (size_t)(nt * 128) * Kb, Kb, Kb, acc, smem);
    u32 brp[4][MI][2];
#pragma unroll
    for (int ni = 0; ni < 4; ++ni)
#pragma unroll
      for (int mi = 0; mi < MI; ++mi) {
        brp[ni][mi][0] = pack2bf(acc[ni][mi][0], acc[ni][mi][1]);
        brp[ni][mi][1] = pack2bf(acc[ni][mi][2], acc[ni][mi][3]);
      }
    zero_acc<MI, 4>(acc);
    gemm_kloop<MI, 4>(p.hb + (size_t)rowbase * DM, DM, WL + OFF_WG + (size_t)(br * 1024 + nt * 128) * DM, DM, DM, acc, smem);
    int m0 = rowbase + wm * 16 * MI + lm, n0 = nt * 128 + wn * 64 + lg * 4;
    asm volatile("" : "+v"(m0), "+v"(n0));
#pragma unroll
    for (int mi = 0; mi < MI; ++mi) {
      const float rs = rsqrtf(rowss[m0 + mi * 16] * (1.f / DM) + EPS);
#pragma unroll
      for (int ni = 0; ni < 4; ++ni) {
        const float4 b4 = *(const float4*)(bg + br * DM + n0 + ni * 16);
        const float bb[4] = {b4.x, b4.y, b4.z, b4.w};
        float mv[4];
#pragma unroll
        for (int r = 0; r < 4; ++r) {
          const float gv = acc[ni][mi][r] * rs + bb[r];
          const float sg = 1.f / (1.f + __expf(-gv));
          const u32 w = brp[ni][mi][r >> 1], mw = mp[ni][mi][r >> 1];
          const float bv = __uint_as_float((r & 1) ? (w & 0xffff0000u) : (w << 16));
          const float mo = __uint_as_float((r & 1) ? (mw & 0xffff0000u) : (mw << 16));
          mv[r] = mo + sg * bv;
        }
        mp[ni][mi][0] = pack2bf(mv[0], mv[1]);
        mp[ni][mi][1] = pack2bf(mv[2], mv[3]);
      }
    }
  }
  int m0 = rowbase + wm * 16 * MI + lm, n0 = nt * 128 + wn * 64 + lg * 4;
  asm volatile("" : "+v"(m0), "+v"(n0));
#pragma unroll
  for (int mi = 0; mi < MI; ++mi)
#pragma unroll
    for (int ni = 0; ni < 4; ++ni) {
      u32x2 pk = {mp[ni][mi][0], mp[ni][mi][1]};
      *(u32x2*)(p.merged + (size_t)(m0 + mi * 16) * DM + n0 + ni * 16) = pk;
    }
}

DI void phase_merge(const Params& p, int layer, unsigned char* smem) {
  constexpr int NT = 8, NTILES = 132 * NT;
  const int nfull = (NTILES / (int)gridDim.x) * (int)gridDim.x;
  for (int it = vblock(); it < nfull; it += gridDim.x) {
    const int g = it / (4 * NT), rem = it - g * (4 * NT), nt = rem >> 2, mt = g * 4 + (rem & 3);
    merge_tile<4>(p, layer, mt * 256, nt, smem);
  }
  for (int s = vblock(); s < 2 * (NTILES - nfull); s += gridDim.x) {
    const int it = nfull + (s >> 1), hf = s & 1;
    const int g = it / (4 * NT), rem = it - g * (4 * NT), nt = rem >> 2, mt = g * 4 + (rem & 3);
    merge_tile<2>(p, layer, mt * 256 + hf * 128, nt, smem);
  }
}

DI void phase_ffnup(const Params& p, int layer, unsigned char* smem) {
  int tid_ = threadIdx.x; asm volatile("" : "+v"(tid_));
  const int tid = tid_, lane = tid & 63, wave = tid >> 6, wm = wave >> 1, wn = wave & 1;
  const int lr = tid >> 3, lc = tid & 7, lm = lane & 15, lg = lane >> 4;
  const u16* W = p.wts + (size_t)layer * LAYER_W + OFF_UP;
  const float* rowss = p.rowss + (size_t)(2 * layer + 1) * R;
  const float* cw = p.conv_w + layer * 3 * DFF;
  const float* cb = p.conv_b + layer * DFF;
  constexpr int NT = 22, MT = 136, NTILES = MT * NT;
  float* G = (float*)smem;
  for (int it = vblock(); it < NTILES; it += gridDim.x) {
    const int g = it / (4 * NT), rem = it - g * (4 * NT), nt = rem >> 2, mt = g * 4 + (rem & 3);
    const int b = mt / 17, ti = mt - b * 17, tbase = 254 * ti - 2;
    f32x4 acc[8][4];
    zero_acc<4, 8>(acc);
    gemm_kloop<4, 8>(p.hb + ((ptrdiff_t)(b * TP + tbase)) * DM, DM, W + (size_t)(nt * 256) * DM, DM, DM, acc, smem);
    int r0 = wm * 64 + lm, gc0 = 64 * wn + 4 * lg;
    asm volatile("" : "+v"(r0), "+v"(gc0));
    int tt[4];
#pragma unroll
    for (int mi = 0; mi < 4; ++mi) {
      const int r = r0 + mi * 16;
      tt[mi] = tbase + r;
      float rs = (tt[mi] >= 0 && tt[mi] < TP) ? rsqrtf(rowss[b * TP + tt[mi]] * (1.f / DM) + EPS) : 0.f;
#pragma unroll
      for (int ni = 0; ni < 8; ++ni) acc[ni][mi] *= rs;
#pragma unroll
      for (int n2 = 0; n2 < 4; ++n2) {
        float4 g4 = make_float4(acc[2 * n2][mi][0], acc[2 * n2][mi][1], acc[2 * n2][mi][2], acc[2 * n2][mi][3]);
        *(float4*)(G + r * 132 + gc0 + 16 * n2) = g4;
      }
    }
    __syncthreads();
#pragma unroll
    for (int n2 = 0; n2 < 4; ++n2) {
      const int gc = gc0 + 16 * n2;
      const int ff = 128 * nt + gc;
      const float4 w0 = *(const float4*)(cw + ff), w1 = *(const float4*)(cw + DFF + ff), w2 = *(const float4*)(cw + 2 * DFF + ff);
      const float4 c4 = *(const float4*)(cb + ff);
#pragma unroll
      for (int mi = 0; mi < 4; ++mi) {
        const int r = r0 + mi * 16;
        if (r >= 2 && tt[mi] < TP) {
          const float4 g1 = *(const float4*)(G + (r - 1) * 132 + gc);
          const float4 g2 = *(const float4*)(G + (r - 2) * 132 + gc);
          float cv[4];
          cv[0] = c4.x + w0.x * g2.x + w1.x * g1.x + w2.x * acc[2 * n2][mi][0];
          cv[1] = c4.y + w0.y * g2.y + w1.y * g1.y + w2.y * acc[2 * n2][mi][1];
          cv[2] = c4.z + w0.z * g2.z + w1.z * g1.z + w2.z * acc[2 * n2][mi][2];
          cv[3] = c4.w + w0.w * g2.w + w1.w * g1.w + w2.w * acc[2 * n2][mi][3];
          float a[4];
#pragma unroll
          for (int e = 0; e < 4; ++e) a[e] = cv[e] / (1.f + __expf(-cv[e])) * acc[2 * n2 + 1][mi][e];
          u32x2 pk = {pack2bf(a[0], a[1]), pack2bf(a[2], a[3])};
          *(u32x2*)(p.act + (size_t)(b * TP + tt[mi]) * DFF + ff) = pk;
        }
      }
    }
    __syncthreads();
  }
}

DI int swap23(int k) { return (k & ~12) | ((k & 4) << 1) | ((k & 8) >> 1); }

DI void build_lut(const Params& p, int bias_head, unsigned char* smem, int tid) {
  float* lut = (float*)(smem + LUT_OFF);
  const int d = tid;
  if (d <= 128) {
    int bucket;
    if (d < 16) bucket = d;
    else {
      float nf = (float)d;
      int large = 16 + (int)(logf(nf / 16.f) / 2.0794415416798357f * 16.f);
      bucket = large < 31 ? large : 31;
    }
    lut[d] = p.rel_bias[bucket * 8 + bias_head] * LOG2E;
  }
}

template <int NCH>
DI void ld_tile_g(u32x4 (&r)[NCH], const u16* base, size_t rstride, int k0, bool is_vt, int tid) {
#pragma unroll
  for (int i = 0; i < NCH; ++i) {
    int id = tid + 256 * i, row = id >> 3, c = id & 7;
    const u16* s = is_vt ? base + (size_t)row * rstride + k0 + c * 8 : base + (size_t)(k0 + row) * rstride + c * 8;
    r[i] = *(const u32x4*)s;
  }
}
template <int NCH>
DI void st_tile_s(const u32x4 (&r)[NCH], unsigned char* dst, bool permute, int tid) {
#pragma unroll
  for (int i = 0; i < NCH; ++i) {
    int id = tid + 256 * i, row = id >> 3, c = id & 7;
    int rr = permute ? swap23(row) : row;
    *(u32x4*)(dst + rr * 144 + c * 16) = r[i];
  }
}

DI bf16x8 pack8(const f32x16& v, int s2) {
  u32x4 pk;
  if (s2 == 0) pk = u32x4{pack2bf(v[0], v[1]), pack2bf(v[2], v[3]), pack2bf(v[4], v[5]), pack2bf(v[6], v[7])};
  else pk = u32x4{pack2bf(v[8], v[9]), pack2bf(v[10], v[11]), pack2bf(v[12], v[13]), pack2bf(v[14], v[15])};
  return __builtin_bit_cast(bf16x8, pk);
}
DI f32x16 zero16() {
  f32x16 z;
#pragma unroll
  for (int i = 0; i < 16; ++i) z[i] = 0.f;
  return z;
}

DI void diff_map(const unsigned char* sk, const bf16x8 (&qf)[4], const unsigned char* sv, const float* lut, bool far,
                 bool diag, int ks0, int tq, int h, int lq, f32x16 (&O)[4], float& m, float& l) {
  const float csc = 0.125f * LOG2E;
  f32x16 S = zero16();
#pragma unroll
  for (int s = 0; s < 4; ++s) {
    bf16x8 kf = *(const bf16x8*)(sk + lq * 144 + (16 * s + 8 * h) * 2);
    S = mfma32(kf, qf[s], S);
  }
  if (far) {
    const float cbias = lut[128];
    float mx = fmaxf(fmaxf(S[0], S[1]), S[2]);
#pragma unroll
    for (int i = 3; i < 15; i += 2) mx = fmaxf(fmaxf(mx, S[i]), S[i + 1]);
    mx = fmaxf(mx, S[15]);
    mx = fmaxf(mx, __shfl_xor(mx, 32));
    const float mn = fmaxf(m, mx * csc + cbias);
    if (__any(mn > m)) {
      const float a = __builtin_amdgcn_exp2f(m - mn);
      l *= a; m = mn;
#pragma unroll
      for (int d = 0; d < 4; ++d) O[d] *= a;
    }
    const float off = cbias - m;
#pragma unroll
    for (int i = 0; i < 16; ++i) { float pv = __builtin_amdgcn_exp2f(S[i] * csc + off); l += pv; S[i] = pv; }
  } else {
    float mx = -1e30f;
#pragma unroll
    for (int i = 0; i < 16; ++i) {
      const int key = ks0 + 16 * (i >> 3) + 8 * h + (i & 7);
      int d = tq - key;
      const bool msk = diag && d < 0;
      d = d < 0 ? 0 : (d > 128 ? 128 : d);
      float x = S[i] * csc + lut[d];
      if (msk) x = -1e30f;
      S[i] = x;
      mx = fmaxf(mx, x);
    }
    mx = fmaxf(mx, __shfl_xor(mx, 32));
    const float mn = fmaxf(m, mx);
    if (__any(mn > m)) {
      const float a = __builtin_amdgcn_exp2f(m - mn);
      l *= a; m = mn;
#pragma unroll
      for (int d = 0; d < 4; ++d) O[d] *= a;
    }
#pragma unroll
    for (int i = 0; i < 16; ++i) { float pv = __builtin_amdgcn_exp2f(S[i] - m); l += pv; S[i] = pv; }
  }
  const bf16x8 p0 = pack8(S, 0), p1 = pack8(S, 1);
#pragma unroll
  for (int d = 0; d < 4; ++d) {
    bf16x8 v0 = *(const bf16x8*)(sv + (d * 32 + lq) * 144 + 16 * h);
    bf16x8 v1 = *(const bf16x8*)(sv + (d * 32 + lq) * 144 + 32 + 16 * h);
    O[d] = mfma32(v0, p0, O[d]);
    O[d] = mfma32(v1, p1, O[d]);
  }
}

DI void diff_map_far2(const unsigned char* sk, const bf16x8 (&qf)[4], const unsigned char* sv, float cbias, int h, int lq,
                      f32x16 (&O)[4], float& m, float& l) {
  const float csc = 0.125f * LOG2E;
  f32x16 S0 = zero16(), S1 = zero16();
#pragma unroll
  for (int s = 0; s < 4; ++s) {
    bf16x8 k0 = *(const bf16x8*)(sk + lq * 144 + (16 * s + 8 * h) * 2);
    bf16x8 k1 = *(const bf16x8*)(sk + (32 + lq) * 144 + (16 * s + 8 * h) * 2);
    S0 = mfma32(k0, qf[s], S0);
    S1 = mfma32(k1, qf[s], S1);
  }
  float mx = fmaxf(fmaxf(S0[0], S0[1]), S0[2]);
#pragma unroll
  for (int i = 3; i < 15; i += 2) mx = fmaxf(fmaxf(mx, S0[i]), S0[i + 1]);
  mx = fmaxf(mx, S0[15]);
#pragma unroll
  for (int i = 0; i < 16; i += 2) mx = fmaxf(fmaxf(mx, S1[i]), S1[i + 1]);
  mx = fmaxf(mx, __shfl_xor(mx, 32));
  const float mn = fmaxf(m, mx * csc + cbias);
  if (__any(mn > m)) {
    const float a = __builtin_amdgcn_exp2f(m - mn);
    l *= a; m = mn;
#pragma unroll
    for (int d = 0; d < 4; ++d) O[d] *= a;
  }
  const float off = cbias - m;
  float la = 0.f, lb = 0.f;
#pragma unroll
  for (int i = 0; i < 16; ++i) {
    float pa = __builtin_amdgcn_exp2f(S0[i] * csc + off), pb = __builtin_amdgcn_exp2f(S1[i] * csc + off);
    la += pa; lb += pb; S0[i] = pa; S1[i] = pb;
  }
  l += la + lb;
  const bf16x8 p0 = pack8(S0, 0), p1 = pack8(S0, 1), p2 = pack8(S1, 0), p3 = pack8(S1, 1);
#pragma unroll
  for (int d = 0; d < 4; ++d) {
    const unsigned char* vr = sv + (d * 32 + lq) * 144 + 16 * h;
    bf16x8 v0 = *(const bf16x8*)(vr), v1 = *(const bf16x8*)(vr + 32), v2 = *(const bf16x8*)(vr + 64), v3 = *(const bf16x8*)(vr + 96);
    O[d] = mfma32(v0, p0, O[d]);
    O[d] = mfma32(v1, p1, O[d]);
    O[d] = mfma32(v2, p2, O[d]);
    O[d] = mfma32(v3, p3, O[d]);
  }
}

DI void diff_job8(const Params& p, int layer, int b, int head, int qb, unsigned char* smem) {
  int tid_ = threadIdx.x; asm volatile("" : "+v"(tid_));
  const int tid = tid_, lane = tid & 63, wave = tid >> 6, h = lane >> 5, lq = lane & 31;
  const int map = wave >> 2, qg = wave & 3;
  const int t0 = qb * 128, tw0 = t0 + 32 * qg, tq = tw0 + lq;
  const float* lut = (const float*)(smem + LUT_OFF);
  build_lut(p, 4 + head, smem, tid);
  bf16x8 qf[4];
  {
    const u16* qr = p.qdf + (size_t)(b * TP + tq) * 512 + head * 128 + 64 * map + 8 * h;
#pragma unroll
    for (int s = 0; s < 4; ++s) qf[s] = *(const bf16x8*)(qr + 16 * s);
  }
  f32x16 O[4];
#pragma unroll
  for (int i = 0; i < 4; ++i) O[i] = zero16();
  float m = -1e30f, l = 0.f;
  const u16* K1 = p.kdf + (size_t)b * TP * 512 + head * 128;
  const u16* VT = p.vtdf + (size_t)(b * 512 + head * 128) * TP;
  const int ntile = 2 * (qb + 1);
  const int krow = tid >> 3, kc = tid & 7, krs = swap23(krow);
  u32x4 rk1, rk2, rv[2];
  auto gl = [&](int k0) {
    const u16* s = K1 + (size_t)(k0 + krow) * 512 + kc * 8;
    rk1 = *(const u32x4*)s; rk2 = *(const u32x4*)(s + 64);
#pragma unroll
    for (int i = 0; i < 2; ++i) rv[i] = *(const u32x4*)(VT + (size_t)(krow + 64 * i) * TP + k0 + kc * 8);
  };
  auto sl = [&](unsigned char* d) {
    *(u32x4*)(d + krs * 144 + kc * 16) = rk1;
    *(u32x4*)(d + 9216 + krs * 144 + kc * 16) = rk2;
#pragma unroll
    for (int i = 0; i < 2; ++i) *(u32x4*)(d + 18432 + (krow + 64 * i) * 144 + kc * 16) = rv[i];
  };
  gl(0); sl(smem);
  if (ntile > 1) gl(64);
  __syncthreads();
  const float cbias = lut[128];
  for (int j = 0; j < ntile; ++j) {
    __syncthreads();
    if (j + 1 < ntile) { sl(smem + ((j + 1) & 1) * 36864); if (j + 2 < ntile) gl((j + 2) * 64); }
    __builtin_amdgcn_sched_barrier(0);
    const unsigned char* sb = smem + (j & 1) * 36864;
    const unsigned char* sk = sb + 9216 * map;
    const int k0 = j * 64;
    if (tw0 - (k0 + 63) >= 113) {
      diff_map_far2(sk, qf, sb + 18432, cbias, h, lq, O, m, l);
    } else {
#pragma unroll 1
      for (int sub = 0; sub < 2; ++sub) {
        const int ks0 = k0 + sub * 32;
        if (ks0 > tw0 + 31) break;
        const bool far = (tw0 - (ks0 + 31)) >= 113;
        const bool diag = (ks0 + 31) > tw0;
        diff_map(sk + sub * 32 * 144, qf, sb + 18432 + sub * 64, lut, far, diag, ks0, tq, h, lq, O, m, l);
      }
    }
  }
  __syncthreads();
  float lam;
  const float lam_init = 0.8f - 0.6f * expf(-0.3f * (float)layer);
  {
    float a = p.lq1[layer * 64 + lane] * p.lk1[layer * 64 + lane];
    float c = p.lq2[layer * 64 + lane] * p.lk2[layer * 64 + lane];
    a = wave_sum(a); c = wave_sum(c);
    lam = expf(a) - expf(c) + lam_init;
  }
  l += __shfl_xor(l, 32);
  const float il = (map ? lam : 1.f) / l;
  float* X = (float*)smem + (size_t)(qg * 32 + lq) * 132;
  if (map == 1) {
#pragma unroll
    for (int d = 0; d < 4; ++d)
#pragma unroll
      for (int g = 0; g < 4; ++g) {
        float4 v = make_float4(O[d][4 * g] * il, O[d][4 * g + 1] * il, O[d][4 * g + 2] * il, O[d][4 * g + 3] * il);
        *(float4*)(X + 32 * d + 8 * g + 4 * h) = v;
      }
  }
  __syncthreads();
  if (map == 0) {
    float ss = 0.f;
#pragma unroll
    for (int d = 0; d < 4; ++d)
#pragma unroll
      for (int g = 0; g < 4; ++g) {
        const float4 v = *(const float4*)(X + 32 * d + 8 * g + 4 * h);
        float y0 = O[d][4 * g] * il - v.x, y1 = O[d][4 * g + 1] * il - v.y, y2 = O[d][4 * g + 2] * il - v.z, y3 = O[d][4 * g + 3] * il - v.w;
        O[d][4 * g] = y0; O[d][4 * g + 1] = y1; O[d][4 * g + 2] = y2; O[d][4 * g + 3] = y3;
        ss += y0 * y0 + y1 * y1 + y2 * y2 + y3 * y3;
      }
    ss += __shfl_xor(ss, 32);
    const float sc = rsqrtf(ss * (1.f / 128.f) + EPS) * (1.f - lam_init);
    const float* sg = p.subln + layer * 128;
    u16* yr = p.ydf + (size_t)(b * TP + tq) * 512 + head * 128;
#pragma unroll
    for (int d = 0; d < 4; ++d)
#pragma unroll
      for (int g = 0; g < 4; ++g) {
        const int dv = 32 * d + 8 * g + 4 * h;
        const float4 g4 = *(const float4*)(sg + dv);
        u32x2 pk = {pack2bf(O[d][4 * g] * sc * g4.x, O[d][4 * g + 1] * sc * g4.y),
                    pack2bf(O[d][4 * g + 2] * sc * g4.z, O[d][4 * g + 3] * sc * g4.w)};
        *(u32x2*)(yr + dv) = pk;
      }
  }
  __syncthreads();
}

DI void sparse_job(const Params& p, int layer, int b, int head, int qb, unsigned char* smem) {
  int tid_ = threadIdx.x & 255; asm volatile("" : "+v"(tid_));
  const int tid = tid_, lane = tid & 63, wave = tid >> 6, h = lane >> 5, lq = lane & 31;
  const int t0 = qb * 128, tw0 = t0 + 32 * wave, tq = tw0 + lq;
  const float* lut = (const float*)(smem + LUT_OFF);
  build_lut(p, head, smem, tid);
  bf16x8 qf[4];
  {
    const u16* qr = p.qsp + (size_t)(b * TP + tq) * 256 + head * 64 + 8 * h;
#pragma unroll
    for (int s = 0; s < 4; ++s) qf[s] = *(const bf16x8*)(qr + 16 * s);
  }
  f32x16 O[2] = {zero16(), zero16()};
  float m = -1e30f, l = 0.f;
  const u16* Kp = p.ksp + (size_t)b * TP * 256 + head * 64;
  const u16* VT = p.vtsp + (size_t)(b * 256 + head * 64) * TP;
  const u32* mrow = p.mask + (size_t)(b * TP + tq) * MW;
  const int ntile = 2 * (qb + 1);
  const float csc = 0.125f * LOG2E;
  u32x4 rk[2], rv[2];
  ld_tile_g<2>(rk, Kp, 256, 0, false, tid); ld_tile_g<2>(rv, VT, TP, 0, true, tid);
  u32x2 mnext = *(const u32x2*)(mrow);
  st_tile_s<2>(rk, smem, true, tid); st_tile_s<2>(rv, smem + 9216, false, tid);
  if (ntile > 1) { ld_tile_g<2>(rk, Kp, 256, 64, false, tid); ld_tile_g<2>(rv, VT, TP, 64, true, tid); }
  for (int j = 0; j < ntile; ++j) {
    const bool more = j + 1 < ntile;
    const u32x2 mcur = mnext;
    __syncthreads();
    if (more) {
      unsigned char* d = smem + ((j + 1) & 1) * 18432; st_tile_s<2>(rk, d, true, tid); st_tile_s<2>(rv, d + 9216, false, tid);
      mnext = *(const u32x2*)(mrow + 2 * (j + 1));
      if (j + 2 < ntile) { const int k0 = (j + 2) * 64; ld_tile_g<2>(rk, Kp, 256, k0, false, tid); ld_tile_g<2>(rv, VT, TP, k0, true, tid); }
    }
    __builtin_amdgcn_sched_barrier(0);
    const unsigned char* sb = smem + (j & 1) * 18432;
#pragma unroll 1
    for (int sub = 0; sub < 2; ++sub) {
      const int ks0 = j * 64 + sub * 32;
      if (ks0 > tw0 + 31) break;
      const u32 mw = sub ? mcur[1] : mcur[0];
      if (!__any(mw != 0u)) continue;
      f32x16 S = zero16();
#pragma unroll
      for (int s = 0; s < 4; ++s) {
        bf16x8 k1 = *(const bf16x8*)(sb + (sub * 32 + lq) * 144 + (16 * s + 8 * h) * 2);
        S = mfma32(k1, qf[s], S);
      }
      const bool far = (tw0 - (ks0 + 31)) >= 113;
      const float cbias = lut[128];
      const u32 sel16 = ((mw >> (8 * h)) & 0xffu) | (((mw >> (16 + 8 * h)) & 0xffu) << 8);
      if (far) {
        float mx = -1e30f;
#pragma unroll
        for (int i = 0; i < 16; ++i) mx = fmaxf(mx, (sel16 & (1u << i)) ? S[i] : -1e30f);
        mx = fmaxf(mx, __shfl_xor(mx, 32));
        const float mn = mx > -1e29f ? fmaxf(m, mx * csc + cbias) : m;
        if (__any(mn > m)) {
          const float a = __builtin_amdgcn_exp2f(m - mn);
          l *= a; O[0] *= a; O[1] *= a;
          m = mn;
        }
        const float off = cbias - m;
#pragma unroll
        for (int i = 0; i < 16; ++i) {
          float pv = (sel16 & (1u << i)) ? __builtin_amdgcn_exp2f(S[i] * csc + off) : 0.f;
          l += pv;
          S[i] = pv;
        }
      } else {
        float mx = -1e30f;
#pragma unroll
        for (int i = 0; i < 16; ++i) {
          const int ko = 16 * (i >> 3) + 8 * h + (i & 7);
          int d = tq - (ks0 + ko); d = d < 0 ? 0 : (d > 128 ? 128 : d);
          float x = S[i] * csc + lut[d];
          if (!(sel16 & (1u << i))) x = -1e30f;
          S[i] = x;
          mx = fmaxf(mx, x);
        }
        mx = fmaxf(mx, __shfl_xor(mx, 32));
        const float mn = fmaxf(m, mx);
        if (__any(mn > m)) {
          const float a = __builtin_amdgcn_exp2f(m - mn);
          l *= a; O[0] *= a; O[1] *= a;
          m = mn;
        }
#pragma unroll
        for (int i = 0; i < 16; ++i) {
          float pv = S[i] > -1e29f ? __builtin_amdgcn_exp2f(S[i] - m) : 0.f;
          l += pv;
          S[i] = pv;
        }
      }
      bf16x8 pa0 = pack8(S, 0), pa1 = pack8(S, 1);
#pragma unroll
      for (int d = 0; d < 2; ++d) {
        bf16x8 v0 = *(const bf16x8*)(sb + 9216 + (d * 32 + lq) * 144 + (sub * 32 + 8 * h) * 2);
        bf16x8 v1 = *(const bf16x8*)(sb + 9216 + (d * 32 + lq) * 144 + (sub * 32 + 16 + 8 * h) * 2);
        O[d] = mfma32(v0, pa0, O[d]);
        O[d] = mfma32(v1, pa1, O[d]);
      }
    }
  }
  __syncthreads();
  l += __shfl_xor(l, 32);
  const float il = 1.f / l;
  u16* yr = p.ysp + (size_t)(b * TP + tq) * 256 + head * 64;
#pragma unroll
  for (int d = 0; d < 2; ++d)
#pragma unroll
    for (int g = 0; g < 4; ++g) {
      u32x2 pk = {pack2bf(O[d][4 * g] * il, O[d][4 * g + 1] * il), pack2bf(O[d][4 * g + 2] * il, O[d][4 * g + 3] * il)};
      *(u32x2*)(yr + 32 * d + 8 * g + 4 * h) = pk;
    }
  __syncthreads();
}

DI void sb_job(const Params& p, int b, int head, int qb, unsigned char* smem) {
  int tid_ = threadIdx.x & 255; asm volatile("" : "+v"(tid_));
  const int tid = tid_, lane = tid & 63, wave = tid >> 6, h = lane >> 5, lq = lane & 31;
  const int t0 = qb * 128, tw0 = t0 + 32 * wave, tq = tw0 + lq;
  bf16x8 qf[4];
  {
    const u16* qr = p.qsb + (size_t)(b * TP + tq) * 256 + head * 64 + 8 * h;
#pragma unroll
    for (int s = 0; s < 4; ++s) qf[s] = *(const bf16x8*)(qr + 16 * s);
  }
  f32x16 O[2] = {zero16(), zero16()};
  float carry = 0.f;
  const u16* Kp = p.ksb + (size_t)b * TP * 256 + head * 64;
  const u16* VT = p.vtsb + (size_t)(b * 256 + head * 64) * TP;
  const int ntile = 2 * (qb + 1);
  u32x4 rk[2], rv[2];
  ld_tile_g<2>(rk, Kp, 256, (ntile - 1) * 64, false, tid); ld_tile_g<2>(rv, VT, TP, (ntile - 1) * 64, true, tid);
  st_tile_s<2>(rk, smem, true, tid); st_tile_s<2>(rv, smem + 9216, false, tid);
  __syncthreads();
  for (int jj = 0; jj < ntile; ++jj) {
    const int j = ntile - 1 - jj;
    const bool more = jj + 1 < ntile;
    if (more) { const int k0 = (j - 1) * 64; ld_tile_g<2>(rk, Kp, 256, k0, false, tid); ld_tile_g<2>(rv, VT, TP, k0, true, tid); }
    __builtin_amdgcn_sched_barrier(0);
    const unsigned char* sb = smem + (jj & 1) * 18432;
    const bool wdone = !__any(carry >= -104.f);
    if (!wdone) {
#pragma unroll 1
      for (int sub = 1; sub >= 0; --sub) {
        const int ks0 = j * 64 + sub * 32;
        if (ks0 > tw0) continue;
        f32x16 S = zero16();
#pragma unroll
        for (int s = 0; s < 4; ++s) {
          bf16x8 k1 = *(const bf16x8*)(sb + (sub * 32 + lq) * 144 + (16 * s + 8 * h) * 2);
          S = mfma32(k1, qf[s], S);
        }
        const bool diag = (ks0 + 31) >= tw0;
        float lsm[16];
        float sA = 0.f, sB = 0.f;
#pragma unroll
        for (int i = 0; i < 16; ++i) {
          const int key = ks0 + 16 * (i >> 3) + 8 * h + (i & 7);
          const float z = S[i] * 0.125f;
          const float sp = fmaxf(z, 0.f) + __logf(1.f + __expf(-fabsf(z)));
          const bool valid = !diag || key < tq;
          lsm[i] = valid ? -sp : 0.f;
          S[i] = valid ? z - sp : -1e30f;
          if (i < 8) sA += lsm[i]; else sB += lsm[i];
        }
        const float oA = __shfl_xor(sA, 32), oB = __shfl_xor(sB, 32);
        const float aboveB = h == 0 ? oB : 0.f;
        const float aboveA = h == 0 ? (oA + sB + oB) : (oB + sB);
        float run = carry + aboveB;
#pragma unroll
        for (int i = 15; i >= 8; --i) { float lw = S[i] + run; run += lsm[i]; S[i] = lw > -1e29f ? __expf(lw) : 0.f; }
        run = carry + aboveA;
#pragma unroll
        for (int i = 7; i >= 0; --i) { float lw = S[i] + run; run += lsm[i]; S[i] = lw > -1e29f ? __expf(lw) : 0.f; }
        carry += sA + sB + oA + oB;
        bf16x8 pa0 = pack8(S, 0), pa1 = pack8(S, 1);
#pragma unroll
        for (int d = 0; d < 2; ++d) {
          bf16x8 v0 = *(const bf16x8*)(sb + 9216 + (d * 32 + lq) * 144 + (sub * 32 + 8 * h) * 2);
          bf16x8 v1 = *(const bf16x8*)(sb + 9216 + (d * 32 + lq) * 144 + (sub * 32 + 16 + 8 * h) * 2);
          O[d] = mfma32(v0, pa0, O[d]);
          O[d] = mfma32(v1, pa1, O[d]);
        }
      }
    }
    if (more) { unsigned char* d = smem + ((jj + 1) & 1) * 18432; st_tile_s<2>(rk, d, true, tid); st_tile_s<2>(rv, d + 9216, false, tid); }
    const int alldone = __syncthreads_and((int)(!__any(carry >= -104.f)));
    if (alldone) break;
  }
  u16* yr = p.ysb + (size_t)(b * TP + tq) * 256 + head * 64;
#pragma unroll
  for (int d = 0; d < 2; ++d)
#pragma unroll
    for (int g = 0; g < 4; ++g) {
      u32x2 pk = {pack2bf(O[d][4 * g], O[d][4 * g + 1]), pack2bf(O[d][4 * g + 2], O[d][4 * g + 3])};
      *(u32x2*)(yr + 32 * d + 8 * g + 4 * h) = pk;
    }
  __syncthreads();
}

DI void idx_scan(const u32* hq, int need, u32* outbin, u32* outneed, int q, int lane) {
  u32 c = 0;
#pragma unroll
  for (int w = 0; w < 8; ++w) { u32 v = hq[8 * lane + w]; c += (v & 0xffffu) + (v >> 16); }
  u32 incl = c;
#pragma unroll
  for (int o = 1; o < 64; o <<= 1) { u32 v = __shfl_down(incl, o); if (lane + o < 64) incl += v; }
  const u32 above = incl - c;
  if ((int)above < need && need <= (int)incl) {
    u32 cum = above;
    for (int bin = 16 * lane + 15; bin >= 16 * lane; --bin) {
      u32 cnt = (hq[bin >> 1] >> ((bin & 1) * 16)) & 0xffffu;
      if ((int)(cum + cnt) >= need) { outbin[q] = (u32)bin; outneed[q] = (u32)need - cum; break; }
      cum += cnt;
    }
  }
}

template <int PASS, bool DIAG>
DI void idx_tile(const bf16x8 kf, const bf16x8 (&qf)[8], const float (&wq)[8], int kt, int lm, int lg, int tq, bool selall, u32 bA, u32 pfx,
                 u32* hist, u32* maskw, u32* cand, u32* ccnt) {
  const f32x4 z4 = {0.f, 0.f, 0.f, 0.f};
  f32x4 sc = z4;
#pragma unroll
  for (int j = 0; j < 8; ++j) {
    f32x4 d = mfma16(kf, qf[j], z4);
#pragma unroll
    for (int r = 0; r < 4; ++r) sc[r] += wq[j] * fmaxf(d[r], 0.f);
  }
  u32 selbits = 0u;
#pragma unroll
  for (int r = 0; r < 4; ++r) {
    const int key = kt * 16 + lg * 4 + r;
    const bool valid = !DIAG || key <= tq;
    const u32 bits = __float_as_uint(sc[r]);
    const u32 u = bits ^ ((u32)((int)bits >> 31) | 0x80000000u);
    if (PASS == 0) {
      if (valid) { const u32 bin = u >> 22; atomicAdd(&hist[lm * 512 + (bin >> 1)], 1u << ((bin & 1) * 16)); }
    } else if (PASS == 1) {
      if (valid && (u >> 22) == bA) { const u32 bin = (u >> 12) & 1023u; atomicAdd(&hist[lm * 512 + (bin >> 1)], 1u << ((bin & 1) * 16)); }
    } else {
      const u32 pp = u >> 12;
      if (valid && (selall || pp > pfx)) selbits |= 1u << r;
      if (valid && !selall && pp == pfx) {
        const u32 ix = atomicAdd(&ccnt[lm], 1u);
        if (ix < 64u) { cand[(lm * 64 + ix) * 2] = u; cand[(lm * 64 + ix) * 2 + 1] = (u32)key; }
      }
    }
  }
  if (PASS == 2 && selbits) {
    const int kb = kt * 16 + lg * 4;
    atomicOr(&maskw[lm * MW + (kb >> 5)], selbits << (kb & 31));
  }
}
template <int PASS>
DI void idx_pass(const u16* kp, const bf16x8 (&qf)[8], const float (&wq)[8], int wave, int ntile, int lm, int lg, int tq, bool selall,
                 u32 bA, u32 pfx, u32* hist, u32* maskw, u32* cand, u32* ccnt) {
  auto ldk = [&](int t) { return *(const bf16x8*)(kp + (size_t)(t < ntile ? t : 0) * 512); };
  int kt = wave;
  bf16x8 ka = ldk(kt), kb = ldk(kt + 4);
  for (; kt + 4 < ntile - 1; kt += 8) {
    const bf16x8 kc = ldk(kt + 8), kd = ldk(kt + 12);
    idx_tile<PASS, false>(ka, qf, wq, kt, lm, lg, tq, selall, bA, pfx, hist, maskw, cand, ccnt);
    idx_tile<PASS, false>(kb, qf, wq, kt + 4, lm, lg, tq, selall, bA, pfx, hist, maskw, cand, ccnt);
    ka = kc; kb = kd;
  }
  if (kt < ntile - 1) { idx_tile<PASS, false>(ka, qf, wq, kt, lm, lg, tq, selall, bA, pfx, hist, maskw, cand, ccnt); kt += 4; ka = kb; }
  if (kt == ntile - 1) idx_tile<PASS, true>(ka, qf, wq, kt, lm, lg, tq, selall, bA, pfx, hist, maskw, cand, ccnt);
}

DI void idx_job(const Params& p, int b, int qg, unsigned char* smem) {
  int tid_ = threadIdx.x & 255; asm volatile("" : "+v"(tid_));
  const int tid = tid_, lane = tid & 63, wave = tid >> 6, lm = lane & 15, lg = lane >> 4;
  u32* hist = (u32*)smem;
  u32* maskw = (u32*)(smem + 32768);
  u32* cand = (u32*)(smem + 41216);
  u32* ccnt = (u32*)(smem + 49408);
  u32* binA = ccnt + 16; u32* needB = ccnt + 32; u32* binB = ccnt + 48; u32* needC = ccnt + 64;
  const int t0 = qg * 16, ntile = qg + 1, tq = t0 + lm;
  const bool selall = tq + 1 <= 256;
  bf16x8 qf[8];
  float wq[8];
  {
    const u16* qr = p.qix + (size_t)(b * TP + tq) * 256 + lg * 8;
    const float* wr = p.wix + (size_t)(b * TP + tq) * 8;
#pragma unroll
    for (int j = 0; j < 8; ++j) { qf[j] = *(const bf16x8*)(qr + j * 32); wq[j] = wr[j]; }
  }
  for (int i = tid; i < 8192 + 2112; i += 256) hist[i] = 0u;
  if (tid < 80) ccnt[tid] = 0u;
  __syncthreads();
  const u16* kbase = p.kix + (size_t)b * TP * 32;
  const f32x4 z4 = {0.f, 0.f, 0.f, 0.f};
  const u16* kp = kbase + (size_t)lm * 32 + lg * 8;
  idx_pass<0>(kp, qf, wq, wave, ntile, lm, lg, tq, selall, 0u, 0u, hist, maskw, cand, ccnt);
  __syncthreads();
  for (int qq = 0; qq < 4; ++qq) idx_scan(hist + (wave * 4 + qq) * 512, 256, binA, needB, wave * 4 + qq, lane);
  __syncthreads();
  for (int i = tid; i < 8192; i += 256) hist[i] = 0u;
  __syncthreads();
  idx_pass<1>(kp, qf, wq, wave, ntile, lm, lg, tq, selall, binA[lm], 0u, hist, maskw, cand, ccnt);
  __syncthreads();
  for (int qq = 0; qq < 4; ++qq) idx_scan(hist + (wave * 4 + qq) * 512, (int)needB[wave * 4 + qq], binB, needC, wave * 4 + qq, lane);
  __syncthreads();
  idx_pass<2>(kp, qf, wq, wave, ntile, lm, lg, tq, selall, binA[lm], (binA[lm] << 10) | binB[lm], hist, maskw, cand, ccnt);
  __syncthreads();
  {
    const int q = tid >> 4, i0 = tid & 15;
    u32 cnt = ccnt[q]; if (cnt > 64u) cnt = 64u;
    const u32 need = needC[q];
    for (u32 c = i0; c < cnt; c += 16) {
      const u32 u = cand[(q * 64 + c) * 2], key = cand[(q * 64 + c) * 2 + 1];
      u32 rank = 0;
      for (u32 e = 0; e < cnt; ++e) {
        const u32 u2 = cand[(q * 64 + e) * 2], k2 = cand[(q * 64 + e) * 2 + 1];
        rank += (u2 > u || (u2 == u && k2 < key)) ? 1u : 0u;
      }
      if (rank < need) atomicOr(&maskw[q * MW + (key >> 5)], 1u << (key & 31));
    }
  }
  __syncthreads();
  for (int i = tid; i < 16 * MW; i += 256) p.mask[(size_t)(b * TP + t0) * MW + i] = maskw[i];
  __syncthreads();
}

DI int next_job(u32* ctr, unsigned char* smem) {
  int* sj = (int*)(smem + SJOB_OFF);
  __syncthreads();
  if (threadIdx.x == 0) *sj = (int)atomicAdd(ctr, 1u);
  __syncthreads();
  return *sj;
}

DI void phase_attn(const Params& p, int layer, int phase, unsigned char* smem) {
  u32* ctr = p.ctr + phase;
  for (;;) {
    const int jp = next_job(ctr, smem);
    if (jp >= 2640) break;
    if (jp < 1056) { const int qb = 32 - jp / 32, r = jp & 31; diff_job8(p, layer, r >> 2, r & 3, qb, smem); continue; }
    int half = threadIdx.x >> 8; asm volatile("" : "+v"(half));
    unsigned char* sm = smem + half * HALF_BYTES;
    const int job = 2 * (jp - 1056) + half;
    if (job < 2112) { idx_job(p, job & 7, 263 - (job >> 3), sm); }
    else { const int i = job - 2112; const int qb = 32 - i / 32, r = i & 31; sb_job(p, r >> 2, r & 3, qb, sm); }
  }
}
DI void phase_sparse(const Params& p, int layer, int phase, unsigned char* smem) {
  u32* ctr = p.ctr + phase;
  for (;;) {
    const int jp = next_job(ctr, smem);
    if (jp >= 528) break;
    int half = threadIdx.x >> 8; asm volatile("" : "+v"(half));
    unsigned char* sm = smem + half * HALF_BYTES;
    const int job = 2 * jp + half;
    const int qb = 32 - job / 32, r = job & 31;
    sparse_job(p, layer, r >> 2, r & 3, qb, sm);
  }
}

DI void run_phase(const Params& p, int ph, unsigned char* smem, int rep = 0) {
  if (ph == 0) { phase_prep(p, smem); return; }
  const int layer = (ph - 1) / 7, s = (ph - 1) % 7;
  const u16* WL = p.wts + (size_t)layer * LAYER_W;
  switch (s) {
    case 0: phase_g1(p, layer, smem); break;
    case 1: phase_attn(p, layer, ph + 16 * rep, smem); break;
    case 2: phase_sparse(p, layer, ph + 16 * rep, smem); break;
    case 3: phase_merge(p, layer, smem); break;
    case 4: phase_resid(p, layer == 0 ? 1 : 0, p.merged, DM, WL + OFF_OUT, p.rowss + (size_t)(2 * layer + 1) * R, false, smem); break;
    case 5: phase_ffnup(p, layer, smem); break;
    default: phase_resid(p, 0, p.act, DFF, WL + OFF_DOWN, p.rowss + (size_t)(2 * layer + 2) * R, layer == 1, smem); break;
  }
}


#define XB_TMO      128
#define XB_XCNT(j)  (256  + 64 * (j))
#define XB_XSUB(j)  (1280 + 64 * (j))
#define XB_XGEN(j)  (2304 + 64 * (j))
#define XB_TOP      3328
#define XB_TOPGEN   3392
#define XCD_BAR_WORDS 3456
#define XB_SPIN_CAP (1u << 20)
#define LAS __attribute__((address_space(3)))
DI unsigned xb_ld(unsigned* p) { return __hip_atomic_load(p, __ATOMIC_RELAXED, __HIP_MEMORY_SCOPE_AGENT); }
DI unsigned xb_add(unsigned* p, unsigned v) { return __hip_atomic_fetch_add(p, v, __ATOMIC_RELAXED, __HIP_MEMORY_SCOPE_AGENT); }
DI unsigned xb_xcc_id() { return (unsigned)__builtin_amdgcn_s_getreg((3 << 11) | 20) & 0xFu; }
#define XB_SPIN(cond, bar) do { unsigned _sp = 0; while (cond) { __builtin_amdgcn_s_sleep(1); \
    if ((++_sp & 255u) == 0u) { if (xb_ld(&(bar)[XB_TMO])) break; if (_sp > XB_SPIN_CAP) { atomicAdd(&(bar)[XB_TMO], 1u); break; } } } } while (0)
struct XcdBarrier { unsigned* bar; unsigned x; volatile LAS unsigned* st; };
DI XcdBarrier xcd_barrier_post(unsigned* bar, volatile LAS unsigned* st) {
  XcdBarrier b; b.bar = bar; b.x = xb_xcc_id(); b.st = st;
  if (threadIdx.x == 0) (void)xb_add(&bar[XB_XCNT(b.x)], 1u);
  return b;
}
DI void xcd_barrier_complete(unsigned* bar, unsigned x, unsigned& nloc, unsigned& nx) {
  const unsigned G = gridDim.x * gridDim.y * gridDim.z;
  unsigned sum, cnt, mine, sp = 0u;
  for (;;) {
    sum = 0u; cnt = 0u; mine = 0u;
#pragma unroll
    for (unsigned j = 0; j < 16; ++j) { const unsigned c = xb_ld(&bar[XB_XCNT(j)]); sum += c; cnt += (c > 0u) ? 1u : 0u; mine = (j == x) ? c : mine; }
    if (sum == G) break;
    __builtin_amdgcn_s_sleep(1);
    if ((++sp & 255u) == 0u) { if (xb_ld(&bar[XB_TMO])) break; if (sp > XB_SPIN_CAP) { atomicAdd(&bar[XB_TMO], 1u); break; } }
  }
  nloc = mine > 0u ? mine : 1u; nx = cnt > 0u ? cnt : 1u;
}
DI void xcd_barrier(const XcdBarrier& b) {
  asm volatile("s_waitcnt vmcnt(0)" ::: "memory");
  __syncthreads();
  if (threadIdx.x == 0) {
    unsigned* bar = b.bar;
    __builtin_amdgcn_s_waitcnt(0);
    unsigned nloc = b.st[0], nx = b.st[1];
    if (nloc == 0u) { xcd_barrier_complete(bar, b.x, nloc, nx); b.st[0] = nloc; b.st[1] = nx; }
    const unsigned old = xb_add(&bar[XB_XSUB(b.x)], 1u);
    const unsigned gen = old / nloc;
    if (old + 1u == (gen + 1u) * nloc) {
      __builtin_amdgcn_fence(__ATOMIC_RELEASE, "agent");
      asm volatile("s_waitcnt vmcnt(0)" ::: "memory");
      const unsigned og = xb_add(&bar[XB_TOP], 1u);
      const unsigned tg = og / nx;
      if (og + 1u == (tg + 1u) * nx) xb_add(&bar[XB_TOPGEN], 1u);
      else XB_SPIN(xb_ld(&bar[XB_TOPGEN]) == tg, bar);
      __builtin_amdgcn_fence(__ATOMIC_ACQUIRE, "agent");
      xb_add(&bar[XB_XGEN(b.x)], 1u);
      asm volatile("s_waitcnt vmcnt(0)" ::: "memory");
    } else {
      XB_SPIN(xb_ld(&bar[XB_XGEN(b.x)]) == gen, bar);
      __builtin_amdgcn_fence(__ATOMIC_ACQUIRE, "agent");
      asm volatile("s_waitcnt vmcnt(0)" ::: "memory");
    }
  }
  __syncthreads();
}

constexpr int NPHASE = 15;

__global__ void __launch_bounds__(512) mega(Params p, int ph_lo, int ph_hi) {
  __shared__ __attribute__((aligned(16))) unsigned char smem[SMEM_BYTES];
  volatile LAS unsigned* xst = (volatile LAS unsigned*)(smem + (SMEM_BYTES - 16));
  if (threadIdx.x == 0) { xst[0] = 0u; xst[1] = 0u; }
  __syncthreads();
  const XcdBarrier xb = xcd_barrier_post(p.bar, xst);
  for (int ph = ph_lo; ph < ph_hi; ++ph) {
    run_phase(p, ph, smem);
#ifdef PROBE_MASK
    if (ph > 0 && ((PROBE_MASK >> ((ph - 1) % 7)) & 1)) { cg::this_grid().sync(); run_phase(p, ph, smem, 1); }
#endif
    if (ph + 1 < ph_hi) { if (ph_hi > 1000) cg::this_grid().sync(); else xcd_barrier(xb); }
  }
}

extern "C" void kernel_launch(void* const* d_in, const int* in_sizes, int n_in, void* d_out, int out_size, void* d_ws,
                              size_t ws_size, hipStream_t stream) {
  Params p{};
  const float* const* in = (const float* const*)d_in;
  p.x = in[0]; p.meta = in[1]; p.rel_bias = in[2]; p.attn_norm = in[3]; p.w_in = in[4]; p.b_gate = in[5];
  p.qn_sp = in[6]; p.kn_sp = in[7]; p.qn_df = in[8]; p.kn_df = in[9]; p.lq1 = in[10]; p.lk1 = in[11]; p.lq2 = in[12];
  p.lk2 = in[13]; p.subln = in[14]; p.w_br_sb = in[15]; p.w_br_sp = in[16]; p.w_br_df = in[17]; p.w_out = in[18];
  p.ffn_norm = in[19]; p.w_up = in[20]; p.conv_w = in[21]; p.conv_b = in[22]; p.w_down = in[23];
  p.out = (float*)d_out;
  unsigned char* w = (unsigned char*)d_ws;
  size_t off = 0;
  auto take = [&](size_t bytes) { unsigned char* r = w + off; off += (bytes + 255) & ~(size_t)255; return r; };
  p.ctr = (u32*)take(256);
  p.bar = (u32*)take((size_t)XCD_BAR_WORDS * 4);
  p.hb = (u16*)take((size_t)(R + 512) * DM * 2) + (size_t)256 * DM;
  p.rowss = (float*)take((size_t)4 * R * 4);
  p.side = (float*)take((size_t)NB * 128 * DM * 4);
  p.wts = (u16*)take((size_t)2 * LAYER_W * 2);
  p.mask = (u32*)take((size_t)R * MW * 4);
  unsigned char* region = w + off;
  p.qsb = (u16*)take((size_t)R * 256 * 2); p.ksb = (u16*)take((size_t)R * 256 * 2);
  p.qsp = (u16*)take((size_t)R * 256 * 2); p.ksp = (u16*)take((size_t)R * 256 * 2);
  p.qdf = (u16*)take((size_t)R * 512 * 2); p.kdf = (u16*)take((size_t)R * 512 * 2);
  p.vtsb = (u16*)take((size_t)R * 256 * 2); p.vtsp = (u16*)take((size_t)R * 256 * 2); p.vtdf = (u16*)take((size_t)R * 512 * 2);
  p.qix = (u16*)take((size_t)R * 256 * 2); p.kix = (u16*)take((size_t)R * 32 * 2); p.wix = (float*)take((size_t)R * 8 * 4);
  p.ysb = (u16*)take((size_t)R * 256 * 2); p.ysp = (u16*)take((size_t)R * 256 * 2); p.ydf = (u16*)take((size_t)R * 512 * 2);
  p.merged = (u16*)region;
  p.act = (u16*)region;
  if (off > ws_size) { fprintf(stderr, "workspace too small: need %zu have %zu\n", off, ws_size); return; }
#if FUSED
  static int grid_blocks = 0;
  if (!grid_blocks) {
    int dev = 0, cus = 0, per_cu = 0;
    hipGetDevice(&dev);
    hipDeviceGetAttribute(&cus, hipDeviceAttributeMultiprocessorCount, dev);
    hipOccupancyMaxActiveBlocksPerMultiprocessor(&per_cu, mega, 512, 0);
    if (per_cu > 1) per_cu = 1;
    grid_blocks = cus * per_cu;
  }
  int lo = 0, hi = NPHASE;
  (void)hipMemsetAsync(p.bar, 0, (size_t)XCD_BAR_WORDS * 4, stream);
  void* args[] = {&p, &lo, &hi};
  hipError_t e = hipLaunchCooperativeKernel((void*)mega, dim3(grid_blocks), dim3(512), args, 0, stream);
  if (e != hipSuccess) fprintf(stderr, "cooperative launch failed: %s (grid %d)\n", hipGetErrorString(e), grid_blocks);
#else
  for (int ph = 0; ph < NPHASE; ++ph) mega<<<256, 512, 0, stream>>>(p, ph, ph + 1);
#endif
}
```

```cpp
#include <hip/hip_runtime.h>
#include <hip/hip_cooperative_groups.h>
#include <cstdio>
namespace cg = cooperative_groups;

#ifndef FUSED
#define FUSED 1
#endif

#define DI __device__ __forceinline__
typedef unsigned short u16;
typedef unsigned int u32;
using bf16x8 = __attribute__((ext_vector_type(8))) short;
using f32x4 = __attribute__((ext_vector_type(4))) float;
using f32x16 = __attribute__((ext_vector_type(16))) float;
using u32x4 = __attribute__((ext_vector_type(4))) unsigned;
using u32x2 = __attribute__((ext_vector_type(2))) unsigned;
typedef __bf16 bf2_t __attribute__((ext_vector_type(2)));
typedef float f2_t __attribute__((ext_vector_type(2)));

constexpr int NB = 8, SEQ = 4096, DM = 1024, TP = 4224, TREAL = 4112, NMETA = 16, R = NB * TP;
constexpr int DFF = 2816, DIN = 6440, MW = 132;
constexpr float EPS = 1e-6f;
constexpr float LOG2E = 1.4426950408889634f;
constexpr int HALF_BYTES = 75776;
constexpr int SMEM_BYTES = 2 * HALF_BYTES;
constexpr int LUT_OFF = 73728;
constexpr int SJOB_OFF = 75000;

constexpr int NWIN = 3584;
constexpr size_t OFF_WIN = 0, OFF_WG = OFF_WIN + (size_t)NWIN * 1024, OFF_BRSB = OFF_WG + (size_t)3072 * 1024, OFF_BRSP = OFF_BRSB + 262144,
                 OFF_BRDF = OFF_BRSP + 262144, OFF_OUT = OFF_BRDF + 524288, OFF_UP = OFF_OUT + 1048576, OFF_DOWN = OFF_UP + (size_t)5632 * 1024,
                 LAYER_W = OFF_DOWN + (size_t)1024 * 2816;

struct Params {
  const float *x, *meta, *rel_bias, *attn_norm, *w_in, *b_gate, *qn_sp, *kn_sp, *qn_df, *kn_df, *lq1, *lk1, *lq2, *lk2,
      *subln, *w_br_sb, *w_br_sp, *w_br_df, *w_out, *ffn_norm, *w_up, *conv_w, *conv_b, *w_down;
  float* out;
  u16* hb; float* rowss; float* side; u16* wts;
  u16 *qsb, *ksb, *qsp, *ksp, *qdf, *kdf, *vtsb, *vtsp, *vtdf, *qix, *kix; float* wix;
  u16 *ysb, *ysp, *ydf; u32* mask; u16* merged; u16* act; u32* ctr; u32* bar;
};

DI u32 pack2bf(float a, float b) {
  f2_t v = {a, b};
  bf2_t r = __builtin_convertvector(v, bf2_t);
  return __builtin_bit_cast(u32, r);
}
DI u16 f2bf(float a) { return (u16)(pack2bf(a, 0.f) & 0xffffu); }
DI float wave_sum(float v) {
#pragma unroll
  for (int o = 32; o; o >>= 1) v += __shfl_xor(v, o);
  return v;
}
DI f32x4 mfma16(bf16x8 a, bf16x8 b, f32x4 c) { return __builtin_amdgcn_mfma_f32_16x16x32_bf16(a, b, c, 0, 0, 0); }
DI f32x16 mfma32(bf16x8 a, bf16x8 b, f32x16 c) { return __builtin_amdgcn_mfma_f32_32x32x16_bf16(a, b, c, 0, 0, 0); }

DI int vblock() {
  int g = gridDim.x, b = blockIdx.x;
  if ((g & 7) == 0) return (b & 7) * (g >> 3) + (b >> 3);
  return b;
}

DI float* hrow_w(const Params& p, int gr) {
  int b = gr / TP, t = gr - b * TP;
  if (t >= NMETA && t < TREAL) return p.out + ((size_t)(b * SEQ + t - NMETA)) * DM;
  int s = t < NMETA ? t : t - TREAL + NMETA;
  return p.side + ((size_t)(b * 128 + s)) * DM;
}
DI const float* hrow_r(const Params& p, int layer, int gr) {
  int b = gr / TP, t = gr - b * TP;
  if (t >= NMETA && t < TREAL) {
    size_t o = ((size_t)(b * SEQ + t - NMETA)) * DM;
    return layer == 0 ? p.x + o : p.out + o;
  }
  int s = t < NMETA ? t : t - TREAL + NMETA;
  return p.side + ((size_t)(b * 128 + s)) * DM;
}

DI int wt_srccol(int kind, int n) {
  if (kind == 0) {
    if (n < 1536) return n;
    if (n < 3072) return 1832 + n - 1536;
    if (n < 3328) return 1536 + n - 3072;
    if (n < 3360) return 1792 + n - 3328;
    if (n < 3368) return 1824 + n - 3360;
    return -1;
  }
  if (kind == 1) return 3368 + n;
  if (kind == 6) {
    int j = n >> 8, w = n & 255, wn = w >> 7, ni = (w & 127) >> 4, c = w & 15;
    int ff = 128 * j + 64 * wn + 16 * (ni >> 1) + c;
    return (ni & 1) ? DFF + ff : ff;
  }
  return n;
}

DI void phase_prep(const Params& p, unsigned char* smem) {
  int tid_ = threadIdx.x; asm volatile("" : "+v"(tid_));
  const int tid = tid_, wave = tid >> 6, lane = tid & 63;
  for (int gr = blockIdx.x * 8 + wave; gr < R; gr += gridDim.x * 8) {
    int b = gr / TP, t = gr - b * TP;
    const float* src = nullptr;
    if (t < NMETA) src = p.meta + (size_t)t * DM;
    else if (t < TREAL) src = p.x + ((size_t)(b * SEQ + t - NMETA)) * DM;
    float4 v[4];
    float ss = 0.f;
#pragma unroll
    for (int i = 0; i < 4; ++i) {
      v[i] = src ? ((const float4*)src)[lane + 64 * i] : make_float4(0.f, 0.f, 0.f, 0.f);
      ss += v[i].x * v[i].x + v[i].y * v[i].y + v[i].z * v[i].z + v[i].w * v[i].w;
    }
    ss = wave_sum(ss);
#pragma unroll
    for (int i = 0; i < 4; ++i) {
      u32x2 pk = {pack2bf(v[i].x, v[i].y), pack2bf(v[i].z, v[i].w)};
      *(u32x2*)(p.hb + (size_t)gr * DM + (lane + 64 * i) * 4) = pk;
    }
    if (lane == 0) { p.rowss[gr] = ss; p.rowss[R + gr] = 0.f; p.rowss[2 * R + gr] = 0.f; p.rowss[3 * R + gr] = 0.f; }
    if (t < NMETA || t >= TREAL) {
      int s = t < NMETA ? t : t - TREAL + NMETA;
      float* d = p.side + ((size_t)(b * 128 + s)) * DM;
#pragma unroll
      for (int i = 0; i < 4; ++i) ((float4*)d)[lane + 64 * i] = v[i];
    }
  }
  if (blockIdx.x == 0 && tid < 64) p.ctr[tid] = 0;
  for (int i = blockIdx.x * 512 + tid; i < 2 * 256 * DM / 8; i += gridDim.x * 512) {
    const int hf = i / (256 * DM / 8), o = i - hf * (256 * DM / 8);
    u16* d = hf ? p.hb + (size_t)R * DM : p.hb - (size_t)256 * DM;
    *(u32x4*)(d + (size_t)o * 8) = u32x4{0u, 0u, 0u, 0u};
  }
  const int half = tid >> 8, t2 = tid & 255;
  float* tl = (float*)(smem + half * HALF_BYTES);
  constexpr int NK[8] = {NWIN, 3072, 1024, 1024, 1024, 1024, 5632, 1024};
  constexpr int KK[8] = {1024, 1024, 256, 256, 512, 1024, 1024, 2816};
  int total = 0;
  int cum[9];
  cum[0] = 0;
#pragma unroll
  for (int k = 0; k < 8; ++k) { total += (NK[k] / 64) * (KK[k] / 64); cum[k + 1] = total; }
  for (int jp = blockIdx.x; 2 * jp < 2 * total; jp += gridDim.x) {
    const int job = 2 * jp + half;
    const bool act = job < 2 * total;
    int layer = job >= total ? 1 : 0;
    int j = job - layer * total;
    int kind = 0;
#pragma unroll
    for (int k = 1; k < 8; ++k) if (j >= cum[k]) kind = k;
    int jj = j;
    int K = 1024, ld = 1024;
    const float* src = p.w_in; const float* gain = nullptr; u16* dst = p.wts + (size_t)layer * LAYER_W;
    switch (kind) {
      case 0: jj -= cum[0]; K = 1024; ld = DIN; src = p.w_in + (size_t)layer * DM * DIN; gain = p.attn_norm + layer * DM; dst += OFF_WIN; break;
      case 1: jj -= cum[1]; K = 1024; ld = DIN; src = p.w_in + (size_t)layer * DM * DIN; gain = p.attn_norm + layer * DM; dst += OFF_WG; break;
      case 2: jj -= cum[2]; K = 256; ld = 1024; src = p.w_br_sb + (size_t)layer * 256 * 1024; dst += OFF_BRSB; break;
      case 3: jj -= cum[3]; K = 256; ld = 1024; src = p.w_br_sp + (size_t)layer * 256 * 1024; dst += OFF_BRSP; break;
      case 4: jj -= cum[4]; K = 512; ld = 1024; src = p.w_br_df + (size_t)layer * 512 * 1024; dst += OFF_BRDF; break;
      case 5: jj -= cum[5]; K = 1024; ld = 1024; src = p.w_out + (size_t)layer * 1024 * 1024; dst += OFF_OUT; break;
      case 6: jj -= cum[6]; K = 1024; ld = 2 * DFF; src = p.w_up + (size_t)layer * DM * 2 * DFF; gain = p.ffn_norm + layer * DM; dst += OFF_UP; break;
      default: jj -= cum[7]; K = DFF; ld = 1024; src = p.w_down + (size_t)layer * DFF * 1024; dst += OFF_DOWN; break;
    }
    int nkt = K / 64;
    int n0 = (jj / nkt) * 64, k0 = (jj % nkt) * 64;
    if (act) {
      const int nn = t2 & 63, kq = t2 >> 6;
      const int col = wt_srccol(kind, n0 + nn);
      const float* sp = src + (size_t)(k0 + kq) * ld + (col >= 0 ? col : 0);
      float v[16];
#pragma unroll
      for (int i = 0; i < 16; ++i) v[i] = sp[(size_t)(4 * i) * ld];
#pragma unroll
      for (int i = 0; i < 16; ++i) {
        float x = col >= 0 ? v[i] : 0.f;
        if (gain) x *= gain[k0 + kq + 4 * i];
        tl[nn * 65 + kq + 4 * i] = x;
      }
    }
    __syncthreads();
    if (act) {
#pragma unroll
      for (int i = 0; i < 2; ++i) {
        int idx = t2 + 256 * i, nn = idx >> 3, c = idx & 7;
        const float* s = tl + nn * 65 + c * 8;
        u32x4 pk = {pack2bf(s[0], s[1]), pack2bf(s[2], s[3]), pack2bf(s[4], s[5]), pack2bf(s[6], s[7])};
        *(u32x4*)(dst + (size_t)(n0 + nn) * K + k0 + c * 8) = pk;
      }
    }
    __syncthreads();
  }
}

template <int MI, int NI>
DI void gemm_kloop(const u16* Au, int lda, const u16* Bu, int ldb, int K, f32x4 (&acc)[NI][MI], unsigned char* smem) {
  int tid_ = threadIdx.x; asm volatile("" : "+v"(tid_));
  const int tid = tid_, lane = tid & 63, wave = tid >> 6, wm = wave >> 1, wn = wave & 1;
  const int lr = tid >> 3, lc = tid & 7;
  const int voa = lr * lda + lc * 8, vob = lr * ldb + lc * 8;
  constexpr int NB2 = NI / 2;
  u32x4 ra[MI], rb[NB2];
  const int nk = K >> 6;
  const int fsw = (lane & 15) >> 1;
  const int fro0 = (lane & 15) * 128 + (((lane >> 4) ^ fsw) << 4);
  const int fro1 = (lane & 15) * 128 + ((((lane >> 4) + 4) ^ fsw) << 4);
  const int wof = lr * 128 + ((lc ^ ((lr >> 1) & 7)) << 4);
#define GLOAD(K0)                                                                                        \
  {                                                                                                      \
    _Pragma("unroll") for (int q = 0; q < MI; ++q) ra[q] = *(const u32x4*)((Au + (size_t)(q * 64) * lda + (K0)) + voa); \
    _Pragma("unroll") for (int q = 0; q < NB2; ++q) rb[q] = *(const u32x4*)((Bu + (size_t)(q * 64) * ldb + (K0)) + vob); \
  }
#define SWRITE(BUF)                                                                                      \
  {                                                                                                      \
    unsigned char* d_ = smem + (BUF) * 65536 + wof;                                                      \
    _Pragma("unroll") for (int q = 0; q < MI; ++q) *(u32x4*)(d_ + q * 8192) = ra[q];                     \
    _Pragma("unroll") for (int q = 0; q < NB2; ++q) *(u32x4*)(d_ + 32768 + q * 8192) = rb[q];            \
  }
  GLOAD(0);
  SWRITE(0);
  if (nk > 1) GLOAD(64);
  for (int kt = 0; kt < nk; ++kt) {
    __syncthreads();
    if (kt + 1 < nk) {
      SWRITE((kt + 1) & 1);
      if (kt + 2 < nk) GLOAD((kt + 2) << 6);
    }
    {
      const unsigned char* sa = smem + (kt & 1) * 65536;
      const unsigned char* sb = sa + 32768;
#pragma unroll
      for (int ks = 0; ks < 2; ++ks) {
        const int fo = ks ? fro1 : fro0;
        bf16x8 af[MI];
#pragma unroll
        for (int i = 0; i < MI; ++i) af[i] = *(const bf16x8*)(sa + (wm * 16 * MI + i * 16) * 128 + fo);
#pragma unroll
        for (int nh = 0; nh < NI; nh += 4) {
          bf16x8 wf[4];
#pragma unroll
          for (int i = 0; i < 4; ++i) wf[i] = *(const bf16x8*)(sb + (wn * 16 * NI + (nh + i) * 16) * 128 + fo);
#pragma unroll
          for (int ni = 0; ni < 4; ++ni)
#pragma unroll
            for (int mi = 0; mi < MI; ++mi) acc[nh + ni][mi] = mfma16(wf[ni], af[mi], acc[nh + ni][mi]);
        }
      }
    }
  }
  __syncthreads();
#undef GLOAD
#undef SWRITE
}

template <int MI, int NI>
DI void zero_acc(f32x4 (&acc)[NI][MI]) {
#pragma unroll
  for (int i = 0; i < NI; ++i)
#pragma unroll
    for (int j = 0; j < MI; ++j) acc[i][j] = f32x4{0.f, 0.f, 0.f, 0.f};
}

DI void phase_g1(const Params& p, int layer, unsigned char* smem) {
  int tid_ = threadIdx.x; asm volatile("" : "+v"(tid_));
  const int tid = tid_, lane = tid & 63, wave = tid >> 6, wm = wave >> 1, wn = wave & 1;
  const int lr = tid >> 3, lc = tid & 7, lm = lane & 15, lg = lane >> 4;
  const u16* W = p.wts + (size_t)layer * LAYER_W + OFF_WIN;
  const float* rowss = p.rowss + (size_t)(2 * layer) * R;
  constexpr int NT = 13, NTILES = 132 * NT;
  for (int it = vblock(); it < NTILES; it += gridDim.x) {
    const int g = it / (4 * NT), rem = it - g * (4 * NT), nt = rem >> 2, mt = g * 4 + (rem & 3);
    f32x4 acc[8][4];
    zero_acc<4, 8>(acc);
    gemm_kloop<4, 8>(p.hb + (size_t)(mt * 256) * DM, DM, W + (size_t)(nt * 256) * DM, DM, DM, acc, smem);
    int mrow[4];
#pragma unroll
    for (int mi = 0; mi < 4; ++mi) {
      mrow[mi] = mt * 256 + wm * 64 + mi * 16 + lm;
      float rs = rsqrtf(rowss[mrow[mi]] * (1.f / DM) + EPS);
#pragma unroll
      for (int ni = 0; ni < 8; ++ni) acc[ni][mi] *= rs;
    }
    int kind;
    u16* dst = nullptr; int ld = 256, col0 = 0, vrows = 256; const float* gn = nullptr;
    if (nt == 0) { kind = 0; dst = p.qsb; }
    else if (nt == 1) { kind = 0; dst = p.ksb; }
    else if (nt == 2) { kind = 2; dst = p.vtsb; vrows = 256; }
    else if (nt == 3) { kind = 1; dst = p.qsp; gn = p.qn_sp + layer * 64; }
    else if (nt == 4) { kind = 1; dst = p.ksp; gn = p.kn_sp + layer * 64; }
    else if (nt == 5) { kind = 2; dst = p.vtsp; vrows = 256; }
    else if (nt < 8) { kind = 1; dst = p.qdf; ld = 512; col0 = (nt - 6) * 256; gn = p.qn_df + layer * 64; }
    else if (nt < 10) { kind = 1; dst = p.kdf; ld = 512; col0 = (nt - 8) * 256; gn = p.kn_df + layer * 64; }
    else if (nt < 12) { kind = 2; dst = p.vtdf; col0 = (nt - 10) * 256; vrows = 512; }
    else { kind = 0; dst = p.qix; }
    if (kind == 1) {
#pragma unroll
      for (int mi = 0; mi < 4; ++mi)
#pragma unroll
        for (int hh = 0; hh < 2; ++hh) {
          float ss = 0.f;
#pragma unroll
          for (int n4 = 0; n4 < 4; ++n4)
#pragma unroll
            for (int r = 0; r < 4; ++r) ss += acc[hh * 4 + n4][mi][r] * acc[hh * 4 + n4][mi][r];
          ss += __shfl_xor(ss, 16);
          ss += __shfl_xor(ss, 32);
          float sc = rsqrtf(ss * (1.f / 64.f) + EPS);
#pragma unroll
          for (int n4 = 0; n4 < 4; ++n4)
#pragma unroll
            for (int r = 0; r < 4; ++r) acc[hh * 4 + n4][mi][r] *= sc * gn[n4 * 16 + lg * 4 + r];
        }
    }
    if (kind == 0 || kind == 1) {
#pragma unroll
      for (int mi = 0; mi < 4; ++mi)
#pragma unroll
        for (int ni = 0; ni < 8; ++ni) {
          u32x2 pk = {pack2bf(acc[ni][mi][0], acc[ni][mi][1]), pack2bf(acc[ni][mi][2], acc[ni][mi][3])};
          *(u32x2*)(dst + (size_t)mrow[mi] * ld + col0 + wn * 128 + ni * 16 + lg * 4) = pk;
        }
    } else if (kind == 2) {
#pragma unroll
      for (int mi = 0; mi < 4; ++mi) {
        int b = mrow[mi] / TP, t = mrow[mi] - b * TP;
#pragma unroll
        for (int ni = 0; ni < 8; ++ni)
#pragma unroll
          for (int r = 0; r < 4; ++r) {
            int row = col0 + wn * 128 + ni * 16 + lg * 4 + r;
            dst[((size_t)(b * vrows + row)) * TP + t] = f2bf(acc[ni][mi][r]);
          }
      }
    }
  }
  {
    const int v = vblock(), first = NTILES % gridDim.x, nfree = gridDim.x - first;
    if (v >= first) {
      for (int s = v - first; s < 132; s += nfree) {
        const int mt = s;
        f32x4 acc[4][4];
        zero_acc<4, 4>(acc);
        gemm_kloop<4, 4>(p.hb + (size_t)(mt * 256) * DM, DM, W + (size_t)(13 * 256) * DM, DM, DM, acc, smem);
        if (wn == 0) {
#pragma unroll
          for (int mi = 0; mi < 4; ++mi) {
            const int m = mt * 256 + wm * 64 + mi * 16 + lm;
            const float rs = rsqrtf(rowss[m] * (1.f / DM) + EPS);
#pragma unroll
            for (int ni = 0; ni < 2; ++ni) {
              u32x2 pk = {pack2bf(acc[ni][mi][0] * rs, acc[ni][mi][1] * rs), pack2bf(acc[ni][mi][2] * rs, acc[ni][mi][3] * rs)};
              *(u32x2*)(p.kix + (size_t)m * 32 + ni * 16 + lg * 4) = pk;
            }
            if (lg < 2) {
              float4 w4 = make_float4(acc[2][mi][0] * rs, acc[2][mi][1] * rs, acc[2][mi][2] * rs, acc[2][mi][3] * rs);
              *(float4*)(p.wix + (size_t)m * 8 + lg * 4) = w4;
            }
          }
        }
      }
    }
  }
}

template <int MI, int NI>
DI void resid_epilogue(const Params& p, int from_x, const f32x4 (&acc)[NI][MI], int row0, int n0, float* rowss_next, bool last, int lm, int lg) {
#pragma unroll
  for (int mi = 0; mi < MI; ++mi) {
    const int m = row0 + mi * 16 + lm;
    const float* hr = hrow_r(p, from_x ? 0 : 1, m);
    float* hw = hrow_w(p, m);
    float ss = 0.f;
#pragma unroll
    for (int ni = 0; ni < NI; ++ni) {
      const int n = n0 + ni * 16 + lg * 4;
      float4 h = *(const float4*)(hr + n);
      h.x += acc[ni][mi][0]; h.y += acc[ni][mi][1]; h.z += acc[ni][mi][2]; h.w += acc[ni][mi][3];
      *(float4*)(hw + n) = h;
      if (!last) {
        u32x2 pk = {pack2bf(h.x, h.y), pack2bf(h.z, h.w)};
        *(u32x2*)(p.hb + (size_t)m * DM + n) = pk;
        ss += h.x * h.x + h.y * h.y + h.z * h.z + h.w * h.w;
      }
    }
    if (!last) {
      ss += __shfl_xor(ss, 16);
      ss += __shfl_xor(ss, 32);
      if (lg == 0) atomicAdd(rowss_next + m, ss);
    }
  }
}

DI void phase_resid(const Params& p, int from_x, const u16* A, int K, const u16* W, float* rowss_next, bool last,
                    unsigned char* smem) {
  int tid_ = threadIdx.x; asm volatile("" : "+v"(tid_));
  const int tid = tid_, lane = tid & 63, wave = tid >> 6, wm = wave >> 1, wn = wave & 1;
  const int lm = lane & 15, lg = lane >> 4;
  constexpr int NT = 4, NTILES = 132 * NT;
  const int nfull = (NTILES / (int)gridDim.x) * (int)gridDim.x;
  for (int it = vblock(); it < nfull; it += gridDim.x) {
    const int g = it / (4 * NT), rem = it - g * (4 * NT), nt = rem >> 2, mt = g * 4 + (rem & 3);
    f32x4 acc[8][4];
    zero_acc<4, 8>(acc);
    gemm_kloop<4, 8>(A + (size_t)(mt * 256) * K, K, W + (size_t)(nt * 256) * K, K, K, acc, smem);
    resid_epilogue<4, 8>(p, from_x, acc, mt * 256 + wm * 64, nt * 256 + wn * 128, rowss_next, last, lm, lg);
  }
  for (int s = vblock(); s < 4 * (NTILES - nfull); s += gridDim.x) {
    const int it = nfull + (s >> 2), hm = s & 1, hn = (s >> 1) & 1;
    const int g = it / (4 * NT), rem = it - g * (4 * NT), nt = rem >> 2, mt = g * 4 + (rem & 3);
    f32x4 acc[4][2];
    zero_acc<2, 4>(acc);
    gemm_kloop<2, 4>(A + (size_t)(mt * 256 + hm * 128) * K, K, W + (size_t)(nt * 256 + hn * 128) * K, K, K, acc, smem);
    resid_epilogue<2, 4>(p, from_x, acc, mt * 256 + hm * 128 + wm * 32, nt * 256 + hn * 128 + wn * 64, rowss_next, last, lm, lg);
  }
}

template <int MI>
DI void merge_tile(const Params& p, int layer, int rowbase, int nt, unsigned char* smem) {
  int tid_ = threadIdx.x; asm volatile("" : "+v"(tid_));
  const int tid = tid_, lane = tid & 63, wave = tid >> 6, wm = wave >> 1, wn = wave & 1;
  const int lm = lane & 15, lg = lane >> 4;
  const u16* WL = p.wts + (size_t)layer * LAYER_W;
  const float* rowss = p.rowss + (size_t)(2 * layer) * R;
  const float* bg = p.b_gate + layer * 3 * DM;
  u32 mp[4][MI][2];
#pragma unroll
  for (int ni = 0; ni < 4; ++ni)
#pragma unroll
    for (int mi = 0; mi < MI; ++mi) { mp[ni][mi][0] = 0u; mp[ni][mi][1] = 0u; }
#pragma unroll 1
  for (int br = 0; br < 3; ++br) {
    const u16* Y = br == 0 ? p.ysb : (br == 1 ? p.ysp : p.ydf);
    const int Kb = br == 2 ? 512 : 256;
    const u16* Wb = WL + (br == 0 ? OFF_BRSB : (br == 1 ? OFF_BRSP : OFF_BRDF));
    f32x4 acc[4][MI];
    zero_acc<MI, 4>(acc);
    gemm_kloop<MI, 4>(Y + (size_t)rowbase * Kb, Kb, Wb + (size_t)(nt * 128) * Kb, Kb, Kb, acc, smem);
    u32 brp[4][MI][2];
#pragma unroll
    for (int ni = 0; ni < 4; ++ni)
#pragma unroll
      for (int mi = 0; mi < MI; ++mi) {
        brp[ni][mi][0] = pack2bf(acc[ni][mi][0], acc[ni][mi][1]);
        brp[ni][mi][1] = pack2bf(acc[ni][mi][2], acc[ni][mi][3]);
      }
    zero_acc<MI, 4>(acc);
    gemm_kloop<MI, 4>(p.hb + (size_t)rowbase * DM, DM, WL + OFF_WG + (size_t)(br * 1024 + nt * 128) * DM, DM, DM, acc, smem);
    int m0 = rowbase + wm * 16 * MI + lm, n0 = nt * 128 + wn * 64 + lg * 4;
    asm volatile("" : "+v"(m0), "+v"(n0));
#pragma unroll
    for (int mi = 0; mi < MI; ++mi) {
      const float rs = rsqrtf(rowss[m0 + mi * 16] * (1.f / DM) + EPS);
#pragma unroll
      for (int ni = 0; ni < 4; ++ni) {
        const float4 b4 = *(const float4*)(bg + br * DM + n0 + ni * 16);
        const float bb[4] = {b4.x, b4.y, b4.z, b4.w};
        float mv[4];
#pragma unroll
        for (int r = 0; r < 4; ++r) {
          const float gv = acc[ni][mi][r] * rs + bb[r];
          const float sg = 1.f / (1.f + __expf(-gv));
          const u32 w = brp[ni][mi][r >> 1], mw = mp[ni][mi][r >> 1];
          const float bv = __uint_as_float((r & 1) ? (w & 0xffff0000u) : (w << 16));
          const float mo = __uint_as_float((r & 1) ? (mw & 0xffff0000u) : (mw << 16));
          mv[r] = mo + sg * bv;
        }
        mp[ni][mi][0] = pack2bf(mv[0], mv[1]);
        mp[ni][mi][1] = pack2bf(mv[2], mv[3]);
      }
    }
  }
  int m0 = rowbase + wm * 16 * MI + lm, n0 = nt * 128 + wn * 64 + lg * 4;
  asm volatile("" : "+v"(m0), "+v"(n0));
#pragma unroll
  for (int mi = 0; mi < MI; ++mi)
#pragma unroll
    for (int ni = 0; ni < 4; ++ni) {
      u32x2 pk = {mp[ni][mi][0], mp[ni][mi][1]};
      *(u32x2*)(p.merged + (size_t)(m0 + mi * 16) * DM + n0 + ni * 16) = pk;
    }
}

DI void phase_merge(const Params& p, int layer, unsigned char* smem) {
  constexpr int NT = 8, NTILES = 132 * NT;
  const int nfull = (NTILES / (int)gridDim.x) * (int)gridDim.x;
  for (int it = vblock(); it < nfull; it += gridDim.x) {
    const int g = it / (4 * NT), rem = it - g * (4 * NT), nt = rem >> 2, mt = g * 4 + (rem & 3);
    merge_tile<4>(p, layer, mt * 256, nt, smem);
  }
  for (int s = vblock(); s < 2 * (NTILES - nfull); s += gridDim.x) {
    const int it = nfull + (s >> 1), hf = s & 1;
    const int g = it / (4 * NT), rem = it - g * (4 * NT), nt = rem >> 2, mt = g * 4 + (rem & 3);
    merge_tile<2>(p, layer, mt * 256 + hf * 128, nt, smem);
  }
}

DI void phase_ffnup(const Params& p, int layer, unsigned char* smem) {
  int tid_ = threadIdx.x; asm volatile("" : "+v"(tid_));
  const int tid = tid_, lane = tid & 63, wave = tid >> 6, wm = wave >> 1, wn = wave & 1;
  const int lr = tid >> 3, lc = tid & 7, lm = lane & 15, lg = lane >> 4;
  const u16* W = p.wts + (size_t)layer * LAYER_W + OFF_UP;
  const float* rowss = p.rowss + (size_t)(2 * layer + 1) * R;
  const float* cw = p.conv_w + layer * 3 * DFF;
  const float* cb = p.conv_b + layer * DFF;
  constexpr int NT = 22, MT = 136, NTILES = MT * NT;
  float* G = (float*)smem;
  for (int it = vblock(); it < NTILES; it += gridDim.x) {
    const int g = it / (4 * NT), rem = it - g * (4 * NT), nt = rem >> 2, mt = g * 4 + (rem & 3);
    const int b = mt / 17, ti = mt - b * 17, tbase = 254 * ti - 2;
    f32x4 acc[8][4];
    zero_acc<4, 8>(acc);
    gemm_kloop<4, 8>(p.hb + ((ptrdiff_t)(b * TP + tbase)) * DM, DM, W + (size_t)(nt * 256) * DM, DM, DM, acc, smem);
    int r0 = wm * 64 + lm, gc0 = 64 * wn + 4 * lg;
    asm volatile("" : "+v"(r0), "+v"(gc0));
    int tt[4];
#pragma unroll
    for (int mi = 0; mi < 4; ++mi) {
      const int r = r0 + mi * 16;
      tt[mi] = tbase + r;
      float rs = (tt[mi] >= 0 && tt[mi] < TP) ? rsqrtf(rowss[b * TP + tt[mi]] * (1.f / DM) + EPS) : 0.f;
#pragma unroll
      for (int ni = 0; ni < 8; ++ni) acc[ni][mi] *= rs;
#pragma unroll
      for (int n2 = 0; n2 < 4; ++n2) {
        float4 g4 = make_float4(acc[2 * n2][mi][0], acc[2 * n2][mi][1], acc[2 * n2][mi][2], acc[2 * n2][mi][3]);
        *(float4*)(G + r * 132 + gc0 + 16 * n2) = g4;
      }
    }
    __syncthreads();
#pragma unroll
    for (int n2 = 0; n2 < 4; ++n2) {
      const int gc = gc0 + 16 * n2;
      const int ff = 128 * nt + gc;
      const float4 w0 = *(const float4*)(cw + ff), w1 = *(const float4*)(cw + DFF + ff), w2 = *(const float4*)(cw + 2 * DFF + ff);
      const float4 c4 = *(const float4*)(cb + ff);
#pragma unroll
      for (int mi = 0; mi < 4; ++mi) {
        const int r = r0 + mi * 16;
        if (r >= 2 && tt[mi] < TP) {
          const float4 g1 = *(const float4*)(G + (r - 1) * 132 + gc);
          const float4 g2 = *(const float4*)(G + (r - 2) * 132 + gc);
          float cv[4];
          cv[0] = c4.x + w0.x * g2.x + w1.x * g1.x + w2.x * acc[2 * n2][mi][0];
          cv[1] = c4.y + w0.y * g2.y + w1.y * g1.y + w2.y * acc[2 * n2][mi][1];
          cv[2] = c4.z + w0.z * g2.z + w1.z * g1.z + w2.z * acc[2 * n2][mi][2];
          cv[3] = c4.w + w0.w * g2.w + w1.w * g1.w + w2.w * acc[2 * n2][mi][3];
          float a[4];
#pragma unroll
          for (int e = 0; e < 4; ++e) a[e] = cv[e] / (1.f + __expf(-cv[e])) * acc[2 * n2 + 1][mi][e];
          u32x2 pk = {pack2bf(a[0], a[1]), pack2bf(a[2], a[3])};
          *(u32x2*)(p.act + (size_t)(b * TP + tt[mi]) * DFF + ff) = pk;
        }
      }
    }
    __syncthreads();
  }
}

DI int swap23(int k) { return (k & ~12) | ((k & 4) << 1) | ((k & 8) >> 1); }

DI void build_lut(const Params& p, int bias_head, unsigned char* smem, int tid) {
  float* lut = (float*)(smem + LUT_OFF);
  const int d = tid;
  if (d <= 128) {
    int bucket;
    if (d < 16) bucket = d;
    else {
      float nf = (float)d;
      int large = 16 + (int)(logf(nf / 16.f) / 2.0794415416798357f * 16.f);
      bucket = large < 31 ? large : 31;
    }
    lut[d] = p.rel_bias[bucket * 8 + bias_head] * LOG2E;
  }
}

template <int NCH>
DI void ld_tile_g(u32x4 (&r)[NCH], const u16* base, size_t rstride, int k0, bool is_vt, int tid) {
#pragma unroll
  for (int i = 0; i < NCH; ++i) {
    int id = tid + 256 * i, row = id >> 3, c = id & 7;
    const u16* s = is_vt ? base + (size_t)row * rstride + k0 + c * 8 : base + (size_t)(k0 + row) * rstride + c * 8;
    r[i] = *(const u32x4*)s;
  }
}
template <int NCH>
DI void st_tile_s(const u32x4 (&r)[NCH], unsigned char* dst, bool permute, int tid) {
#pragma unroll
  for (int i = 0; i < NCH; ++i) {
    int id = tid + 256 * i, row = id >> 3, c = id & 7;
    int rr = permute ? swap23(row) : row;
    *(u32x4*)(dst + rr * 144 + c * 16) = r[i];
  }
}

DI bf16x8 pack8(const f32x16& v, int s2) {
  u32x4 pk;
  if (s2 == 0) pk = u32x4{pack2bf(v[0], v[1]), pack2bf(v[2], v[3]), pack2bf(v[4], v[5]), pack2bf(v[6], v[7])};
  else pk = u32x4{pack2bf(v[8], v[9]), pack2bf(v[10], v[11]), pack2bf(v[12], v[13]), pack2bf(v[14], v[15])};
  return __builtin_bit_cast(bf16x8, pk);
}
DI f32x16 zero16() {
  f32x16 z;
#pragma unroll
  for (int i = 0; i < 16; ++i) z[i] = 0.f;
  return z;
}

DI void diff_map(const unsigned char* sk, const bf16x8 (&qf)[4], const unsigned char* sv, const float* lut, bool far,
                 bool diag, int ks0, int tq, int h, int lq, f32x16 (&O)[4], float& m, float& l) {
  const float csc = 0.125f * LOG2E;
  f32x16 S = zero16();
#pragma unroll
  for (int s = 0; s < 4; ++s) {
    bf16x8 kf = *(const bf16x8*)(sk + lq * 144 + (16 * s + 8 * h) * 2);
    S = mfma32(kf, qf[s], S);
  }
  if (far) {
    const float cbias = lut[128];
    float mx = fmaxf(fmaxf(S[0], S[1]), S[2]);
#pragma unroll
    for (int i = 3; i < 15; i += 2) mx = fmaxf(fmaxf(mx, S[i]), S[i + 1]);
    mx = fmaxf(mx, S[15]);
    mx = fmaxf(mx, __shfl_xor(mx, 32));
    const float mn = fmaxf(m, mx * csc + cbias);
    if (__any(mn > m)) {
      const float a = __builtin_amdgcn_exp2f(m - mn);
      l *= a; m = mn;
#pragma unroll
      for (int d = 0; d < 4; ++d) O[d] *= a;
    }
    const float off = cbias - m;
#pragma unroll
    for (int i = 0; i < 16; ++i) { float pv = __builtin_amdgcn_exp2f(S[i] * csc + off); l += pv; S[i] = pv; }
  } else {
    float mx = -1e30f;
#pragma unroll
    for (int i = 0; i < 16; ++i) {
      const int key = ks0 + 16 * (i >> 3) + 8 * h + (i & 7);
      int d = tq - key;
      const bool msk = diag && d < 0;
      d = d < 0 ? 0 : (d > 128 ? 128 : d);
      float x = S[i] * csc + lut[d];
      if (msk) x = -1e30f;
      S[i] = x;
      mx = fmaxf(mx, x);
    }
    mx = fmaxf(mx, __shfl_xor(mx, 32));
    const float mn = fmaxf(m, mx);
    if (__any(mn > m)) {
      const float a = __builtin_amdgcn_exp2f(m - mn);
      l *= a; m = mn;
#pragma unroll
      for (int d = 0; d < 4; ++d) O[d] *= a;
    }
#pragma unroll
    for (int i = 0; i < 16; ++i) { float pv = __builtin_amdgcn_exp2f(S[i] - m); l += pv; S[i] = pv; }
  }
  const bf16x8 p0 = pack8(S, 0), p1 = pack8(S, 1);
#pragma unroll
  for (int d = 0; d < 4; ++d) {
    bf16x8 v0 = *(const bf16x8*)(sv + (d * 32 + lq) * 144 + 16 * h);
    bf16x8 v1 = *(const bf16x8*)(sv + (d * 32 + lq) * 144 + 32 + 16 * h);
    O[d] = mfma32(v0, p0, O[d]);
    O[d] = mfma32(v1, p1, O[d]);
  }
}

DI void diff_map_far2(const unsigned char* sk, const bf16x8 (&qf)[4], const unsigned char* sv, float cbias, int h, int lq,
                      f32x16 (&O)[4], float& m, float& l) {
  const float csc = 0.125f * LOG2E;
  f32x16 S0 = zero16(), S1 = zero16();
#pragma unroll
  for (int s = 0; s < 4; ++s) {
    bf16x8 k0 = *(const bf16x8*)(sk + lq * 144 + (16 * s + 8 * h) * 2);
    bf16x8 k1 = *(const bf16x8*)(sk + (32 + lq) * 144 + (16 * s + 8 * h) * 2);
    S0 = mfma32(k0, qf[s], S0);
    S1 = mfma32(k1, qf[s], S1);
  }
  float mx = fmaxf(fmaxf(S0[0], S0[1]), S0[2]);
#pragma unroll
  for (int i = 3; i < 15; i += 2) mx = fmaxf(fmaxf(mx, S0[i]), S0[i + 1]);
  mx = fmaxf(mx, S0[15]);
#pragma unroll
  for (int i = 0; i < 16; i += 2) mx = fmaxf(fmaxf(mx, S1[i]), S1[i + 1]);
  mx = fmaxf(mx, __shfl_xor(mx, 32));
  const float mn = fmaxf(m, mx * csc + cbias);
  if (__any(mn > m)) {
    const float a = __builtin_amdgcn_exp2f(m - mn);
    l *= a; m = mn;
#pragma unroll
    for (int d = 0; d < 4; ++d) O[d] *= a;
  }
  const float off = cbias - m;
  float la = 0.f, lb = 0.f;
#pragma unroll
  for (int i = 0; i < 16; ++i) {
    float pa = __builtin_amdgcn_exp2f(S0[i] * csc + off), pb = __builtin_amdgcn_exp2f(S1[i] * csc + off);
    la += pa; lb += pb; S0[i] = pa; S1[i] = pb;
  }
  l += la + lb;
  const bf16x8 p0 = pack8(S0, 0), p1 = pack8(S0, 1), p2 = pack8(S1, 0), p3 = pack8(S1, 1);
#pragma unroll
  for (int d = 0; d < 4; ++d) {
    const unsigned char* vr = sv + (d * 32 + lq) * 144 + 16 * h;
    bf16x8 v0 = *(const bf16x8*)(vr), v1 = *(const bf16x8*)(vr + 32), v2 = *(const bf16x8*)(vr + 64), v3 = *(const bf16x8*)(vr + 96);
    O[d] = mfma32(v0, p0, O[d]);
    O[d] = mfma32(v1, p1, O[d]);
    O[d] = mfma32(v2, p2, O[d]);
    O[d] = mfma32(v3, p3, O[d]);
  }
}

DI void diff_job8(const Params& p, int layer, int b, int head, int qb, unsigned char* smem) {
  int tid_ = threadIdx.x; asm volatile("" : "+v"(tid_));
  const int tid = tid_, lane = tid & 63, wave = tid >> 6, h = lane >> 5, lq = lane & 31;
  const int map = wave >> 2, qg = wave & 3;
  const int t0 = qb * 128, tw0 = t0 + 32 * qg, tq = tw0 + lq;
  const float* lut = (const float*)(smem + LUT_OFF);
  build_lut(p, 4 + head, smem, tid);
  bf16x8 qf[4];
  {
    const u16* qr = p.qdf + (size_t)(b * TP + tq) * 512 + head * 128 + 64 * map + 8 * h;
#pragma unroll
    for (int s = 0; s < 4; ++s) qf[s] = *(const bf16x8*)(qr + 16 * s);
  }
  f32x16 O[4];
#pragma unroll
  for (int i = 0; i < 4; ++i) O[i] = zero16();
  float m = -1e30f, l = 0.f;
  const u16* K1 = p.kdf + (size_t)b * TP * 512 + head * 128;
  const u16* VT = p.vtdf + (size_t)(b * 512 + head * 128) * TP;
  const int ntile = 2 * (qb + 1);
  const int krow = tid >> 3, kc = tid & 7, krs = swap23(krow);
  u32x4 rk1, rk2, rv[2];
  auto gl = [&](int k0) {
    const u16* s = K1 + (size_t)(k0 + krow) * 512 + kc * 8;
    rk1 = *(const u32x4*)s; rk2 = *(const u32x4*)(s + 64);
#pragma unroll
    for (int i = 0; i < 2; ++i) rv[i] = *(const u32x4*)(VT + (size_t)(krow + 64 * i) * TP + k0 + kc * 8);
  };
  auto sl = [&](unsigned char* d) {
    *(u32x4*)(d + krs * 144 + kc * 16) = rk1;
    *(u32x4*)(d + 9216 + krs * 144 + kc * 16) = rk2;
#pragma unroll
    for (int i = 0; i < 2; ++i) *(u32x4*)(d + 18432 + (krow + 64 * i) * 144 + kc * 16) = rv[i];
  };
  gl(0); sl(smem);
  __syncthreads();
  const float cbias = lut[128];
  for (int j = 0; j < ntile; ++j) {
    const bool more = j + 1 < ntile;
    if (more) gl((j + 1) * 64);
    __builtin_amdgcn_sched_barrier(0);
    const unsigned char* sb = smem + (j & 1) * 36864;
    const unsigned char* sk = sb + 9216 * map;
    const int k0 = j * 64;
    if (tw0 - (k0 + 63) >= 113) {
      diff_map_far2(sk, qf, sb + 18432, cbias, h, lq, O, m, l);
    } else {
#pragma unroll 1
      for (int sub = 0; sub < 2; ++sub) {
        const int ks0 = k0 + sub * 32;
        if (ks0 > tw0 + 31) break;
        const bool far = (tw0 - (ks0 + 31)) >= 113;
        const bool diag = (ks0 + 31) > tw0;
        diff_map(sk + sub * 32 * 144, qf, sb + 18432 + sub * 64, lut, far, diag, ks0, tq, h, lq, O, m, l);
      }
    }
    if (more) sl(smem + ((j + 1) & 1) * 36864);
    __syncthreads();
  }
  float lam;
  const float lam_init = 0.8f - 0.6f * expf(-0.3f * (float)layer);
  {
    float a = p.lq1[layer * 64 + lane] * p.lk1[layer * 64 + lane];
    float c = p.lq2[layer * 64 + lane] * p.lk2[layer * 64 + lane];
    a = wave_sum(a); c = wave_sum(c);
    lam = expf(a) - expf(c) + lam_init;
  }
  l += __shfl_xor(l, 32);
  const float il = (map ? lam : 1.f) / l;
  float* X = (float*)smem + (size_t)(qg * 32 + lq) * 132;
  if (map == 1) {
#pragma unroll
    for (int d = 0; d < 4; ++d)
#pragma unroll
      for (int g = 0; g < 4; ++g) {
        float4 v = make_float4(O[d][4 * g] * il, O[d][4 * g + 1] * il, O[d][4 * g + 2] * il, O[d][4 * g + 3] * il);
        *(float4*)(X + 32 * d + 8 * g + 4 * h) = v;
      }
  }
  __syncthreads();
  if (map == 0) {
    float ss = 0.f;
#pragma unroll
    for (int d = 0; d < 4; ++d)
#pragma unroll
      for (int g = 0; g < 4; ++g) {
        const float4 v = *(const float4*)(X + 32 * d + 8 * g + 4 * h);
        float y0 = O[d][4 * g] * il - v.x, y1 = O[d][4 * g + 1] * il - v.y, y2 = O[d][4 * g + 2] * il - v.z, y3 = O[d][4 * g + 3] * il - v.w;
        O[d][4 * g] = y0; O[d][4 * g + 1] = y1; O[d][4 * g + 2] = y2; O[d][4 * g + 3] = y3;
        ss += y0 * y0 + y1 * y1 + y2 * y2 + y3 * y3;
      }
    ss += __shfl_xor(ss, 32);
    const float sc = rsqrtf(ss * (1.f / 128.f) + EPS) * (1.f - lam_init);
    const float* sg = p.subln + layer * 128;
    u16* yr = p.ydf + (size_t)(b * TP + tq) * 512 + head * 128;
#pragma unroll
    for (int d = 0; d < 4; ++d)
#pragma unroll
      for (int g = 0; g < 4; ++g) {
        const int dv = 32 * d + 8 * g + 4 * h;
        const float4 g4 = *(const float4*)(sg + dv);
        u32x2 pk = {pack2bf(O[d][4 * g] * sc * g4.x, O[d][4 * g + 1] * sc * g4.y),
                    pack2bf(O[d][4 * g + 2] * sc * g4.z, O[d][4 * g + 3] * sc * g4.w)};
        *(u32x2*)(yr + dv) = pk;
      }
  }
  __syncthreads();
}

DI void sparse_job(const Params& p, int layer, int b, int head, int qb, unsigned char* smem) {
  int tid_ = threadIdx.x & 255; asm volatile("" : "+v"(tid_));
  const int tid = tid_, lane = tid & 63, wave = tid >> 6, h = lane >> 5, lq = lane & 31;
  const int t0 = qb * 128, tw0 = t0 + 32 * wave, tq = tw0 + lq;
  const float* lut = (const float*)(smem + LUT_OFF);
  build_lut(p, head, smem, tid);
  bf16x8 qf[4];
  {
    const u16* qr = p.qsp + (size_t)(b * TP + tq) * 256 + head * 64 + 8 * h;
#pragma unroll
    for (int s = 0; s < 4; ++s) qf[s] = *(const bf16x8*)(qr + 16 * s);
  }
  f32x16 O[2] = {zero16(), zero16()};
  float m = -1e30f, l = 0.f;
  const u16* Kp = p.ksp + (size_t)b * TP * 256 + head * 64;
  const u16* VT = p.vtsp + (size_t)(b * 256 + head * 64) * TP;
  const u32* mrow = p.mask + (size_t)(b * TP + tq) * MW;
  const int ntile = 2 * (qb + 1);
  const float csc = 0.125f * LOG2E;
  u32x4 rk[2], rv[2];
  ld_tile_g<2>(rk, Kp, 256, 0, false, tid); ld_tile_g<2>(rv, VT, TP, 0, true, tid);
  u32x2 mnext = *(const u32x2*)(mrow);
  st_tile_s<2>(rk, smem, true, tid); st_tile_s<2>(rv, smem + 9216, false, tid);
  __syncthreads();
  for (int j = 0; j < ntile; ++j) {
    const bool more = j + 1 < ntile;
    const u32x2 mcur = mnext;
    if (more) { const int k0 = (j + 1) * 64; ld_tile_g<2>(rk, Kp, 256, k0, false, tid); ld_tile_g<2>(rv, VT, TP, k0, true, tid); mnext = *(const u32x2*)(mrow + 2 * (j + 1)); }
    __builtin_amdgcn_sched_barrier(0);
    const unsigned char* sb = smem + (j & 1) * 18432;
#pragma unroll 1
    for (int sub = 0; sub < 2; ++sub) {
      const int ks0 = j * 64 + sub * 32;
      if (ks0 > tw0 + 31) break;
      const u32 mw = sub ? mcur[1] : mcur[0];
      if (!__any(mw != 0u)) continue;
      f32x16 S = zero16();
#pragma unroll
      for (int s = 0; s < 4; ++s) {
        bf16x8 k1 = *(const bf16x8*)(sb + (sub * 32 + lq) * 144 + (16 * s + 8 * h) * 2);
        S = mfma32(k1, qf[s], S);
      }
      const bool far = (tw0 - (ks0 + 31)) >= 113;
      const float cbias = lut[128];
      const u32 sel16 = ((mw >> (8 * h)) & 0xffu) | (((mw >> (16 + 8 * h)) & 0xffu) << 8);
      if (far) {
        float mx = -1e30f;
#pragma unroll
        for (int i = 0; i < 16; ++i) mx = fmaxf(mx, (sel16 & (1u << i)) ? S[i] : -1e30f);
        mx = fmaxf(mx, __shfl_xor(mx, 32));
        const float mn = mx > -1e29f ? fmaxf(m, mx * csc + cbias) : m;
        if (__any(mn > m)) {
          const float a = __builtin_amdgcn_exp2f(m - mn);
          l *= a; O[0] *= a; O[1] *= a;
          m = mn;
        }
        const float off = cbias - m;
#pragma unroll
        for (int i = 0; i < 16; ++i) {
          float pv = (sel16 & (1u << i)) ? __builtin_amdgcn_exp2f(S[i] * csc + off) : 0.f;
          l += pv;
          S[i] = pv;
        }
      } else {
        float mx = -1e30f;
#pragma unroll
        for (int i = 0; i < 16; ++i) {
          const int ko = 16 * (i >> 3) + 8 * h + (i & 7);
          int d = tq - (ks0 + ko); d = d < 0 ? 0 : (d > 128 ? 128 : d);
          float x = S[i] * csc + lut[d];
          if (!(sel16 & (1u << i))) x = -1e30f;
          S[i] = x;
          mx = fmaxf(mx, x);
        }
        mx = fmaxf(mx, __shfl_xor(mx, 32));
        const float mn = fmaxf(m, mx);
        if (__any(mn > m)) {
          const float a = __builtin_amdgcn_exp2f(m - mn);
          l *= a; O[0] *= a; O[1] *= a;
          m = mn;
        }
#pragma unroll
        for (int i = 0; i < 16; ++i) {
          float pv = S[i] > -1e29f ? __builtin_amdgcn_exp2f(S[i] - m) : 0.f;
          l += pv;
          S[i] = pv;
        }
      }
      bf16x8 pa0 = pack8(S, 0), pa1 = pack8(S, 1);
#pragma unroll
      for (int d = 0; d < 2; ++d) {
        bf16x8 v0 = *(const bf16x8*)(sb + 9216 + (d * 32 + lq) * 144 + (sub * 32 + 8 * h) * 2);
        bf16x8 v1 = *(const bf16x8*)(sb + 9216 + (d * 32 + lq) * 144 + (sub * 32 + 16 + 8 * h) * 2);
        O[d] = mfma32(v0, pa0, O[d]);
        O[d] = mfma32(v1, pa1, O[d]);
      }
    }
    if (more) { unsigned char* d = smem + ((j + 1) & 1) * 18432; st_tile_s<2>(rk, d, true, tid); st_tile_s<2>(rv, d + 9216, false, tid); }
    __syncthreads();
  }
  l += __shfl_xor(l, 32);
  const float il = 1.f / l;
  u16* yr = p.ysp + (size_t)(b * TP + tq) * 256 + head * 64;
#pragma unroll
  for (int d = 0; d < 2; ++d)
#pragma unroll
    for (int g = 0; g < 4; ++g) {
      u32x2 pk = {pack2bf(O[d][4 * g] * il, O[d][4 * g + 1] * il), pack2bf(O[d][4 * g + 2] * il, O[d][4 * g + 3] * il)};
      *(u32x2*)(yr + 32 * d + 8 * g + 4 * h) = pk;
    }
  __syncthreads();
}

DI void sb_job(const Params& p, int b, int head, int qb, unsigned char* smem) {
  int tid_ = threadIdx.x & 255; asm volatile("" : "+v"(tid_));
  const int tid = tid_, lane = tid & 63, wave = tid >> 6, h = lane >> 5, lq = lane & 31;
  const int t0 = qb * 128, tw0 = t0 + 32 * wave, tq = tw0 + lq;
  bf16x8 qf[4];
  {
    const u16* qr = p.qsb + (size_t)(b * TP + tq) * 256 + head * 64 + 8 * h;
#pragma unroll
    for (int s = 0; s < 4; ++s) qf[s] = *(const bf16x8*)(qr + 16 * s);
  }
  f32x16 O[2] = {zero16(), zero16()};
  float carry = 0.f;
  const u16* Kp = p.ksb + (size_t)b * TP * 256 + head * 64;
  const u16* VT = p.vtsb + (size_t)(b * 256 + head * 64) * TP;
  const int ntile = 2 * (qb + 1);
  u32x4 rk[2], rv[2];
  ld_tile_g<2>(rk, Kp, 256, (ntile - 1) * 64, false, tid); ld_tile_g<2>(rv, VT, TP, (ntile - 1) * 64, true, tid);
  st_tile_s<2>(rk, smem, true, tid); st_tile_s<2>(rv, smem + 9216, false, tid);
  __syncthreads();
  for (int jj = 0; jj < ntile; ++jj) {
    const int j = ntile - 1 - jj;
    const bool more = jj + 1 < ntile;
    if (more) { const int k0 = (j - 1) * 64; ld_tile_g<2>(rk, Kp, 256, k0, false, tid); ld_tile_g<2>(rv, VT, TP, k0, true, tid); }
    __builtin_amdgcn_sched_barrier(0);
    const unsigned char* sb = smem + (jj & 1) * 18432;
    const bool wdone = !__any(carry >= -104.f);
    if (!wdone) {
#pragma unroll 1
      for (int sub = 1; sub >= 0; --sub) {
        const int ks0 = j * 64 + sub * 32;
        if (ks0 > tw0) continue;
        f32x16 S = zero16();
#pragma unroll
        for (int s = 0; s < 4; ++s) {
          bf16x8 k1 = *(const bf16x8*)(sb + (sub * 32 + lq) * 144 + (16 * s + 8 * h) * 2);
          S = mfma32(k1, qf[s], S);
        }
        const bool diag = (ks0 + 31) >= tw0;
        float lsm[16];
        float sA = 0.f, sB = 0.f;
#pragma unroll
        for (int i = 0; i < 16; ++i) {
          const int key = ks0 + 16 * (i >> 3) + 8 * h + (i & 7);
          const float z = S[i] * 0.125f;
          const float sp = fmaxf(z, 0.f) + __logf(1.f + __expf(-fabsf(z)));
          const bool valid = !diag || key < tq;
          lsm[i] = valid ? -sp : 0.f;
          S[i] = valid ? z - sp : -1e30f;
          if (i < 8) sA += lsm[i]; else sB += lsm[i];
        }
        const float oA = __shfl_xor(sA, 32), oB = __shfl_xor(sB, 32);
        const float aboveB = h == 0 ? oB : 0.f;
        const float aboveA = h == 0 ? (oA + sB + oB) : (oB + sB);
        float run = carry + aboveB;
#pragma unroll
        for (int i = 15; i >= 8; --i) { float lw = S[i] + run; run += lsm[i]; S[i] = lw > -1e29f ? __expf(lw) : 0.f; }
        run = carry + aboveA;
#pragma unroll
        for (int i = 7; i >= 0; --i) { float lw = S[i] + run; run += lsm[i]; S[i] = lw > -1e29f ? __expf(lw) : 0.f; }
        carry += sA + sB + oA + oB;
        bf16x8 pa0 = pack8(S, 0), pa1 = pack8(S, 1);
#pragma unroll
        for (int d = 0; d < 2; ++d) {
          bf16x8 v0 = *(const bf16x8*)(sb + 9216 + (d * 32 + lq) * 144 + (sub * 32 + 8 * h) * 2);
          bf16x8 v1 = *(const bf16x8*)(sb + 9216 + (d * 32 + lq) * 144 + (sub * 32 + 16 + 8 * h) * 2);
          O[d] = mfma32(v0, pa0, O[d]);
          O[d] = mfma32(v1, pa1, O[d]);
        }
      }
    }
    if (more) { unsigned char* d = smem + ((jj + 1) & 1) * 18432; st_tile_s<2>(rk, d, true, tid); st_tile_s<2>(rv, d + 9216, false, tid); }
    const int alldone = __syncthreads_and((int)(!__any(carry >= -104.f)));
    if (alldone) break;
  }
  u16* yr = p.ysb + (size_t)(b * TP + tq) * 256 + head * 64;
#pragma unroll
  for (int d = 0; d < 2; ++d)
#pragma unroll
    for (int g = 0; g < 4; ++g) {
      u32x2 pk = {pack2bf(O[d][4 * g], O[d][4 * g + 1]), pack2bf(O[d][4 * g + 2], O[d][4 * g + 3])};
      *(u32x2*)(yr + 32 * d + 8 * g + 4 * h) = pk;
    }
  __syncthreads();
}

DI void idx_scan(const u32* hq, int need, u32* outbin, u32* outneed, int q, int lane) {
  u32 c = 0;
#pragma unroll
  for (int w = 0; w < 8; ++w) { u32 v = hq[8 * lane + w]; c += (v & 0xffffu) + (v >> 16); }
  u32 incl = c;
#pragma unroll
  for (int o = 1; o < 64; o <<= 1) { u32 v = __shfl_down(incl, o); if (lane + o < 64) incl += v; }
  const u32 above = incl - c;
  if ((int)above < need && need <= (int)incl) {
    u32 cum = above;
    for (int bin = 16 * lane + 15; bin >= 16 * lane; --bin) {
      u32 cnt = (hq[bin >> 1] >> ((bin & 1) * 16)) & 0xffffu;
      if ((int)(cum + cnt) >= need) { outbin[q] = (u32)bin; outneed[q] = (u32)need - cum; break; }
      cum += cnt;
    }
  }
}

template <int PASS, bool DIAG>
DI void idx_tile(const bf16x8 kf, const bf16x8 (&qf)[8], const float (&wq)[8], int kt, int lm, int lg, int tq, bool selall, u32 bA, u32 pfx,
                 u32* hist, u32* maskw, u32* cand, u32* ccnt) {
  const f32x4 z4 = {0.f, 0.f, 0.f, 0.f};
  f32x4 sc = z4;
#pragma unroll
  for (int j = 0; j < 8; ++j) {
    f32x4 d = mfma16(kf, qf[j], z4);
#pragma unroll
    for (int r = 0; r < 4; ++r) sc[r] += wq[j] * fmaxf(d[r], 0.f);
  }
  u32 selbits = 0u;
#pragma unroll
  for (int r = 0; r < 4; ++r) {
    const int key = kt * 16 + lg * 4 + r;
    const bool valid = !DIAG || key <= tq;
    const u32 bits = __float_as_uint(sc[r]);
    const u32 u = bits ^ ((u32)((int)bits >> 31) | 0x80000000u);
    if (PASS == 0) {
      if (valid) { const u32 bin = u >> 22; atomicAdd(&hist[lm * 512 + (bin >> 1)], 1u << ((bin & 1) * 16)); }
    } else if (PASS == 1) {
      if (valid && (u >> 22) == bA) { const u32 bin = (u >> 12) & 1023u; atomicAdd(&hist[lm * 512 + (bin >> 1)], 1u << ((bin & 1) * 16)); }
    } else {
      const u32 pp = u >> 12;
      if (valid && (selall || pp > pfx)) selbits |= 1u << r;
      if (valid && !selall && pp == pfx) {
        const u32 ix = atomicAdd(&ccnt[lm], 1u);
        if (ix < 64u) { cand[(lm * 64 + ix) * 2] = u; cand[(lm * 64 + ix) * 2 + 1] = (u32)key; }
      }
    }
  }
  if (PASS == 2 && selbits) {
    const int kb = kt * 16 + lg * 4;
    atomicOr(&maskw[lm * MW + (kb >> 5)], selbits << (kb & 31));
  }
}
template <int PASS>
DI void idx_pass(const u16* kp, const bf16x8 (&qf)[8], const float (&wq)[8], int wave, int ntile, int lm, int lg, int tq, bool selall,
                 u32 bA, u32 pfx, u32* hist, u32* maskw, u32* cand, u32* ccnt) {
  auto ldk = [&](int t) { return *(const bf16x8*)(kp + (size_t)(t < ntile ? t : 0) * 512); };
  int kt = wave;
  bf16x8 ka = ldk(kt), kb = ldk(kt + 4);
  for (; kt + 4 < ntile - 1; kt += 8) {
    const bf16x8 kc = ldk(kt + 8), kd = ldk(kt + 12);
    idx_tile<PASS, false>(ka, qf, wq, kt, lm, lg, tq, selall, bA, pfx, hist, maskw, cand, ccnt);
    idx_tile<PASS, false>(kb, qf, wq, kt + 4, lm, lg, tq, selall, bA, pfx, hist, maskw, cand, ccnt);
    ka = kc; kb = kd;
  }
  if (kt < ntile - 1) { idx_tile<PASS, false>(ka, qf, wq, kt, lm, lg, tq, selall, bA, pfx, hist, maskw, cand, ccnt); kt += 4; ka = kb; }
  if (kt == ntile - 1) idx_tile<PASS, true>(ka, qf, wq, kt, lm, lg, tq, selall, bA, pfx, hist, maskw, cand, ccnt);
}

DI void idx_job(const Params& p, int b, int qg, unsigned char* smem) {
  int tid_ = threadIdx.x & 255; asm volatile("" : "+v"(tid_));
  const int tid = tid_, lane = tid & 63, wave = tid >> 6, lm = lane & 15, lg = lane >> 4;
  u32* hist = (u32*)smem;
  u32* maskw = (u32*)(smem + 32768);
  u32* cand = (u32*)(smem + 41216);
  u32* ccnt = (u32*)(smem + 49408);
  u32* binA = ccnt + 16; u32* needB = ccnt + 32; u32* binB = ccnt + 48; u32* needC = ccnt + 64;
  const int t0 = qg * 16, ntile = qg + 1, tq = t0 + lm;
  const bool selall = tq + 1 <= 256;
  bf16x8 qf[8];
  float wq[8];
  {
    const u16* qr = p.qix + (size_t)(b * TP + tq) * 256 + lg * 8;
    const float* wr = p.wix + (size_t)(b * TP + tq) * 8;
#pragma unroll
    for (int j = 0; j < 8; ++j) { qf[j] = *(const bf16x8*)(qr + j * 32); wq[j] = wr[j]; }
  }
  for (int i = tid; i < 8192 + 2112; i += 256) hist[i] = 0u;
  if (tid < 80) ccnt[tid] = 0u;
  __syncthreads();
  const u16* kbase = p.kix + (size_t)b * TP * 32;
  const f32x4 z4 = {0.f, 0.f, 0.f, 0.f};
  const u16* kp = kbase + (size_t)lm * 32 + lg * 8;
  idx_pass<0>(kp, qf, wq, wave, ntile, lm, lg, tq, selall, 0u, 0u, hist, maskw, cand, ccnt);
  __syncthreads();
  for (int qq = 0; qq < 4; ++qq) idx_scan(hist + (wave * 4 + qq) * 512, 256, binA, needB, wave * 4 + qq, lane);
  __syncthreads();
  for (int i = tid; i < 8192; i += 256) hist[i] = 0u;
  __syncthreads();
  idx_pass<1>(kp, qf, wq, wave, ntile, lm, lg, tq, selall, binA[lm], 0u, hist, maskw, cand, ccnt);
  __syncthreads();
  for (int qq = 0; qq < 4; ++qq) idx_scan(hist + (wave * 4 + qq) * 512, (int)needB[wave * 4 + qq], binB, needC, wave * 4 + qq, lane);
  __syncthreads();
  idx_pass<2>(kp, qf, wq, wave, ntile, lm, lg, tq, selall, binA[lm], (binA[lm] << 10) | binB[lm], hist, maskw, cand, ccnt);
  __syncthreads();
  {
    const int q = tid >> 4, i0 = tid & 15;
    u32 cnt = ccnt[q]; if (cnt > 64u) cnt = 64u;
    const u32 need = needC[q];
    for (u32 c = i0; c < cnt; c += 16) {
      const u32 u = cand[(q * 64 + c) * 2], key = cand[(q * 64 + c) * 2 + 1];
      u32 rank = 0;
      for (u32 e = 0; e < cnt; ++e) {
        const u32 u2 = cand[(q * 64 + e) * 2], k2 = cand[(q * 64 + e) * 2 + 1];
        rank += (u2 > u || (u2 == u && k2 < key)) ? 1u : 0u;
      }
      if (rank < need) atomicOr(&maskw[q * MW + (key >> 5)], 1u << (key & 31));
    }
  }
  __syncthreads();
  for (int i = tid; i < 16 * MW; i += 256) p.mask[(size_t)(b * TP + t0) * MW + i] = maskw[i];
  __syncthreads();
}

DI int next_job(u32* ctr, unsigned char* smem) {
  int* sj = (int*)(smem + SJOB_OFF);
  __syncthreads();
  if (threadIdx.x == 0) *sj = (int)atomicAdd(ctr, 1u);
  __syncthreads();
  return *sj;
}

DI void phase_attn(const Params& p, int layer, int phase, unsigned char* smem) {
  u32* ctr = p.ctr + phase;
  for (;;) {
    const int jp = next_job(ctr, smem);
    if (jp >= 2640) break;
    if (jp < 1056) { const int qb = 32 - jp / 32, r = jp & 31; diff_job8(p, layer, r >> 2, r & 3, qb, smem); continue; }
    int half = threadIdx.x >> 8; asm volatile("" : "+v"(half));
    unsigned char* sm = smem + half * HALF_BYTES;
    const int job = 2 * (jp - 1056) + half;
    if (job < 2112) { idx_job(p, job & 7, 263 - (job >> 3), sm); }
    else { const int i = job - 2112; const int qb = 32 - i / 32, r = i & 31; sb_job(p, r >> 2, r & 3, qb, sm); }
  }
}
DI void phase_sparse(const Params& p, int layer, int phase, unsigned char* smem) {
  u32* ctr = p.ctr + phase;
  for (;;) {
    const int jp = next_job(ctr, smem);
    if (jp >= 528) break;
    int half = threadIdx.x >> 8; asm volatile("" : "+v"(half));
    unsigned char* sm = smem + half * HALF_BYTES;
    const int job = 2 * jp + half;
    const int qb = 32 - job / 32, r = job & 31;
    sparse_job(p, layer, r >> 2, r & 3, qb, sm);
  }
}

DI void run_phase(const Params& p, int ph, unsigned char* smem, int rep = 0) {
  if (ph == 0) { phase_prep(p, smem); return; }
  const int layer = (ph - 1) / 7, s = (ph - 1) % 7;
  const u16* WL = p.wts + (size_t)layer * LAYER_W;
  switch (s) {
    case 0: phase_g1(p, layer, smem); break;
    case 1: phase_attn(p, layer, ph + 16 * rep, smem); break;
    case 2: phase_sparse(p, layer, ph + 16 * rep, smem); break;
    case 3: phase_merge(p, layer, smem); break;
    case 4: phase_resid(p, layer == 0 ? 1 : 0, p.merged, DM, WL + OFF_OUT, p.rowss + (size_t)(2 * layer + 1) * R, false, smem); break;
    case 5: phase_ffnup(p, layer, smem); break;
    default: phase_resid(p, 0, p.act, DFF, WL + OFF_DOWN, p.rowss + (size_t)(2 * layer + 2) * R, layer == 1, smem); break;
  }
}


#define XB_TMO      128
#define XB_XCNT(j)  (256  + 64 * (j))
#define XB_XSUB(j)  (1280 + 64 * (j))
#define XB_XGEN(j)  (2304 + 64 * (j))
#define XB_TOP      3328
#define XB_TOPGEN   3392
#define XCD_BAR_WORDS 3456
#define XB_SPIN_CAP (1u << 20)
#define LAS __attribute__((address_space(3)))
DI unsigned xb_ld(unsigned* p) { return __hip_atomic_load(p, __ATOMIC_RELAXED, __HIP_MEMORY_SCOPE_AGENT); }
DI unsigned xb_add(unsigned* p, unsigned v) { return __hip_atomic_fetch_add(p, v, __ATOMIC_RELAXED, __HIP_MEMORY_SCOPE_AGENT); }
DI unsigned xb_xcc_id() { return (unsigned)__builtin_amdgcn_s_getreg((3 << 11) | 20) & 0xFu; }
#define XB_SPIN(cond, bar) do { unsigned _sp = 0; while (cond) { __builtin_amdgcn_s_sleep(1); \
    if ((++_sp & 255u) == 0u) { if (xb_ld(&(bar)[XB_TMO])) break; if (_sp > XB_SPIN_CAP) { atomicAdd(&(bar)[XB_TMO], 1u); break; } } } } while (0)
struct XcdBarrier { unsigned* bar; unsigned x; volatile LAS unsigned* st; };
DI XcdBarrier xcd_barrier_post(unsigned* bar, volatile LAS unsigned* st) {
  XcdBarrier b; b.bar = bar; b.x = xb_xcc_id(); b.st = st;
  if (threadIdx.x == 0) (void)xb_add(&bar[XB_XCNT(b.x)], 1u);
  return b;
}
DI void xcd_barrier_complete(unsigned* bar, unsigned x, unsigned& nloc, unsigned& nx) {
  const unsigned G = gridDim.x * gridDim.y * gridDim.z;
  unsigned sum, cnt, mine, sp = 0u;
  for (;;) {
    sum = 0u; cnt = 0u; mine = 0u;
#pragma unroll
    for (unsigned j = 0; j < 16; ++j) { const unsigned c = xb_ld(&bar[XB_XCNT(j)]); sum += c; cnt += (c > 0u) ? 1u : 0u; mine = (j == x) ? c : mine; }
    if (sum == G) break;
    __builtin_amdgcn_s_sleep(1);
    if ((++sp & 255u) == 0u) { if (xb_ld(&bar[XB_TMO])) break; if (sp > XB_SPIN_CAP) { atomicAdd(&bar[XB_TMO], 1u); break; } }
  }
  nloc = mine > 0u ? mine : 1u; nx = cnt > 0u ? cnt : 1u;
}
DI void xcd_barrier(const XcdBarrier& b) {
  asm volatile("s_waitcnt vmcnt(0)" ::: "memory");
  __syncthreads();
  if (threadIdx.x == 0) {
    unsigned* bar = b.bar;
    __builtin_amdgcn_s_waitcnt(0);
    unsigned nloc = b.st[0], nx = b.st[1];
    if (nloc == 0u) { xcd_barrier_complete(bar, b.x, nloc, nx); b.st[0] = nloc; b.st[1] = nx; }
    const unsigned old = xb_add(&bar[XB_XSUB(b.x)], 1u);
    const unsigned gen = old / nloc;
    if (old + 1u == (gen + 1u) * nloc) {
      __builtin_amdgcn_fence(__ATOMIC_RELEASE, "agent");
      asm volatile("s_waitcnt vmcnt(0)" ::: "memory");
      const unsigned og = xb_add(&bar[XB_TOP], 1u);
      const unsigned tg = og / nx;
      if (og + 1u == (tg + 1u) * nx) xb_add(&bar[XB_TOPGEN], 1u);
      else XB_SPIN(xb_ld(&bar[XB_TOPGEN]) == tg, bar);
      __builtin_amdgcn_fence(__ATOMIC_ACQUIRE, "agent");
      xb_add(&bar[XB_XGEN(b.x)], 1u);
      asm volatile("s_waitcnt vmcnt(0)" ::: "memory");
    } else {
      XB_SPIN(xb_ld(&bar[XB_XGEN(b.x)]) == gen, bar);
      __builtin_amdgcn_fence(__ATOMIC_ACQUIRE, "agent");
      asm volatile("s_waitcnt vmcnt(0)" ::: "memory");
    }
  }
  __syncthreads();
}

constexpr int NPHASE = 15;

__global__ void __launch_bounds__(512) mega(Params p, int ph_lo, int ph_hi) {
  __shared__ __attribute__((aligned(16))) unsigned char smem[SMEM_BYTES];
  volatile LAS unsigned* xst = (volatile LAS unsigned*)(smem + (SMEM_BYTES - 16));
  if (threadIdx.x == 0) { xst[0] = 0u; xst[1] = 0u; }
  __syncthreads();
  const XcdBarrier xb = xcd_barrier_post(p.bar, xst);
  for (int ph = ph_lo; ph < ph_hi; ++ph) {
    run_phase(p, ph, smem);
#ifdef PROBE_MASK
    if (ph > 0 && ((PROBE_MASK >> ((ph - 1) % 7)) & 1)) { cg::this_grid().sync(); run_phase(p, ph, smem, 1); }
#endif
    if (ph + 1 < ph_hi) { if (ph_hi > 1000) cg::this_grid().sync(); else xcd_barrier(xb); }
  }
}

extern "C" void kernel_launch(void* const* d_in, const int* in_sizes, int n_in, void* d_out, int out_size, void* d_ws,
                              size_t ws_size, hipStream_t stream) {
  Params p{};
  const float* const* in = (const float* const*)d_in;
  p.x = in[0]; p.meta = in[1]; p.rel_bias = in[2]; p.attn_norm = in[3]; p.w_in = in[4]; p.b_gate = in[5];
  p.qn_sp = in[6]; p.kn_sp = in[7]; p.qn_df = in[8]; p.kn_df = in[9]; p.lq1 = in[10]; p.lk1 = in[11]; p.lq2 = in[12];
  p.lk2 = in[13]; p.subln = in[14]; p.w_br_sb = in[15]; p.w_br_sp = in[16]; p.w_br_df = in[17]; p.w_out = in[18];
  p.ffn_norm = in[19]; p.w_up = in[20]; p.conv_w = in[21]; p.conv_b = in[22]; p.w_down = in[23];
  p.out = (float*)d_out;
  unsigned char* w = (unsigned char*)d_ws;
  size_t off = 0;
  auto take = [&](size_t bytes) { unsigned char* r = w + off; off += (bytes + 255) & ~(size_t)255; return r; };
  p.ctr = (u32*)take(256);
  p.bar = (u32*)take((size_t)XCD_BAR_WORDS * 4);
  p.hb = (u16*)take((size_t)(R + 512) * DM * 2) + (size_t)256 * DM;
  p.rowss = (float*)take((size_t)4 * R * 4);
  p.side = (float*)take((size_t)NB * 128 * DM * 4);
  p.wts = (u16*)take((size_t)2 * LAYER_W * 2);
  p.mask = (u32*)take((size_t)R * MW * 4);
  unsigned char* region = w + off;
  p.qsb = (u16*)take((size_t)R * 256 * 2); p.ksb = (u16*)take((size_t)R * 256 * 2);
  p.qsp = (u16*)take((size_t)R * 256 * 2); p.ksp = (u16*)take((size_t)R * 256 * 2);
  p.qdf = (u16*)take((size_t)R * 512 * 2); p.kdf = (u16*)take((size_t)R * 512 * 2);
  p.vtsb = (u16*)take((size_t)R * 256 * 2); p.vtsp = (u16*)take((size_t)R * 256 * 2); p.vtdf = (u16*)take((size_t)R * 512 * 2);
  p.qix = (u16*)take((size_t)R * 256 * 2); p.kix = (u16*)take((size_t)R * 32 * 2); p.wix = (float*)take((size_t)R * 8 * 4);
  p.ysb = (u16*)take((size_t)R * 256 * 2); p.ysp = (u16*)take((size_t)R * 256 * 2); p.ydf = (u16*)take((size_t)R * 512 * 2);
  p.merged = (u16*)region;
  p.act = (u16*)region;
  if (off > ws_size) { fprintf(stderr, "workspace too small: need %zu have %zu\n", off, ws_size); return; }
#if FUSED
  static int grid_blocks = 0;
  if (!grid_blocks) {
    int dev = 0, cus = 0, per_cu = 0;
    hipGetDevice(&dev);
    hipDeviceGetAttribute(&cus, hipDeviceAttributeMultiprocessorCount, dev);
    hipOccupancyMaxActiveBlocksPerMultiprocessor(&per_cu, mega, 512, 0);
    if (per_cu > 1) per_cu = 1;
    grid_blocks = cus * per_cu;
  }
  int lo = 0, hi = NPHASE;
  (void)hipMemsetAsync(p.bar, 0, (size_t)XCD_BAR_WORDS * 4, stream);
  void* args[] = {&p, &lo, &hi};
  hipError_t e = hipLaunchCooperativeKernel((void*)mega, dim3(grid_blocks), dim3(512), args, 0, stream);
  if (e != hipSuccess) fprintf(stderr, "cooperative launch failed: %s (grid %d)\n", hipGetErrorString(e), grid_blocks);
#else
  for (int ph = 0; ph < NPHASE; ++ph) mega<<<256, 512, 0, stream>>>(p, ph, ph + 1);
#endif
}
```

```cpp
#include <hip/hip_runtime.h>
#include <hip/hip_cooperative_groups.h>
#include <cstdio>
namespace cg = cooperative_groups;

#ifndef FUSED
#define FUSED 1
#endif

#define DI __device__ __forceinline__
typedef unsigned short u16;
typedef unsigned int u32;
using bf16x8 = __attribute__((ext_vector_type(8))) short;
using f32x4 = __attribute__((ext_vector_type(4))) float;
using f32x16 = __attribute__((ext_vector_type(16))) float;
using u32x4 = __attribute__((ext_vector_type(4))) unsigned;
using u32x2 = __attribute__((ext_vector_type(2))) unsigned;
typedef __bf16 bf2_t __attribute__((ext_vector_type(2)));
typedef float f2_t __attribute__((ext_vector_type(2)));

constexpr int NB = 8, SEQ = 4096, DM = 1024, TP = 4224, TREAL = 4112, NMETA = 16, R = NB * TP;
constexpr int DFF = 2816, DIN = 6440, MW = 132;
constexpr float EPS = 1e-6f;
constexpr float LOG2E = 1.4426950408889634f;
constexpr int HALF_BYTES = 75776;
constexpr int SMEM_BYTES = 2 * HALF_BYTES;
constexpr int LUT_OFF = 73728;
constexpr int SJOB_OFF = 75000;

constexpr int NWIN = 3584;
constexpr size_t OFF_WIN = 0, OFF_WG = OFF_WIN + (size_t)NWIN * 1024, OFF_BRSB = OFF_WG + (size_t)3072 * 1024, OFF_BRSP = OFF_BRSB + 262144,
                 OFF_BRDF = OFF_BRSP + 262144, OFF_OUT = OFF_BRDF + 524288, OFF_UP = OFF_OUT + 1048576, OFF_DOWN = OFF_UP + (size_t)5632 * 1024,
                 LAYER_W = OFF_DOWN + (size_t)1024 * 2816;

struct Params {
  const float *x, *meta, *rel_bias, *attn_norm, *w_in, *b_gate, *qn_sp, *kn_sp, *qn_df, *kn_df, *lq1, *lk1, *lq2, *lk2,
      *subln, *w_br_sb, *w_br_sp, *w_br_df, *w_out, *ffn_norm, *w_up, *conv_w, *conv_b, *w_down;
  float* out;
  u16* hb; float* rowss; float* side; u16* wts;
  u16 *qsb, *ksb, *qsp, *ksp, *qdf, *kdf, *vtsb, *vtsp, *vtdf, *qix, *kix; float* wix;
  u16 *ysb, *ysp, *ydf; u32* mask; u16* merged; u16* act; u32* ctr; u32* bar;
};

DI u32 pack2bf(float a, float b) {
  f2_t v = {a, b};
  bf2_t r = __builtin_convertvector(v, bf2_t);
  return __builtin_bit_cast(u32, r);
}
DI u16 f2bf(float a) { return (u16)(pack2bf(a, 0.f) & 0xffffu); }
DI float wave_sum(float v) {
#pragma unroll
  for (int o = 32; o; o >>= 1) v += __shfl_xor(v, o);
  return v;
}
DI f32x4 mfma16(bf16x8 a, bf16x8 b, f32x4 c) { return __builtin_amdgcn_mfma_f32_16x16x32_bf16(a, b, c, 0, 0, 0); }
DI f32x16 mfma32(bf16x8 a, bf16x8 b, f32x16 c) { return __builtin_amdgcn_mfma_f32_32x32x16_bf16(a, b, c, 0, 0, 0); }

DI int vblock() {
  int g = gridDim.x, b = blockIdx.x;
  if ((g & 7) == 0) return (b & 7) * (g >> 3) + (b >> 3);
  return b;
}

DI float* hrow_w(const Params& p, int gr) {
  int b = gr / TP, t = gr - b * TP;
  if (t >= NMETA && t < TREAL) return p.out + ((size_t)(b * SEQ + t - NMETA)) * DM;
  int s = t < NMETA ? t : t - TREAL + NMETA;
  return p.side + ((size_t)(b * 128 + s)) * DM;
}
DI const float* hrow_r(const Params& p, int layer, int gr) {
  int b = gr / TP, t = gr - b * TP;
  if (t >= NMETA && t < TREAL) {
    size_t o = ((size_t)(b * SEQ + t - NMETA)) * DM;
    return layer == 0 ? p.x + o : p.out + o;
  }
  int s = t < NMETA ? t : t - TREAL + NMETA;
  return p.side + ((size_t)(b * 128 + s)) * DM;
}

DI int wt_srccol(int kind, int n) {
  if (kind == 0) {
    if (n < 1536) return n;
    if (n < 3072) return 1832 + n - 1536;
    if (n < 3328) return 1536 + n - 3072;
    if (n < 3360) return 1792 + n - 3328;
    if (n < 3368) return 1824 + n - 3360;
    return -1;
  }
  if (kind == 1) return 3368 + n;
  if (kind == 6) {
    int j = n >> 8, w = n & 255, wn = w >> 7, ni = (w & 127) >> 4, c = w & 15;
    int ff = 128 * j + 64 * wn + 16 * (ni >> 1) + c;
    return (ni & 1) ? DFF + ff : ff;
  }
  return n;
}

DI void phase_prep(const Params& p, unsigned char* smem) {
  int tid_ = threadIdx.x; asm volatile("" : "+v"(tid_));
  const int tid = tid_, wave = tid >> 6, lane = tid & 63;
  for (int gr = blockIdx.x * 8 + wave; gr < R; gr += gridDim.x * 8) {
    int b = gr / TP, t = gr - b * TP;
    const float* src = nullptr;
    if (t < NMETA) src = p.meta + (size_t)t * DM;
    else if (t < TREAL) src = p.x + ((size_t)(b * SEQ + t - NMETA)) * DM;
    float4 v[4];
    float ss = 0.f;
#pragma unroll
    for (int i = 0; i < 4; ++i) {
      v[i] = src ? ((const float4*)src)[lane + 64 * i] : make_float4(0.f, 0.f, 0.f, 0.f);
      ss += v[i].x * v[i].x + v[i].y * v[i].y + v[i].z * v[i].z + v[i].w * v[i].w;
    }
    ss = wave_sum(ss);
#pragma unroll
    for (int i = 0; i < 4; ++i) {
      u32x2 pk = {pack2bf(v[i].x, v[i].y), pack2bf(v[i].z, v[i].w)};
      *(u32x2*)(p.hb + (size_t)gr * DM + (lane + 64 * i) * 4) = pk;
    }
    if (lane == 0) { p.rowss[gr] = ss; p.rowss[R + gr] = 0.f; p.rowss[2 * R + gr] = 0.f; p.rowss[3 * R + gr] = 0.f; }
    if (t < NMETA || t >= TREAL) {
      int s = t < NMETA ? t : t - TREAL + NMETA;
      float* d = p.side + ((size_t)(b * 128 + s)) * DM;
#pragma unroll
      for (int i = 0; i < 4; ++i) ((float4*)d)[lane + 64 * i] = v[i];
    }
  }
  if (blockIdx.x == 0 && tid < 64) p.ctr[tid] = 0;
  for (int i = blockIdx.x * 512 + tid; i < 2 * 256 * DM / 8; i += gridDim.x * 512) {
    const int hf = i / (256 * DM / 8), o = i - hf * (256 * DM / 8);
    u16* d = hf ? p.hb + (size_t)R * DM : p.hb - (size_t)256 * DM;
    *(u32x4*)(d + (size_t)o * 8) = u32x4{0u, 0u, 0u, 0u};
  }
  const int half = tid >> 8, t2 = tid & 255;
  float* tl = (float*)(smem + half * HALF_BYTES);
  constexpr int NK[8] = {NWIN, 3072, 1024, 1024, 1024, 1024, 5632, 1024};
  constexpr int KK[8] = {1024, 1024, 256, 256, 512, 1024, 1024, 2816};
  int total = 0;
  int cum[9];
  cum[0] = 0;
#pragma unroll
  for (int k = 0; k < 8; ++k) { total += (NK[k] / 64) * (KK[k] / 64); cum[k + 1] = total; }
  for (int jp = blockIdx.x; 2 * jp < 2 * total; jp += gridDim.x) {
    const int job = 2 * jp + half;
    const bool act = job < 2 * total;
    int layer = job >= total ? 1 : 0;
    int j = job - layer * total;
    int kind = 0;
#pragma unroll
    for (int k = 1; k < 8; ++k) if (j >= cum[k]) kind = k;
    int jj = j;
    int K = 1024, ld = 1024;
    const float* src = p.w_in; const float* gain = nullptr; u16* dst = p.wts + (size_t)layer * LAYER_W;
    switch (kind) {
      case 0: jj -= cum[0]; K = 1024; ld = DIN; src = p.w_in + (size_t)layer * DM * DIN; gain = p.attn_norm + layer * DM; dst += OFF_WIN; break;
      case 1: jj -= cum[1]; K = 1024; ld = DIN; src = p.w_in + (size_t)layer * DM * DIN; gain = p.attn_norm + layer * DM; dst += OFF_WG; break;
      case 2: jj -= cum[2]; K = 256; ld = 1024; src = p.w_br_sb + (size_t)layer * 256 * 1024; dst += OFF_BRSB; break;
      case 3: jj -= cum[3]; K = 256; ld = 1024; src = p.w_br_sp + (size_t)layer * 256 * 1024; dst += OFF_BRSP; break;
      case 4: jj -= cum[4]; K = 512; ld = 1024; src = p.w_br_df + (size_t)layer * 512 * 1024; dst += OFF_BRDF; break;
      case 5: jj -= cum[5]; K = 1024; ld = 1024; src = p.w_out + (size_t)layer * 1024 * 1024; dst += OFF_OUT; break;
      case 6: jj -= cum[6]; K = 1024; ld = 2 * DFF; src = p.w_up + (size_t)layer * DM * 2 * DFF; gain = p.ffn_norm + layer * DM; dst += OFF_UP; break;
      default: jj -= cum[7]; K = DFF; ld = 1024; src = p.w_down + (size_t)layer * DFF * 1024; dst += OFF_DOWN; break;
    }
    int nkt = K / 64;
    int n0 = (jj / nkt) * 64, k0 = (jj % nkt) * 64;
    if (act) {
      const int nn = t2 & 63, kq = t2 >> 6;
      const int col = wt_srccol(kind, n0 + nn);
      const float* sp = src + (size_t)(k0 + kq) * ld + (col >= 0 ? col : 0);
      float v[16];
#pragma unroll
      for (int i = 0; i < 16; ++i) v[i] = sp[(size_t)(4 * i) * ld];
#pragma unroll
      for (int i = 0; i < 16; ++i) {
        float x = col >= 0 ? v[i] : 0.f;
        if (gain) x *= gain[k0 + kq + 4 * i];
        tl[nn * 65 + kq + 4 * i] = x;
      }
    }
    __syncthreads();
    if (act) {
#pragma unroll
      for (int i = 0; i < 2; ++i) {
        int idx = t2 + 256 * i, nn = idx >> 3, c = idx & 7;
        const float* s = tl + nn * 65 + c * 8;
        u32x4 pk = {pack2bf(s[0], s[1]), pack2bf(s[2], s[3]), pack2bf(s[4], s[5]), pack2bf(s[6], s[7])};
        *(u32x4*)(dst + (size_t)(n0 + nn) * K + k0 + c * 8) = pk;
      }
    }
    __syncthreads();
  }
}

template <int MI, int NI>
DI void gemm_kloop(const u16* Au, int lda, const u16* Bu, int ldb, int K, f32x4 (&acc)[NI][MI], unsigned char* smem) {
  int tid_ = threadIdx.x; asm volatile("" : "+v"(tid_));
  const int tid = tid_, lane = tid & 63, wave = tid >> 6, wm = wave >> 1, wn = wave & 1;
  const int lr = tid >> 3, lc = tid & 7;
  const int voa = lr * lda + lc * 8, vob = lr * ldb + lc * 8;
  constexpr int NB2 = NI / 2;
  u32x4 ra[MI], rb[NB2];
  const int nk = K >> 6;
  const int fsw = (lane & 15) >> 1;
  const int fro0 = (lane & 15) * 128 + (((lane >> 4) ^ fsw) << 4);
  const int fro1 = (lane & 15) * 128 + ((((lane >> 4) + 4) ^ fsw) << 4);
  const int wof = lr * 128 + ((lc ^ ((lr >> 1) & 7)) << 4);
#define GLOAD(K0)                                                                                        \
  {                                                                                                      \
    _Pragma("unroll") for (int q = 0; q < MI; ++q) ra[q] = *(const u32x4*)((Au + (size_t)(q * 64) * lda + (K0)) + voa); \
    _Pragma("unroll") for (int q = 0; q < NB2; ++q) rb[q] = *(const u32x4*)((Bu + (size_t)(q * 64) * ldb + (K0)) + vob); \
  }
#define SWRITE(BUF)                                                                                      \
  {                                                                                                      \
    unsigned char* d_ = smem + (BUF) * 65536 + wof;                                                      \
    _Pragma("unroll") for (int q = 0; q < MI; ++q) *(u32x4*)(d_ + q * 8192) = ra[q];                     \
    _Pragma("unroll") for (int q = 0; q < NB2; ++q) *(u32x4*)(d_ + 32768 + q * 8192) = rb[q];            \
  }
  GLOAD(0);
  SWRITE(0);
  if (nk > 1) GLOAD(64);
  for (int kt = 0; kt < nk; ++kt) {
    __syncthreads();
    if (kt + 1 < nk) {
      SWRITE((kt + 1) & 1);
      if (kt + 2 < nk) GLOAD((kt + 2) << 6);
    }
    {
      const unsigned char* sa = smem + (kt & 1) * 65536;
      const unsigned char* sb = sa + 32768;
#pragma unroll
      for (int ks = 0; ks < 2; ++ks) {
        const int fo = ks ? fro1 : fro0;
        bf16x8 af[MI];
#pragma unroll
        for (int i = 0; i < MI; ++i) af[i] = *(const bf16x8*)(sa + (wm * 16 * MI + i * 16) * 128 + fo);
#pragma unroll
        for (int nh = 0; nh < NI; nh += 4) {
          bf16x8 wf[4];
#pragma unroll
          for (int i = 0; i < 4; ++i) wf[i] = *(const bf16x8*)(sb + (wn * 16 * NI + (nh + i) * 16) * 128 + fo);
#pragma unroll
          for (int ni = 0; ni < 4; ++ni)
#pragma unroll
            for (int mi = 0; mi < MI; ++mi) acc[nh + ni][mi] = mfma16(wf[ni], af[mi], acc[nh + ni][mi]);
        }
      }
    }
  }
  __syncthreads();
#undef GLOAD
#undef SWRITE
}

template <int MI, int NI>
DI void zero_acc(f32x4 (&acc)[NI][MI]) {
#pragma unroll
  for (int i = 0; i < NI; ++i)
#pragma unroll
    for (int j = 0; j < MI; ++j) acc[i][j] = f32x4{0.f, 0.f, 0.f, 0.f};
}

DI void phase_g1(const Params& p, int layer, unsigned char* smem) {
  int tid_ = threadIdx.x; asm volatile("" : "+v"(tid_));
  const int tid = tid_, lane = tid & 63, wave = tid >> 6, wm = wave >> 1, wn = wave & 1;
  const int lr = tid >> 3, lc = tid & 7, lm = lane & 15, lg = lane >> 4;
  const u16* W = p.wts + (size_t)layer * LAYER_W + OFF_WIN;
  const float* rowss = p.rowss + (size_t)(2 * layer) * R;
  constexpr int NT = 13, NTILES = 132 * NT;
  for (int it = vblock(); it < NTILES; it += gridDim.x) {
    const int g = it / (4 * NT), rem = it - g * (4 * NT), nt = rem >> 2, mt = g * 4 + (rem & 3);
    f32x4 acc[8][4];
    zero_acc<4, 8>(acc);
    gemm_kloop<4, 8>(p.hb + (size_t)(mt * 256) * DM, DM, W + (size_t)(nt * 256) * DM, DM, DM, acc, smem);
    int mrow[4];
#pragma unroll
    for (int mi = 0; mi < 4; ++mi) {
      mrow[mi] = mt * 256 + wm * 64 + mi * 16 + lm;
      float rs = rsqrtf(rowss[mrow[mi]] * (1.f / DM) + EPS);
#pragma unroll
      for (int ni = 0; ni < 8; ++ni) acc[ni][mi] *= rs;
    }
    int kind;
    u16* dst = nullptr; int ld = 256, col0 = 0, vrows = 256; const float* gn = nullptr;
    if (nt == 0) { kind = 0; dst = p.qsb; }
    else if (nt == 1) { kind = 0; dst = p.ksb; }
    else if (nt == 2) { kind = 2; dst = p.vtsb; vrows = 256; }
    else if (nt == 3) { kind = 1; dst = p.qsp; gn = p.qn_sp + layer * 64; }
    else if (nt == 4) { kind = 1; dst = p.ksp; gn = p.kn_sp + layer * 64; }
    else if (nt == 5) { kind = 2; dst = p.vtsp; vrows = 256; }
    else if (nt < 8) { kind = 1; dst = p.qdf; ld = 512; col0 = (nt - 6) * 256; gn = p.qn_df + layer * 64; }
    else if (nt < 10) { kind = 1; dst = p.kdf; ld = 512; col0 = (nt - 8) * 256; gn = p.kn_df + layer * 64; }
    else if (nt < 12) { kind = 2; dst = p.vtdf; col0 = (nt - 10) * 256; vrows = 512; }
    else { kind = 0; dst = p.qix; }
    if (kind == 1) {
#pragma unroll
      for (int mi = 0; mi < 4; ++mi)
#pragma unroll
        for (int hh = 0; hh < 2; ++hh) {
          float ss = 0.f;
#pragma unroll
          for (int n4 = 0; n4 < 4; ++n4)
#pragma unroll
            for (int r = 0; r < 4; ++r) ss += acc[hh * 4 + n4][mi][r] * acc[hh * 4 + n4][mi][r];
          ss += __shfl_xor(ss, 16);
          ss += __shfl_xor(ss, 32);
          float sc = rsqrtf(ss * (1.f / 64.f) + EPS);
#pragma unroll
          for (int n4 = 0; n4 < 4; ++n4)
#pragma unroll
            for (int r = 0; r < 4; ++r) acc[hh * 4 + n4][mi][r] *= sc * gn[n4 * 16 + lg * 4 + r];
        }
    }
    if (kind == 0 || kind == 1) {
#pragma unroll
      for (int mi = 0; mi < 4; ++mi)
#pragma unroll
        for (int ni = 0; ni < 8; ++ni) {
          u32x2 pk = {pack2bf(acc[ni][mi][0], acc[ni][mi][1]), pack2bf(acc[ni][mi][2], acc[ni][mi][3])};
          *(u32x2*)(dst + (size_t)mrow[mi] * ld + col0 + wn * 128 + ni * 16 + lg * 4) = pk;
        }
    } else if (kind == 2) {
#pragma unroll
      for (int mi = 0; mi < 4; ++mi) {
        int b = mrow[mi] / TP, t = mrow[mi] - b * TP;
#pragma unroll
        for (int ni = 0; ni < 8; ++ni)
#pragma unroll
          for (int r = 0; r < 4; ++r) {
            int row = col0 + wn * 128 + ni * 16 + lg * 4 + r;
            dst[((size_t)(b * vrows + row)) * TP + t] = f2bf(acc[ni][mi][r]);
          }
      }
    }
  }
  {
    const int v = vblock(), first = NTILES % gridDim.x, nfree = gridDim.x - first;
    if (v >= first) {
      for (int s = v - first; s < 132; s += nfree) {
        const int mt = s;
        f32x4 acc[4][4];
        zero_acc<4, 4>(acc);
        gemm_kloop<4, 4>(p.hb + (size_t)(mt * 256) * DM, DM, W + (size_t)(13 * 256) * DM, DM, DM, acc, smem);
        if (wn == 0) {
#pragma unroll
          for (int mi = 0; mi < 4; ++mi) {
            const int m = mt * 256 + wm * 64 + mi * 16 + lm;
            const float rs = rsqrtf(rowss[m] * (1.f / DM) + EPS);
#pragma unroll
            for (int ni = 0; ni < 2; ++ni) {
              u32x2 pk = {pack2bf(acc[ni][mi][0] * rs, acc[ni][mi][1] * rs), pack2bf(acc[ni][mi][2] * rs, acc[ni][mi][3] * rs)};
              *(u32x2*)(p.kix + (size_t)m * 32 + ni * 16 + lg * 4) = pk;
            }
            if (lg < 2) {
              float4 w4 = make_float4(acc[2][mi][0] * rs, acc[2][mi][1] * rs, acc[2][mi][2] * rs, acc[2][mi][3] * rs);
              *(float4*)(p.wix + (size_t)m * 8 + lg * 4) = w4;
            }
          }
        }
      }
    }
  }
}

template <int MI, int NI>
DI void resid_epilogue(const Params& p, int from_x, const f32x4 (&acc)[NI][MI], int row0, int n0, float* rowss_next, bool last, int lm, int lg) {
#pragma unroll
  for (int mi = 0; mi < MI; ++mi) {
    const int m = row0 + mi * 16 + lm;
    const float* hr = hrow_r(p, from_x ? 0 : 1, m);
    float* hw = hrow_w(p, m);
    float ss = 0.f;
#pragma unroll
    for (int ni = 0; ni < NI; ++ni) {
      const int n = n0 + ni * 16 + lg * 4;
      float4 h = *(const float4*)(hr + n);
      h.x += acc[ni][mi][0]; h.y += acc[ni][mi][1]; h.z += acc[ni][mi][2]; h.w += acc[ni][mi][3];
      *(float4*)(hw + n) = h;
      if (!last) {
        u32x2 pk = {pack2bf(h.x, h.y), pack2bf(h.z, h.w)};
        *(u32x2*)(p.hb + (size_t)m * DM + n) = pk;
        ss += h.x * h.x + h.y * h.y + h.z * h.z + h.w * h.w;
      }
    }
    if (!last) {
      ss += __shfl_xor(ss, 16);
      ss += __shfl_xor(ss, 32);
      if (lg == 0) atomicAdd(rowss_next + m, ss);
    }
  }
}

DI void phase_resid(const Params& p, int from_x, const u16* A, int K, const u16* W, float* rowss_next, bool last,
                    unsigned char* smem) {
  int tid_ = threadIdx.x; asm volatile("" : "+v"(tid_));
  const int tid = tid_, lane = tid & 63, wave = tid >> 6, wm = wave >> 1, wn = wave & 1;
  const int lm = lane & 15, lg = lane >> 4;
  constexpr int NT = 4, NTILES = 132 * NT;
  const int nfull = (NTILES / (int)gridDim.x) * (int)gridDim.x;
  for (int it = vblock(); it < nfull; it += gridDim.x) {
    const int g = it / (4 * NT), rem = it - g * (4 * NT), nt = rem >> 2, mt = g * 4 + (rem & 3);
    f32x4 acc[8][4];
    zero_acc<4, 8>(acc);
    gemm_kloop<4, 8>(A + (size_t)(mt * 256) * K, K, W + (size_t)(nt * 256) * K, K, K, acc, smem);
    resid_epilogue<4, 8>(p, from_x, acc, mt * 256 + wm * 64, nt * 256 + wn * 128, rowss_next, last, lm, lg);
  }
  for (int s = vblock(); s < 4 * (NTILES - nfull); s += gridDim.x) {
    const int it = nfull + (s >> 2), hm = s & 1, hn = (s >> 1) & 1;
    const int g = it / (4 * NT), rem = it - g * (4 * NT), nt = rem >> 2, mt = g * 4 + (rem & 3);
    f32x4 acc[4][2];
    zero_acc<2, 4>(acc);
    gemm_kloop<2, 4>(A + (size_t)(mt * 256 + hm * 128) * K, K, W + (size_t)(nt * 256 + hn * 128) * K, K, K, acc, smem);
    resid_epilogue<2, 4>(p, from_x, acc, mt * 256 + hm * 128 + wm * 32, nt * 256 + hn * 128 + wn * 64, rowss_next, last, lm, lg);
  }
}

template <int MI>
DI void merge_tile(const Params& p, int layer, int rowbase, int nt, unsigned char* smem) {
  int tid_ = threadIdx.x; asm volatile("" : "+v"(tid_));
  const int tid = tid_, lane = tid & 63, wave = tid >> 6, wm = wave >> 1, wn = wave & 1;
  const int lm = lane & 15, lg = lane >> 4;
  const u16* WL = p.wts + (size_t)layer * LAYER_W;
  const float* rowss = p.rowss + (size_t)(2 * layer) * R;
  const float* bg = p.b_gate + layer * 3 * DM;
  u32 mp[4][MI][2];
#pragma unroll
  for (int ni = 0; ni < 4; ++ni)
#pragma unroll
    for (int mi = 0; mi < MI; ++mi) { mp[ni][mi][0] = 0u; mp[ni][mi][1] = 0u; }
#pragma unroll 1
  for (int br = 0; br < 3; ++br) {
    const u16* Y = br == 0 ? p.ysb : (br == 1 ? p.ysp : p.ydf);
    const int Kb = br == 2 ? 512 : 256;
    const u16* Wb = WL + (br == 0 ? OFF_BRSB : (br == 1 ? OFF_BRSP : OFF_BRDF));
    f32x4 acc[4][MI];
    zero_acc<MI, 4>(acc);
    gemm_kloop<MI, 4>(Y + (size_t)rowbase * Kb, Kb, Wb + (size_t)(nt * 128) * Kb, Kb, Kb, acc, smem);
    u32 brp[4][MI][2];
#pragma unroll
    for (int ni = 0; ni < 4; ++ni)
#pragma unroll
      for (int mi = 0; mi < MI; ++mi) {
        brp[ni][mi][0] = pack2bf(acc[ni][mi][0], acc[ni][mi][1]);
        brp[ni][mi][1] = pack2bf(acc[ni][mi][2], acc[ni][mi][3]);
      }
    zero_acc<MI, 4>(acc);
    gemm_kloop<MI, 4>(p.hb + (size_t)rowbase * DM, DM, WL + OFF_WG + (size_t)(br * 1024 + nt * 128) * DM, DM, DM, acc, smem);
    int m0 = rowbase + wm * 16 * MI + lm, n0 = nt * 128 + wn * 64 + lg * 4;
    asm volatile("" : "+v"(m0), "+v"(n0));
#pragma unroll
    for (int mi = 0; mi < MI; ++mi) {
      const float rs = rsqrtf(rowss[m0 + mi * 16] * (1.f / DM) + EPS);
#pragma unroll
      for (int ni = 0; ni < 4; ++ni) {
        const float4 b4 = *(const float4*)(bg + br * DM + n0 + ni * 16);
        const float bb[4] = {b4.x, b4.y, b4.z, b4.w};
        float mv[4];
#pragma unroll
        for (int r = 0; r < 4; ++r) {
          const float gv = acc[ni][mi][r] * rs + bb[r];
          const float sg = 1.f / (1.f + __expf(-gv));
          const u32 w = brp[ni][mi][r >> 1], mw = mp[ni][mi][r >> 1];
          const float bv = __uint_as_float((r & 1) ? (w & 0xffff0000u) : (w << 16));
          const float mo = __uint_as_float((r & 1) ? (mw & 0xffff0000u) : (mw << 16));
          mv[r] = mo + sg * bv;
        }
        mp[ni][mi][0] = pack2bf(mv[0], mv[1]);
        mp[ni][mi][1] = pack2bf(mv[2], mv[3]);
      }
    }
  }
  int m0 = rowbase + wm * 16 * MI + lm, n0 = nt * 128 + wn * 64 + lg * 4;
  asm volatile("" : "+v"(m0), "+v"(n0));
#pragma unroll
  for (int mi = 0; mi < MI; ++mi)
#pragma unroll
    for (int ni = 0; ni < 4; ++ni) {
      u32x2 pk = {mp[ni][mi][0], mp[ni][mi][1]};
      *(u32x2*)(p.merged + (size_t)(m0 + mi * 16) * DM + n0 + ni * 16) = pk;
    }
}

DI void phase_merge(const Params& p, int layer, unsigned char* smem) {
  constexpr int NT = 8, NTILES = 132 * NT;
  const int nfull = (NTILES / (int)gridDim.x) * (int)gridDim.x;
  for (int it = vblock(); it < nfull; it += gridDim.x) {
    const int g = it / (4 * NT), rem = it - g * (4 * NT), nt = rem >> 2, mt = g * 4 + (rem & 3);
    merge_tile<4>(p, layer, mt * 256, nt, smem);
  }
  for (int s = vblock(); s < 2 * (NTILES - nfull); s += gridDim.x) {
    const int it = nfull + (s >> 1), hf = s & 1;
    const int g = it / (4 * NT), rem = it - g * (4 * NT), nt = rem >> 2, mt = g * 4 + (rem & 3);
    merge_tile<2>(p, layer, mt * 256 + hf * 128, nt, smem);
  }
}

DI void phase_ffnup(const Params& p, int layer, unsigned char* smem) {
  int tid_ = threadIdx.x; asm volatile("" : "+v"(tid_));
  const int tid = tid_, lane = tid & 63, wave = tid >> 6, wm = wave >> 1, wn = wave & 1;
  const int lr = tid >> 3, lc = tid & 7, lm = lane & 15, lg = lane >> 4;
  const u16* W = p.wts + (size_t)layer * LAYER_W + OFF_UP;
  const float* rowss = p.rowss + (size_t)(2 * layer + 1) * R;
  const float* cw = p.conv_w + layer * 3 * DFF;
  const float* cb = p.conv_b + layer * DFF;
  constexpr int NT = 22, MT = 136, NTILES = MT * NT;
  float* G = (float*)smem;
  for (int it = vblock(); it < NTILES; it += gridDim.x) {
    const int g = it / (4 * NT), rem = it - g * (4 * NT), nt = rem >> 2, mt = g * 4 + (rem & 3);
    const int b = mt / 17, ti = mt - b * 17, tbase = 254 * ti - 2;
    f32x4 acc[8][4];
    zero_acc<4, 8>(acc);
    gemm_kloop<4, 8>(p.hb + ((ptrdiff_t)(b * TP + tbase)) * DM, DM, W + (size_t)(nt * 256) * DM, DM, DM, acc, smem);
    int r0 = wm * 64 + lm, gc0 = 64 * wn + 4 * lg;
    asm volatile("" : "+v"(r0), "+v"(gc0));
    int tt[4];
#pragma unroll
    for (int mi = 0; mi < 4; ++mi) {
      const int r = r0 + mi * 16;
      tt[mi] = tbase + r;
      float rs = (tt[mi] >= 0 && tt[mi] < TP) ? rsqrtf(rowss[b * TP + tt[mi]] * (1.f / DM) + EPS) : 0.f;
#pragma unroll
      for (int ni = 0; ni < 8; ++ni) acc[ni][mi] *= rs;
#pragma unroll
      for (int n2 = 0; n2 < 4; ++n2) {
        float4 g4 = make_float4(acc[2 * n2][mi][0], acc[2 * n2][mi][1], acc[2 * n2][mi][2], acc[2 * n2][mi][3]);
        *(float4*)(G + r * 132 + gc0 + 16 * n2) = g4;
      }
    }
    __syncthreads();
#pragma unroll
    for (int n2 = 0; n2 < 4; ++n2) {
      const int gc = gc0 + 16 * n2;
      const int ff = 128 * nt + gc;
      const float4 w0 = *(const float4*)(cw + ff), w1 = *(const float4*)(cw + DFF + ff), w2 = *(const float4*)(cw + 2 * DFF + ff);
      const float4 c4 = *(const float4*)(cb + ff);
#pragma unroll
      for (int mi = 0; mi < 4; ++mi) {
        const int r = r0 + mi * 16;
        if (r >= 2 && tt[mi] < TP) {
          const float4 g1 = *(const float4*)(G + (r - 1) * 132 + gc);
          const float4 g2 = *(const float4*)(G + (r - 2) * 132 + gc);
          float cv[4];
          cv[0] = c4.x + w0.x * g2.x + w1.x * g1.x + w2.x * acc[2 * n2][mi][0];
          cv[1] = c4.y + w0.y * g2.y + w1.y * g1.y + w2.y * acc[2 * n2][mi][1];
          cv[2] = c4.z + w0.z * g2.z + w1.z * g1.z + w2.z * acc[2 * n2][mi][2];
          cv[3] = c4.w + w0.w * g2.w + w1.w * g1.w + w2.w * acc[2 * n2][mi][3];
          float a[4];
#pragma unroll
          for (int e = 0; e < 4; ++e) a[e] = cv[e] / (1.f + __expf(-cv[e])) * acc[2 * n2 + 1][mi][e];
          u32x2 pk = {pack2bf(a[0], a[1]), pack2bf(a[2], a[3])};
          *(u32x2*)(p.act + (size_t)(b * TP + tt[mi]) * DFF + ff) = pk;
        }
      }
    }
    __syncthreads();
  }
}

DI int swap23(int k) { return (k & ~12) | ((k & 4) << 1) | ((k & 8) >> 1); }

DI void build_lut(const Params& p, int bias_head, unsigned char* smem, int tid) {
  float* lut = (float*)(smem + LUT_OFF);
  const int d = tid;
  if (d <= 128) {
    int bucket;
    if (d < 16) bucket = d;
    else {
      float nf = (float)d;
      int large = 16 + (int)(logf(nf / 16.f) / 2.0794415416798357f * 16.f);
      bucket = large < 31 ? large : 31;
    }
    lut[d] = p.rel_bias[bucket * 8 + bias_head] * LOG2E;
  }
}

template <int NCH>
DI void ld_tile_g(u32x4 (&r)[NCH], const u16* base, size_t rstride, int k0, bool is_vt, int tid) {
#pragma unroll
  for (int i = 0; i < NCH; ++i) {
    int id = tid + 256 * i, row = id >> 3, c = id & 7;
    const u16* s = is_vt ? base + (size_t)row * rstride + k0 + c * 8 : base + (size_t)(k0 + row) * rstride + c * 8;
    r[i] = *(const u32x4*)s;
  }
}
template <int NCH>
DI void st_tile_s(const u32x4 (&r)[NCH], unsigned char* dst, bool permute, int tid) {
#pragma unroll
  for (int i = 0; i < NCH; ++i) {
    int id = tid + 256 * i, row = id >> 3, c = id & 7;
    int rr = permute ? swap23(row) : row;
    *(u32x4*)(dst + rr * 144 + c * 16) = r[i];
  }
}

DI bf16x8 pack8(const f32x16& v, int s2) {
  u32x4 pk;
  if (s2 == 0) pk = u32x4{pack2bf(v[0], v[1]), pack2bf(v[2], v[3]), pack2bf(v[4], v[5]), pack2bf(v[6], v[7])};
  else pk = u32x4{pack2bf(v[8], v[9]), pack2bf(v[10], v[11]), pack2bf(v[12], v[13]), pack2bf(v[14], v[15])};
  return __builtin_bit_cast(bf16x8, pk);
}
DI f32x16 zero16() {
  f32x16 z;
#pragma unroll
  for (int i = 0; i < 16; ++i) z[i] = 0.f;
  return z;
}

DI void diff_map(const unsigned char* sk, const bf16x8 (&qf)[4], const unsigned char* sv, const float* lut, bool far,
                 bool diag, int ks0, int tq, int h, int lq, f32x16 (&O)[4], float& m, float& l) {
  const float csc = 0.125f * LOG2E;
  f32x16 S = zero16();
#pragma unroll
  for (int s = 0; s < 4; ++s) {
    bf16x8 kf = *(const bf16x8*)(sk + lq * 144 + (16 * s + 8 * h) * 2);
    S = mfma32(kf, qf[s], S);
  }
  if (far) {
    const float cbias = lut[128];
    float mx = fmaxf(fmaxf(S[0], S[1]), S[2]);
#pragma unroll
    for (int i = 3; i < 15; i += 2) mx = fmaxf(fmaxf(mx, S[i]), S[i + 1]);
    mx = fmaxf(mx, S[15]);
    mx = fmaxf(mx, __shfl_xor(mx, 32));
    const float mn = fmaxf(m, mx * csc + cbias);
    if (__any(mn > m)) {
      const float a = __builtin_amdgcn_exp2f(m - mn);
      l *= a; m = mn;
#pragma unroll
      for (int d = 0; d < 4; ++d) O[d] *= a;
    }
    const float off = cbias - m;
#pragma unroll
    for (int i = 0; i < 16; ++i) { float pv = __builtin_amdgcn_exp2f(S[i] * csc + off); l += pv; S[i] = pv; }
  } else {
    float mx = -1e30f;
#pragma unroll
    for (int i = 0; i < 16; ++i) {
      const int key = ks0 + 16 * (i >> 3) + 8 * h + (i & 7);
      int d = tq - key;
      const bool msk = diag && d < 0;
      d = d < 0 ? 0 : (d > 128 ? 128 : d);
      float x = S[i] * csc + lut[d];
      if (msk) x = -1e30f;
      S[i] = x;
      mx = fmaxf(mx, x);
    }
    mx = fmaxf(mx, __shfl_xor(mx, 32));
    const float mn = fmaxf(m, mx);
    if (__any(mn > m)) {
      const float a = __builtin_amdgcn_exp2f(m - mn);
      l *= a; m = mn;
#pragma unroll
      for (int d = 0; d < 4; ++d) O[d] *= a;
    }
#pragma unroll
    for (int i = 0; i < 16; ++i) { float pv = __builtin_amdgcn_exp2f(S[i] - m); l += pv; S[i] = pv; }
  }
  const bf16x8 p0 = pack8(S, 0), p1 = pack8(S, 1);
#pragma unroll
  for (int d = 0; d < 4; ++d) {
    bf16x8 v0 = *(const bf16x8*)(sv + (d * 32 + lq) * 144 + 16 * h);
    bf16x8 v1 = *(const bf16x8*)(sv + (d * 32 + lq) * 144 + 32 + 16 * h);
    O[d] = mfma32(v0, p0, O[d]);
    O[d] = mfma32(v1, p1, O[d]);
  }
}

DI void diff_map_far2(const unsigned char* sk, const bf16x8 (&qf)[4], const unsigned char* sv, float cbias, int h, int lq,
                      f32x16 (&O)[4], float& m, float& l) {
  const float csc = 0.125f * LOG2E;
  f32x16 S0 = zero16(), S1 = zero16();
#pragma unroll
  for (int s = 0; s < 4; ++s) {
    bf16x8 k0 = *(const bf16x8*)(sk + lq * 144 + (16 * s + 8 * h) * 2);
    bf16x8 k1 = *(const bf16x8*)(sk + (32 + lq) * 144 + (16 * s + 8 * h) * 2);
    S0 = mfma32(k0, qf[s], S0);
    S1 = mfma32(k1, qf[s], S1);
  }
  float mx = fmaxf(fmaxf(S0[0], S0[1]), S0[2]);
#pragma unroll
  for (int i = 3; i < 15; i += 2) mx = fmaxf(fmaxf(mx, S0[i]), S0[i + 1]);
  mx = fmaxf(mx, S0[15]);
#pragma unroll
  for (int i = 0; i < 16; i += 2) mx = fmaxf(fmaxf(mx, S1[i]), S1[i + 1]);
  mx = fmaxf(mx, __shfl_xor(mx, 32));
  const float mn = fmaxf(m, mx * csc + cbias);
  if (__any(mn > m)) {
    const float a = __builtin_amdgcn_exp2f(m - mn);
    l *= a; m = mn;
#pragma unroll
    for (int d = 0; d < 4; ++d) O[d] *= a;
  }
  const float off = cbias - m;
  float la = 0.f, lb = 0.f;
#pragma unroll
  for (int i = 0; i < 16; ++i) {
    float pa = __builtin_amdgcn_exp2f(S0[i] * csc + off), pb = __builtin_amdgcn_exp2f(S1[i] * csc + off);
    la += pa; lb += pb; S0[i] = pa; S1[i] = pb;
  }
  l += la + lb;
  const bf16x8 p0 = pack8(S0, 0), p1 = pack8(S0, 1), p2 = pack8(S1, 0), p3 = pack8(S1, 1);
#pragma unroll
  for (int d = 0; d < 4; ++d) {
    const unsigned char* vr = sv + (d * 32 + lq) * 144 + 16 * h;
    bf16x8 v0 = *(const bf16x8*)(vr), v1 = *(const bf16x8*)(vr + 32), v2 = *(const bf16x8*)(vr + 64), v3 = *(const bf16x8*)(vr + 96);
    O[d] = mfma32(v0, p0, O[d]);
    O[d] = mfma32(v1, p1, O[d]);
    O[d] = mfma32(v2, p2, O[d]);
    O[d] = mfma32(v3, p3, O[d]);
  }
}

DI void diff_job8(const Params& p, int layer, int b, int head, int qb, unsigned char* smem) {
  int tid_ = threadIdx.x; asm volatile("" : "+v"(tid_));
  const int tid = tid_, lane = tid & 63, wave = tid >> 6, h = lane >> 5, lq = lane & 31;
  const int map = wave >> 2, qg = wave & 3;
  const int t0 = qb * 128, tw0 = t0 + 32 * qg, tq = tw0 + lq;
  const float* lut = (const float*)(smem + LUT_OFF);
  build_lut(p, 4 + head, smem, tid);
  bf16x8 qf[4];
  {
    const u16* qr = p.qdf + (size_t)(b * TP + tq) * 512 + head * 128 + 64 * map + 8 * h;
#pragma unroll
    for (int s = 0; s < 4; ++s) qf[s] = *(const bf16x8*)(qr + 16 * s);
  }
  f32x16 O[4];
#pragma unroll
  for (int i = 0; i < 4; ++i) O[i] = zero16();
  float m = -1e30f, l = 0.f;
  const u16* K1 = p.kdf + (size_t)b * TP * 512 + head * 128;
  const u16* VT = p.vtdf + (size_t)(b * 512 + head * 128) * TP;
  const int ntile = 2 * (qb + 1);
  const int krow = tid >> 3, kc = tid & 7, krs = swap23(krow);
  u32x4 rk1, rk2, rv[2];
  auto gl = [&](int k0) {
    const u16* s = K1 + (size_t)(k0 + krow) * 512 + kc * 8;
    rk1 = *(const u32x4*)s; rk2 = *(const u32x4*)(s + 64);
#pragma unroll
    for (int i = 0; i < 2; ++i) rv[i] = *(const u32x4*)(VT + (size_t)(krow + 64 * i) * TP + k0 + kc * 8);
  };
  auto sl = [&](unsigned char* d) {
    *(u32x4*)(d + krs * 144 + kc * 16) = rk1;
    *(u32x4*)(d + 9216 + krs * 144 + kc * 16) = rk2;
#pragma unroll
    for (int i = 0; i < 2; ++i) *(u32x4*)(d + 18432 + (krow + 64 * i) * 144 + kc * 16) = rv[i];
  };
  gl(0); sl(smem);
  if (ntile > 1) gl(64);
  __syncthreads();
  const float cbias = lut[128];
  for (int j = 0; j < ntile; ++j) {
    __syncthreads();
    if (j + 1 < ntile) { sl(smem + ((j + 1) & 1) * 36864); if (j + 2 < ntile) gl((j + 2) * 64); }
    const unsigned char* sb = smem + (j & 1) * 36864;
    const unsigned char* sk = sb + 9216 * map;
    const int k0 = j * 64;
    if (tw0 - (k0 + 63) >= 113) {
      diff_map_far2(sk, qf, sb + 18432, cbias, h, lq, O, m, l);
    } else {
#pragma unroll 1
      for (int sub = 0; sub < 2; ++sub) {
        const int ks0 = k0 + sub * 32;
        if (ks0 > tw0 + 31) break;
        const bool far = (tw0 - (ks0 + 31)) >= 113;
        const bool diag = (ks0 + 31) > tw0;
        diff_map(sk + sub * 32 * 144, qf, sb + 18432 + sub * 64, lut, far, diag, ks0, tq, h, lq, O, m, l);
      }
    }
  }
  __syncthreads();
  float lam;
  const float lam_init = 0.8f - 0.6f * expf(-0.3f * (float)layer);
  {
    float a = p.lq1[layer * 64 + lane] * p.lk1[layer * 64 + lane];
    float c = p.lq2[layer * 64 + lane] * p.lk2[layer * 64 + lane];
    a = wave_sum(a); c = wave_sum(c);
    lam = expf(a) - expf(c) + lam_init;
  }
  l += __shfl_xor(l, 32);
  const float il = (map ? lam : 1.f) / l;
  float* X = (float*)smem + (size_t)(qg * 32 + lq) * 132;
  if (map == 1) {
#pragma unroll
    for (int d = 0; d < 4; ++d)
#pragma unroll
      for (int g = 0; g < 4; ++g) {
        float4 v = make_float4(O[d][4 * g] * il, O[d][4 * g + 1] * il, O[d][4 * g + 2] * il, O[d][4 * g + 3] * il);
        *(float4*)(X + 32 * d + 8 * g + 4 * h) = v;
      }
  }
  __syncthreads();
  if (map == 0) {
    float ss = 0.f;
#pragma unroll
    for (int d = 0; d < 4; ++d)
#pragma unroll
      for (int g = 0; g < 4; ++g) {
        const float4 v = *(const float4*)(X + 32 * d + 8 * g + 4 * h);
        float y0 = O[d][4 * g] * il - v.x, y1 = O[d][4 * g + 1] * il - v.y, y2 = O[d][4 * g + 2] * il - v.z, y3 = O[d][4 * g + 3] * il - v.w;
        O[d][4 * g] = y0; O[d][4 * g + 1] = y1; O[d][4 * g + 2] = y2; O[d][4 * g + 3] = y3;
        ss += y0 * y0 + y1 * y1 + y2 * y2 + y3 * y3;
      }
    ss += __shfl_xor(ss, 32);
    const float sc = rsqrtf(ss * (1.f / 128.f) + EPS) * (1.f - lam_init);
    const float* sg = p.subln + layer * 128;
    u16* yr = p.ydf + (size_t)(b * TP + tq) * 512 + head * 128;
#pragma unroll
    for (int d = 0; d < 4; ++d)
#pragma unroll
      for (int g = 0; g < 4; ++g) {
        const int dv = 32 * d + 8 * g + 4 * h;
        const float4 g4 = *(const float4*)(sg + dv);
        u32x2 pk = {pack2bf(O[d][4 * g] * sc * g4.x, O[d][4 * g + 1] * sc * g4.y),
                    pack2bf(O[d][4 * g + 2] * sc * g4.z, O[d][4 * g + 3] * sc * g4.w)};
        *(u32x2*)(yr + dv) = pk;
      }
  }
  __syncthreads();
}

DI void sparse_job(const Params& p, int layer, int b, int head, int qb, unsigned char* smem) {
  int tid_ = threadIdx.x & 255; asm volatile("" : "+v"(tid_));
  const int tid = tid_, lane = tid & 63, wave = tid >> 6, h = lane >> 5, lq = lane & 31;
  const int t0 = qb * 128, tw0 = t0 + 32 * wave, tq = tw0 + lq;
  const float* lut = (const float*)(smem + LUT_OFF);
  build_lut(p, head, smem, tid);
  bf16x8 qf[4];
  {
    const u16* qr = p.qsp + (size_t)(b * TP + tq) * 256 + head * 64 + 8 * h;
#pragma unroll
    for (int s = 0; s < 4; ++s) qf[s] = *(const bf16x8*)(qr + 16 * s);
  }
  f32x16 O[2] = {zero16(), zero16()};
  float m = -1e30f, l = 0.f;
  const u16* Kp = p.ksp + (size_t)b * TP * 256 + head * 64;
  const u16* VT = p.vtsp + (size_t)(b * 256 + head * 64) * TP;
  const u32* mrow = p.mask + (size_t)(b * TP + tq) * MW;
  const int ntile = 2 * (qb + 1);
  const float csc = 0.125f * LOG2E;
  u32x4 rk[2], rv[2];
  ld_tile_g<2>(rk, Kp, 256, 0, false, tid); ld_tile_g<2>(rv, VT, TP, 0, true, tid);
  u32x2 mnext = *(const u32x2*)(mrow);
  st_tile_s<2>(rk, smem, true, tid); st_tile_s<2>(rv, smem + 9216, false, tid);
  if (ntile > 1) { ld_tile_g<2>(rk, Kp, 256, 64, false, tid); ld_tile_g<2>(rv, VT, TP, 64, true, tid); }
  for (int j = 0; j < ntile; ++j) {
    const bool more = j + 1 < ntile;
    const u32x2 mcur = mnext;
    __syncthreads();
    if (more) {
      unsigned char* d = smem + ((j + 1) & 1) * 18432; st_tile_s<2>(rk, d, true, tid); st_tile_s<2>(rv, d + 9216, false, tid);
      mnext = *(const u32x2*)(mrow + 2 * (j + 1));
      if (j + 2 < ntile) { const int k0 = (j + 2) * 64; ld_tile_g<2>(rk, Kp, 256, k0, false, tid); ld_tile_g<2>(rv, VT, TP, k0, true, tid); }
    }
    const unsigned char* sb = smem + (j & 1) * 18432;
#pragma unroll 1
    for (int sub = 0; sub < 2; ++sub) {
      const int ks0 = j * 64 + sub * 32;
      if (ks0 > tw0 + 31) break;
      const u32 mw = sub ? mcur[1] : mcur[0];
      if (!__any(mw != 0u)) continue;
      f32x16 S = zero16();
#pragma unroll
      for (int s = 0; s < 4; ++s) {
        bf16x8 k1 = *(const bf16x8*)(sb + (sub * 32 + lq) * 144 + (16 * s + 8 * h) * 2);
        S = mfma32(k1, qf[s], S);
      }
      const bool far = (tw0 - (ks0 + 31)) >= 113;
      const float cbias = lut[128];
      const u32 sel16 = ((mw >> (8 * h)) & 0xffu) | (((mw >> (16 + 8 * h)) & 0xffu) << 8);
      if (far) {
        float mx = -1e30f;
#pragma unroll
        for (int i = 0; i < 16; ++i) mx = fmaxf(mx, (sel16 & (1u << i)) ? S[i] : -1e30f);
        mx = fmaxf(mx, __shfl_xor(mx, 32));
        const float mn = mx > -1e29f ? fmaxf(m, mx * csc + cbias) : m;
        if (__any(mn > m)) {
          const float a = __builtin_amdgcn_exp2f(m - mn);
          l *= a; O[0] *= a; O[1] *= a;
          m = mn;
        }
        const float off = cbias - m;
#pragma unroll
        for (int i = 0; i < 16; ++i) {
          float pv = (sel16 & (1u << i)) ? __builtin_amdgcn_exp2f(S[i] * csc + off) : 0.f;
          l += pv;
          S[i] = pv;
        }
      } else {
        float mx = -1e30f;
#pragma unroll
        for (int i = 0; i < 16; ++i) {
          const int ko = 16 * (i >> 3) + 8 * h + (i & 7);
          int d = tq - (ks0 + ko); d = d < 0 ? 0 : (d > 128 ? 128 : d);
          float x = S[i] * csc + lut[d];
          if (!(sel16 & (1u << i))) x = -1e30f;
          S[i] = x;
          mx = fmaxf(mx, x);
        }
        mx = fmaxf(mx, __shfl_xor(mx, 32));
        const float mn = fmaxf(m, mx);
        if (__any(mn > m)) {
          const float a = __builtin_amdgcn_exp2f(m - mn);
          l *= a; O[0] *= a; O[1] *= a;
          m = mn;
        }
#pragma unroll
        for (int i = 0; i < 16; ++i) {
          float pv = S[i] > -1e29f ? __builtin_amdgcn_exp2f(S[i] - m) : 0.f;
          l += pv;
          S[i] = pv;
        }
      }
      bf16x8 pa0 = pack8(S, 0), pa1 = pack8(S, 1);
#pragma unroll
      for (int d = 0; d < 2; ++d) {
        bf16x8 v0 = *(const bf16x8*)(sb + 9216 + (d * 32 + lq) * 144 + (sub * 32 + 8 * h) * 2);
        bf16x8 v1 = *(const bf16x8*)(sb + 9216 + (d * 32 + lq) * 144 + (sub * 32 + 16 + 8 * h) * 2);
        O[d] = mfma32(v0, pa0, O[d]);
        O[d] = mfma32(v1, pa1, O[d]);
      }
    }
  }
  __syncthreads();
  l += __shfl_xor(l, 32);
  const float il = 1.f / l;
  u16* yr = p.ysp + (size_t)(b * TP + tq) * 256 + head * 64;
#pragma unroll
  for (int d = 0; d < 2; ++d)
#pragma unroll
    for (int g = 0; g < 4; ++g) {
      u32x2 pk = {pack2bf(O[d][4 * g] * il, O[d][4 * g + 1] * il), pack2bf(O[d][4 * g + 2] * il, O[d][4 * g + 3] * il)};
      *(u32x2*)(yr + 32 * d + 8 * g + 4 * h) = pk;
    }
  __syncthreads();
}

DI void sb_job(const Params& p, int b, int head, int qb, unsigned char* smem) {
  int tid_ = threadIdx.x & 255; asm volatile("" : "+v"(tid_));
  const int tid = tid_, lane = tid & 63, wave = tid >> 6, h = lane >> 5, lq = lane & 31;
  const int t0 = qb * 128, tw0 = t0 + 32 * wave, tq = tw0 + lq;
  bf16x8 qf[4];
  {
    const u16* qr = p.qsb + (size_t)(b * TP + tq) * 256 + head * 64 + 8 * h;
#pragma unroll
    for (int s = 0; s < 4; ++s) qf[s] = *(const bf16x8*)(qr + 16 * s);
  }
  f32x16 O[2] = {zero16(), zero16()};
  float carry = 0.f;
  const u16* Kp = p.ksb + (size_t)b * TP * 256 + head * 64;
  const u16* VT = p.vtsb + (size_t)(b * 256 + head * 64) * TP;
  const int ntile = 2 * (qb + 1);
  u32x4 rk[2], rv[2];
  ld_tile_g<2>(rk, Kp, 256, (ntile - 1) * 64, false, tid); ld_tile_g<2>(rv, VT, TP, (ntile - 1) * 64, true, tid);
  st_tile_s<2>(rk, smem, true, tid); st_tile_s<2>(rv, smem + 9216, false, tid);
  __syncthreads();
  for (int jj = 0; jj < ntile; ++jj) {
    const int j = ntile - 1 - jj;
    const bool more = jj + 1 < ntile;
    if (more) { const int k0 = (j - 1) * 64; ld_tile_g<2>(rk, Kp, 256, k0, false, tid); ld_tile_g<2>(rv, VT, TP, k0, true, tid); }
    __builtin_amdgcn_sched_barrier(0);
    const unsigned char* sb = smem + (jj & 1) * 18432;
    const bool wdone = !__any(carry >= -104.f);
    if (!wdone) {
#pragma unroll 1
      for (int sub = 1; sub >= 0; --sub) {
        const int ks0 = j * 64 + sub * 32;
        if (ks0 > tw0) continue;
        f32x16 S = zero16();
#pragma unroll
        for (int s = 0; s < 4; ++s) {
          bf16x8 k1 = *(const bf16x8*)(sb + (sub * 32 + lq) * 144 + (16 * s + 8 * h) * 2);
          S = mfma32(k1, qf[s], S);
        }
        const bool diag = (ks0 + 31) >= tw0;
        float lsm[16];
        float sA = 0.f, sB = 0.f;
#pragma unroll
        for (int i = 0; i < 16; ++i) {
          const int key = ks0 + 16 * (i >> 3) + 8 * h + (i & 7);
          const float z = S[i] * 0.125f;
          const float sp = fmaxf(z, 0.f) + __logf(1.f + __expf(-fabsf(z)));
          const bool valid = !diag || key < tq;
          lsm[i] = valid ? -sp : 0.f;
          S[i] = valid ? z - sp : -1e30f;
          if (i < 8) sA += lsm[i]; else sB += lsm[i];
        }
        const float oA = __shfl_xor(sA, 32), oB = __shfl_xor(sB, 32);
        const float aboveB = h == 0 ? oB : 0.f;
        const float aboveA = h == 0 ? (oA + sB + oB) : (oB + sB);
        float run = carry + aboveB;
#pragma unroll
        for (int i = 15; i >= 8; --i) { float lw = S[i] + run; run += lsm[i]; S[i] = lw > -1e29f ? __expf(lw) : 0.f; }
        run = carry + aboveA;
#pragma unroll
        for (int i = 7; i >= 0; --i) { float lw = S[i] + run; run += lsm[i]; S[i] = lw > -1e29f ? __expf(lw) : 0.f; }
        carry += sA + sB + oA + oB;
        bf16x8 pa0 = pack8(S, 0), pa1 = pack8(S, 1);
#pragma unroll
        for (int d = 0; d < 2; ++d) {
          bf16x8 v0 = *(const bf16x8*)(sb + 9216 + (d * 32 + lq) * 144 + (sub * 32 + 8 * h) * 2);
          bf16x8 v1 = *(const bf16x8*)(sb + 9216 + (d * 32 + lq) * 144 + (sub * 32 + 16 + 8 * h) * 2);
          O[d] = mfma32(v0, pa0, O[d]);
          O[d] = mfma32(v1, pa1, O[d]);
        }
      }
    }
    if (more) { unsigned char* d = smem + ((jj + 1) & 1) * 18432; st_tile_s<2>(rk, d, true, tid); st_tile_s<2>(rv, d + 9216, false, tid); }
    const int alldone = __syncthreads_and((int)(!__any(carry >= -104.f)));
    if (alldone) break;
  }
  u16* yr = p.ysb + (size_t)(b * TP + tq) * 256 + head * 64;
#pragma unroll
  for (int d = 0; d < 2; ++d)
#pragma unroll
    for (int g = 0; g < 4; ++g) {
      u32x2 pk = {pack2bf(O[d][4 * g], O[d][4 * g + 1]), pack2bf(O[d][4 * g + 2], O[d][4 * g + 3])};
      *(u32x2*)(yr + 32 * d + 8 * g + 4 * h) = pk;
    }
  __syncthreads();
}

DI void idx_scan(const u32* hq, int need, u32* outbin, u32* outneed, int q, int lane) {
  u32 c = 0;
#pragma unroll
  for (int w = 0; w < 8; ++w) { u32 v = hq[8 * lane + w]; c += (v & 0xffffu) + (v >> 16); }
  u32 incl = c;
#pragma unroll
  for (int o = 1; o < 64; o <<= 1) { u32 v = __shfl_down(incl, o); if (lane + o < 64) incl += v; }
  const u32 above = incl - c;
  if ((int)above < need && need <= (int)incl) {
    u32 cum = above;
    for (int bin = 16 * lane + 15; bin >= 16 * lane; --bin) {
      u32 cnt = (hq[bin >> 1] >> ((bin & 1) * 16)) & 0xffffu;
      if ((int)(cum + cnt) >= need) { outbin[q] = (u32)bin; outneed[q] = (u32)need - cum; break; }
      cum += cnt;
    }
  }
}

template <int PASS, bool DIAG>
DI void idx_tile(const bf16x8 kf, const bf16x8 (&qf)[8], const float (&wq)[8], int kt, int lm, int lg, int tq, bool selall, u32 bA, u32 pfx,
                 u32* hist, u32* maskw, u32* cand, u32* ccnt) {
  const f32x4 z4 = {0.f, 0.f, 0.f, 0.f};
  f32x4 sc = z4;
#pragma unroll
  for (int j = 0; j < 8; ++j) {
    f32x4 d = mfma16(kf, qf[j], z4);
#pragma unroll
    for (int r = 0; r < 4; ++r) sc[r] += wq[j] * fmaxf(d[r], 0.f);
  }
  u32 selbits = 0u;
#pragma unroll
  for (int r = 0; r < 4; ++r) {
    const int key = kt * 16 + lg * 4 + r;
    const bool valid = !DIAG || key <= tq;
    const u32 bits = __float_as_uint(sc[r]);
    const u32 u = bits ^ ((u32)((int)bits >> 31) | 0x80000000u);
    if (PASS == 0) {
      if (valid) { const u32 bin = u >> 22; atomicAdd(&hist[lm * 512 + (bin >> 1)], 1u << ((bin & 1) * 16)); }
    } else if (PASS == 1) {
      if (valid && (u >> 22) == bA) { const u32 bin = (u >> 12) & 1023u; atomicAdd(&hist[lm * 512 + (bin >> 1)], 1u << ((bin & 1) * 16)); }
    } else {
      const u32 pp = u >> 12;
      if (valid && (selall || pp > pfx)) selbits |= 1u << r;
      if (valid && !selall && pp == pfx) {
        const u32 ix = atomicAdd(&ccnt[lm], 1u);
        if (ix < 64u) { cand[(lm * 64 + ix) * 2] = u; cand[(lm * 64 + ix) * 2 + 1] = (u32)key; }
      }
    }
  }
  if (PASS == 2 && selbits) {
    const int kb = kt * 16 + lg * 4;
    atomicOr(&maskw[lm * MW + (kb >> 5)], selbits << (kb & 31));
  }
}
template <int PASS>
DI void idx_pass(const u16* kp, const bf16x8 (&qf)[8], const float (&wq)[8], int wave, int ntile, int lm, int lg, int tq, bool selall,
                 u32 bA, u32 pfx, u32* hist, u32* maskw, u32* cand, u32* ccnt) {
  auto ldk = [&](int t) { return *(const bf16x8*)(kp + (size_t)(t < ntile ? t : 0) * 512); };
  int kt = wave;
  bf16x8 ka = ldk(kt), kb = ldk(kt + 4);
  for (; kt + 4 < ntile - 1; kt += 8) {
    const bf16x8 kc = ldk(kt + 8), kd = ldk(kt + 12);
    idx_tile<PASS, false>(ka, qf, wq, kt, lm, lg, tq, selall, bA, pfx, hist, maskw, cand, ccnt);
    idx_tile<PASS, false>(kb, qf, wq, kt + 4, lm, lg, tq, selall, bA, pfx, hist, maskw, cand, ccnt);
    ka = kc; kb = kd;
  }
  if (kt < ntile - 1) { idx_tile<PASS, false>(ka, qf, wq, kt, lm, lg, tq, selall, bA, pfx, hist, maskw, cand, ccnt); kt += 4; ka = kb; }
  if (kt == ntile - 1) idx_tile<PASS, true>(ka, qf, wq, kt, lm, lg, tq, selall, bA, pfx, hist, maskw, cand, ccnt);
}

DI void idx_job(const Params& p, int b, int qg, unsigned char* smem) {
  int tid_ = threadIdx.x & 255; asm volatile("" : "+v"(tid_));
  const int tid = tid_, lane = tid & 63, wave = tid >> 6, lm = lane & 15, lg = lane >> 4;
  u32* hist = (u32*)smem;
  u32* maskw = (u32*)(smem + 32768);
  u32* cand = (u32*)(smem + 41216);
  u32* ccnt = (u32*)(smem + 49408);
  u32* binA = ccnt + 16; u32* needB = ccnt + 32; u32* binB = ccnt + 48; u32* needC = ccnt + 64;
  const int t0 = qg * 16, ntile = qg + 1, tq = t0 + lm;
  const bool selall = tq + 1 <= 256;
  bf16x8 qf[8];
  float wq[8];
  {
    const u16* qr = p.qix + (size_t)(b * TP + tq) * 256 + lg * 8;
    const float* wr = p.wix + (size_t)(b * TP + tq) * 8;
#pragma unroll
    for (int j = 0; j < 8; ++j) { qf[j] = *(const bf16x8*)(qr + j * 32); wq[j] = wr[j]; }
  }
  for (int i = tid; i < 8192 + 2112; i += 256) hist[i] = 0u;
  if (tid < 80) ccnt[tid] = 0u;
  __syncthreads();
  const u16* kbase = p.kix + (size_t)b * TP * 32;
  const f32x4 z4 = {0.f, 0.f, 0.f, 0.f};
  const u16* kp = kbase + (size_t)lm * 32 + lg * 8;
  idx_pass<0>(kp, qf, wq, wave, ntile, lm, lg, tq, selall, 0u, 0u, hist, maskw, cand, ccnt);
  __syncthreads();
  for (int qq = 0; qq < 4; ++qq) idx_scan(hist + (wave * 4 + qq) * 512, 256, binA, needB, wave * 4 + qq, lane);
  __syncthreads();
  for (int i = tid; i < 8192; i += 256) hist[i] = 0u;
  __syncthreads();
  idx_pass<1>(kp, qf, wq, wave, ntile, lm, lg, tq, selall, binA[lm], 0u, hist, maskw, cand, ccnt);
  __syncthreads();
  for (int qq = 0; qq < 4; ++qq) idx_scan(hist + (wave * 4 + qq) * 512, (int)needB[wave * 4 + qq], binB, needC, wave * 4 + qq, lane);
  __syncthreads();
  idx_pass<2>(kp, qf, wq, wave, ntile, lm, lg, tq, selall, binA[lm], (binA[lm] << 10) | binB[lm], hist, maskw, cand, ccnt);
  __syncthreads();
  {
    const int q = tid >> 4, i0 = tid & 15;
    u32 cnt = ccnt[q]; if (cnt > 64u) cnt = 64u;
    const u32 need = needC[q];
    for (u32 c = i0; c < cnt; c += 16) {
      const u32 u = cand[(q * 64 + c) * 2], key = cand[(q * 64 + c) * 2 + 1];
      u32 rank = 0;
      for (u32 e = 0; e < cnt; ++e) {
        const u32 u2 = cand[(q * 64 + e) * 2], k2 = cand[(q * 64 + e) * 2 + 1];
        rank += (u2 > u || (u2 == u && k2 < key)) ? 1u : 0u;
      }
      if (rank < need) atomicOr(&maskw[q * MW + (key >> 5)], 1u << (key & 31));
    }
  }
  __syncthreads();
  for (int i = tid; i < 16 * MW; i += 256) p.mask[(size_t)(b * TP + t0) * MW + i] = maskw[i];
  __syncthreads();
}

DI int next_job(u32* ctr, unsigned char* smem) {
  int* sj = (int*)(smem + SJOB_OFF);
  __syncthreads();
  if (threadIdx.x == 0) *sj = (int)atomicAdd(ctr, 1u);
  __syncthreads();
  return *sj;
}

DI void phase_attn(const Params& p, int layer, int phase, unsigned char* smem) {
  u32* ctr = p.ctr + phase;
  for (;;) {
    const int jp = next_job(ctr, smem);
    if (jp >= 2640) break;
    if (jp < 1056) { const int qb = 32 - jp / 32, r = jp & 31; diff_job8(p, layer, r >> 2, r & 3, qb, smem); continue; }
    int half = threadIdx.x >> 8; asm volatile("" : "+v"(half));
    unsigned char* sm = smem + half * HALF_BYTES;
    const int job = 2 * (jp - 1056) + half;
    if (job < 2112) { idx_job(p, job & 7, 263 - (job >> 3), sm); }
    else { const int i = job - 2112; const int qb = 32 - i / 32, r = i & 31; sb_job(p, r >> 2, r & 3, qb, sm); }
  }
}
DI void phase_sparse(const Params& p, int layer, int phase, unsigned char* smem) {
  u32* ctr = p.ctr + phase;
  for (;;) {
    const int jp = next_job(ctr, smem);
    if (jp >= 528) break;
    int half = threadIdx.x >> 8; asm volatile("" : "+v"(half));
    unsigned char* sm = smem + half * HALF_BYTES;
    const int job = 2 * jp + half;
    const int qb = 32 - job / 32, r = job & 31;
    sparse_job(p, layer, r >> 2, r & 3, qb, sm);
  }
}

DI void run_phase(const Params& p, int ph, unsigned char* smem, int rep = 0) {
  if (ph == 0) { phase_prep(p, smem); return; }
  const int layer = (ph - 1) / 7, s = (ph - 1) % 7;
  const u16* WL = p.wts + (size_t)layer * LAYER_W;
  switch (s) {
    case 0: phase_g1(p, layer, smem); break;
    case 1: phase_attn(p, layer, ph + 16 * rep, smem); break;
    case 2: phase_sparse(p, layer, ph + 16 * rep, smem); break;
    case 3: phase_merge(p, layer, smem); break;
    case 4: phase_resid(p, layer == 0 ? 1 : 0, p.merged, DM, WL + OFF_OUT, p.rowss + (size_t)(2 * layer + 1) * R, false, smem); break;
    case 5: phase_ffnup(p, layer, smem); break;
    default: phase_resid(p, 0, p.act, DFF, WL + OFF_DOWN, p.rowss + (size_t)(2 * layer + 2) * R, layer == 1, smem); break;
  }
}


#define XB_TMO      128
#define XB_XCNT(j)  (256  + 64 * (j))
#define XB_XSUB(j)  (1280 + 64 * (j))
#define XB_XGEN(j)  (2304 + 64 * (j))
#define XB_TOP      3328
#define XB_TOPGEN   3392
#define XCD_BAR_WORDS 3456
#define XB_SPIN_CAP (1u << 20)
#define LAS __attribute__((address_space(3)))
DI unsigned xb_ld(unsigned* p) { return __hip_atomic_load(p, __ATOMIC_RELAXED, __HIP_MEMORY_SCOPE_AGENT); }
DI unsigned xb_add(unsigned* p, unsigned v) { return __hip_atomic_fetch_add(p, v, __ATOMIC_RELAXED, __HIP_MEMORY_SCOPE_AGENT); }
DI unsigned xb_xcc_id() { return (unsigned)__builtin_amdgcn_s_getreg((3 << 11) | 20) & 0xFu; }
#define XB_SPIN(cond, bar) do { unsigned _sp = 0; while (cond) { __builtin_amdgcn_s_sleep(1); \
    if ((++_sp & 255u) == 0u) { if (xb_ld(&(bar)[XB_TMO])) break; if (_sp > XB_SPIN_CAP) { atomicAdd(&(bar)[XB_TMO], 1u); break; } } } } while (0)
struct XcdBarrier { unsigned* bar; unsigned x; volatile LAS unsigned* st; };
DI XcdBarrier xcd_barrier_post(unsigned* bar, volatile LAS unsigned* st) {
  XcdBarrier b; b.bar = bar; b.x = xb_xcc_id(); b.st = st;
  if (threadIdx.x == 0) (void)xb_add(&bar[XB_XCNT(b.x)], 1u);
  return b;
}
DI void xcd_barrier_complete(unsigned* bar, unsigned x, unsigned& nloc, unsigned& nx) {
  const unsigned G = gridDim.x * gridDim.y * gridDim.z;
  unsigned sum, cnt, mine, sp = 0u;
  for (;;) {
    sum = 0u; cnt = 0u; mine = 0u;
#pragma unroll
    for (unsigned j = 0; j < 16; ++j) { const unsigned c = xb_ld(&bar[XB_XCNT(j)]); sum += c; cnt += (c > 0u) ? 1u : 0u; mine = (j == x) ? c : mine; }
    if (sum == G) break;
    __builtin_amdgcn_s_sleep(1);
    if ((++sp & 255u) == 0u) { if (xb_ld(&bar[XB_TMO])) break; if (sp > XB_SPIN_CAP) { atomicAdd(&bar[XB_TMO], 1u); break; } }
  }
  nloc = mine > 0u ? mine : 1u; nx = cnt > 0u ? cnt : 1u;
}
DI void xcd_barrier(const XcdBarrier& b) {
  asm volatile("s_waitcnt vmcnt(0)" ::: "memory");
  __syncthreads();
  if (threadIdx.x == 0) {
    unsigned* bar = b.bar;
    __builtin_amdgcn_s_waitcnt(0);
    unsigned nloc = b.st[0], nx = b.st[1];
    if (nloc == 0u) { xcd_barrier_complete(bar, b.x, nloc, nx); b.st[0] = nloc; b.st[1] = nx; }
    const unsigned old = xb_add(&bar[XB_XSUB(b.x)], 1u);
    const unsigned gen = old / nloc;
    if (old + 1u == (gen + 1u) * nloc) {
      __builtin_amdgcn_fence(__ATOMIC_RELEASE, "agent");
      asm volatile("s_waitcnt vmcnt(0)" ::: "memory");
      const unsigned og = xb_add(&bar[XB_TOP], 1u);
      const unsigned tg = og / nx;
      if (og + 1u == (tg + 1u) * nx) xb_add(&bar[XB_TOPGEN], 1u);
      else XB_SPIN(xb_ld(&bar[XB_TOPGEN]) == tg, bar);
      __builtin_amdgcn_fence(__ATOMIC_ACQUIRE, "agent");
      xb_add(&bar[XB_XGEN(b.x)], 1u);
      asm volatile("s_waitcnt vmcnt(0)" ::: "memory");
    } else {
      XB_SPIN(xb_ld(&bar[XB_XGEN(b.x)]) == gen, bar);
      __builtin_amdgcn_fence(__ATOMIC_ACQUIRE, "agent");
      asm volatile("s_waitcnt vmcnt(0)" ::: "memory");
    }
  }
  __syncthreads();
}

constexpr int NPHASE = 15;

__global__ void __launch_bounds__(512) mega(Params p, int ph_lo, int ph_hi) {
  __shared__ __attribute__((aligned(16))) unsigned char smem[SMEM_BYTES];
  volatile LAS unsigned* xst = (volatile LAS unsigned*)(smem + (SMEM_BYTES - 16));
  if (threadIdx.x == 0) { xst[0] = 0u; xst[1] = 0u; }
  __syncthreads();
  const XcdBarrier xb = xcd_barrier_post(p.bar, xst);
  for (int ph = ph_lo; ph < ph_hi; ++ph) {
    run_phase(p, ph, smem);
#ifdef PROBE_MASK
    if (ph > 0 && ((PROBE_MASK >> ((ph - 1) % 7)) & 1)) { cg::this_grid().sync(); run_phase(p, ph, smem, 1); }
#endif
    if (ph + 1 < ph_hi) { if (ph_hi > 1000) cg::this_grid().sync(); else xcd_barrier(xb); }
  }
}

extern "C" void kernel_launch(void* const* d_in, const int* in_sizes, int n_in, void* d_out, int out_size, void* d_ws,
                              size_t ws_size, hipStream_t stream) {
  Params p{};
  const float* const* in = (const float* const*)d_in;
  p.x = in[0]; p.meta = in[1]; p.rel_bias = in[2]; p.attn_norm = in[3]; p.w_in = in[4]; p.b_gate = in[5];
  p.qn_sp = in[6]; p.kn_sp = in[7]; p.qn_df = in[8]; p.kn_df = in[9]; p.lq1 = in[10]; p.lk1 = in[11]; p.lq2 = in[12];
  p.lk2 = in[13]; p.subln = in[14]; p.w_br_sb = in[15]; p.w_br_sp = in[16]; p.w_br_df = in[17]; p.w_out = in[18];
  p.ffn_norm = in[19]; p.w_up = in[20]; p.conv_w = in[21]; p.conv_b = in[22]; p.w_down = in[23];
  p.out = (float*)d_out;
  unsigned char* w = (unsigned char*)d_ws;
  size_t off = 0;
  auto take = [&](size_t bytes) { unsigned char* r = w + off; off += (bytes + 255) & ~(size_t)255; return r; };
  p.ctr = (u32*)take(256);
  p.bar = (u32*)take((size_t)XCD_BAR_WORDS * 4);
  p.hb = (u16*)take((size_t)(R + 512) * DM * 2) + (size_t)256 * DM;
  p.rowss = (float*)take((size_t)4 * R * 4);
  p.side = (float*)take((size_t)NB * 128 * DM * 4);
  p.wts = (u16*)take((size_t)2 * LAYER_W * 2);
  p.mask = (u32*)take((size_t)R * MW * 4);
  unsigned char* region = w + off;
  p.qsb = (u16*)take((size_t)R * 256 * 2); p.ksb = (u16*)take((size_t)R * 256 * 2);
  p.qsp = (u16*)take((size_t)R * 256 * 2); p.ksp = (u16*)take((size_t)R * 256 * 2);
  p.qdf = (u16*)take((size_t)R * 512 * 2); p.kdf = (u16*)take((size_t)R * 512 * 2);
  p.vtsb = (u16*)take((size_t)R * 256 * 2); p.vtsp = (u16*)take((size_t)R * 256 * 2); p.vtdf = (u16*)take((size_t)R * 512 * 2);
  p.qix = (u16*)take((size_t)R * 256 * 2); p.kix = (u16*)take((size_t)R * 32 * 2); p.wix = (float*)take((size_t)R * 8 * 4);
  p.ysb = (u16*)take((size_t)R * 256 * 2); p.ysp = (u16*)take((size_t)R * 256 * 2); p.ydf = (u16*)take((size_t)R * 512 * 2);
  p.merged = (u16*)region;
  p.act = (u16*)region;
  if (off > ws_size) { fprintf(stderr, "workspace too small: need %zu have %zu\n", off, ws_size); return; }
#if FUSED
  static int grid_blocks = 0;
  if (!grid_blocks) {
    int dev = 0, cus = 0, per_cu = 0;
    hipGetDevice(&dev);
    hipDeviceGetAttribute(&cus, hipDeviceAttributeMultiprocessorCount, dev);
    hipOccupancyMaxActiveBlocksPerMultiprocessor(&per_cu, mega, 512, 0);
    if (per_cu > 1) per_cu = 1;
    grid_blocks = cus * per_cu;
  }
  int lo = 0, hi = NPHASE;
  (void)hipMemsetAsync(p.bar, 0, (size_t)XCD_BAR_WORDS * 4, stream);
  void* args[] = {&p, &lo, &hi};
  hipError_t e = hipLaunchCooperativeKernel((void*)mega, dim3(grid_blocks), dim3(512), args, 0, stream);
  if (e != hipSuccess) fprintf(stderr, "cooperative launch failed: %s (grid %d)\n", hipGetErrorString(e), grid_blocks);
#else
  for (int ph = 0; ph < NPHASE; ++ph) mega<<<256, 512, 0, stream>>>(p, ph, ph + 1);
#endif
}
```

```cpp
#include <hip/hip_runtime.h>
#include <hip/hip_cooperative_groups.h>
#include <cstdio>
namespace cg = cooperative_groups;

#ifndef FUSED
#define FUSED 1
#endif

#define DI __device__ __forceinline__
typedef unsigned short u16;
typedef unsigned int u32;
using bf16x8 = __attribute__((ext_vector_type(8))) short;
using f32x4 = __attribute__((ext_vector_type(4))) float;
using f32x16 = __attribute__((ext_vector_type(16))) float;
using u32x4 = __attribute__((ext_vector_type(4))) unsigned;
using u32x2 = __attribute__((ext_vector_type(2))) unsigned;
typedef __bf16 bf2_t __attribute__((ext_vector_type(2)));
typedef float f2_t __attribute__((ext_vector_type(2)));

constexpr int NB = 8, SEQ = 4096, DM = 1024, TP = 4224, TREAL = 4112, NMETA = 16, R = NB * TP;
constexpr int DFF = 2816, DIN = 6440, MW = 132;
constexpr float EPS = 1e-6f;
constexpr float LOG2E = 1.4426950408889634f;
constexpr int HALF_BYTES = 75776;
constexpr int SMEM_BYTES = 2 * HALF_BYTES;
constexpr int LUT_OFF = 73728;
constexpr int SJOB_OFF = 75000;

constexpr int NWIN = 3584;
constexpr size_t OFF_WIN = 0, OFF_WG = OFF_WIN + (size_t)NWIN * 1024, OFF_BRSB = OFF_WG + (size_t)3072 * 1024, OFF_BRSP = OFF_BRSB + 262144,
                 OFF_BRDF = OFF_BRSP + 262144, OFF_OUT = OFF_BRDF + 524288, OFF_UP = OFF_OUT + 1048576, OFF_DOWN = OFF_UP + (size_t)5632 * 1024,
                 LAYER_W = OFF_DOWN + (size_t)1024 * 2816;

struct Params {
  const float *x, *meta, *rel_bias, *attn_norm, *w_in, *b_gate, *qn_sp, *kn_sp, *qn_df, *kn_df, *lq1, *lk1, *lq2, *lk2,
      *subln, *w_br_sb, *w_br_sp, *w_br_df, *w_out, *ffn_norm, *w_up, *conv_w, *conv_b, *w_down;
  float* out;
  u16* hb; float* rowss; float* side; u16* wts;
  u16 *qsb, *ksb, *qsp, *ksp, *qdf, *kdf, *vtsb, *vtsp, *vtdf, *qix, *kix; float* wix;
  u16 *ysb, *ysp, *ydf; u32* mask; u16* merged; u16* act; u32* ctr; u32* bar;
};

DI u32 pack2bf(float a, float b) {
  f2_t v = {a, b};
  bf2_t r = __builtin_convertvector(v, bf2_t);
  return __builtin_bit_cast(u32, r);
}
DI u16 f2bf(float a) { return (u16)(pack2bf(a, 0.f) & 0xffffu); }
DI float wave_sum(float v) {
#pragma unroll
  for (int o = 32; o; o >>= 1) v += __shfl_xor(v, o);
  return v;
}
DI f32x4 mfma16(bf16x8 a, bf16x8 b, f32x4 c) { return __builtin_amdgcn_mfma_f32_16x16x32_bf16(a, b, c, 0, 0, 0); }
DI f32x16 mfma32(bf16x8 a, bf16x8 b, f32x16 c) { return __builtin_amdgcn_mfma_f32_32x32x16_bf16(a, b, c, 0, 0, 0); }

DI int vblock() {
  int g = gridDim.x, b = blockIdx.x;
  if ((g & 7) == 0) return (b & 7) * (g >> 3) + (b >> 3);
  return b;
}

DI float* hrow_w(const Params& p, int gr) {
  int b = gr / TP, t = gr - b * TP;
  if (t >= NMETA && t < TREAL) return p.out + ((size_t)(b * SEQ + t - NMETA)) * DM;
  int s = t < NMETA ? t : t - TREAL + NMETA;
  return p.side + ((size_t)(b * 128 + s)) * DM;
}
DI const float* hrow_r(const Params& p, int layer, int gr) {
  int b = gr / TP, t = gr - b * TP;
  if (t >= NMETA && t < TREAL) {
    size_t o = ((size_t)(b * SEQ + t - NMETA)) * DM;
    return layer == 0 ? p.x + o : p.out + o;
  }
  int s = t < NMETA ? t : t - TREAL + NMETA;
  return p.side + ((size_t)(b * 128 + s)) * DM;
}

DI int wt_srccol(int kind, int n) {
  if (kind == 0) {
    if (n < 1536) return n;
    if (n < 3072) return 1832 + n - 1536;
    if (n < 3328) return 1536 + n - 3072;
    if (n < 3360) return 1792 + n - 3328;
    if (n < 3368) return 1824 + n - 3360;
    return -1;
  }
  if (kind == 1) return 3368 + n;
  if (kind == 6) {
    int j = n >> 8, w = n & 255, wn = w >> 7, ni = (w & 127) >> 4, c = w & 15;
    int ff = 128 * j + 64 * wn + 16 * (ni >> 1) + c;
    return (ni & 1) ? DFF + ff : ff;
  }
  return n;
}

DI void phase_prep(const Params& p, unsigned char* smem) {
  int tid_ = threadIdx.x; asm volatile("" : "+v"(tid_));
  const int tid = tid_, wave = tid >> 6, lane = tid & 63;
  for (int gr = blockIdx.x * 8 + wave; gr < R; gr += gridDim.x * 8) {
    int b = gr / TP, t = gr - b * TP;
    const float* src = nullptr;
    if (t < NMETA) src = p.meta + (size_t)t * DM;
    else if (t < TREAL) src = p.x + ((size_t)(b * SEQ + t - NMETA)) * DM;
    float4 v[4];
    float ss = 0.f;
#pragma unroll
    for (int i = 0; i < 4; ++i) {
      v[i] = src ? ((const float4*)src)[lane + 64 * i] : make_float4(0.f, 0.f, 0.f, 0.f);
      ss += v[i].x * v[i].x + v[i].y * v[i].y + v[i].z * v[i].z + v[i].w * v[i].w;
    }
    ss = wave_sum(ss);
#pragma unroll
    for (int i = 0; i < 4; ++i) {
      u32x2 pk = {pack2bf(v[i].x, v[i].y), pack2bf(v[i].z, v[i].w)};
      *(u32x2*)(p.hb + (size_t)gr * DM + (lane + 64 * i) * 4) = pk;
    }
    if (lane == 0) { p.rowss[gr] = ss; p.rowss[R + gr] = 0.f; p.rowss[2 * R + gr] = 0.f; p.rowss[3 * R + gr] = 0.f; }
    if (t < NMETA || t >= TREAL) {
      int s = t < NMETA ? t : t - TREAL + NMETA;
      float* d = p.side + ((size_t)(b * 128 + s)) * DM;
#pragma unroll
      for (int i = 0; i < 4; ++i) ((float4*)d)[lane + 64 * i] = v[i];
    }
  }
  if (blockIdx.x == 0 && tid < 64) p.ctr[tid] = 0;
  for (int i = blockIdx.x * 512 + tid; i < 2 * 256 * DM / 8; i += gridDim.x * 512) {
    const int hf = i / (256 * DM / 8), o = i - hf * (256 * DM / 8);
    u16* d = hf ? p.hb + (size_t)R * DM : p.hb - (size_t)256 * DM;
    *(u32x4*)(d + (size_t)o * 8) = u32x4{0u, 0u, 0u, 0u};
  }
  const int half = tid >> 8, t2 = tid & 255;
  float* tl = (float*)(smem + half * HALF_BYTES);
  constexpr int NK[8] = {NWIN, 3072, 1024, 1024, 1024, 1024, 5632, 1024};
  constexpr int KK[8] = {1024, 1024, 256, 256, 512, 1024, 1024, 2816};
  int total = 0;
  int cum[9];
  cum[0] = 0;
#pragma unroll
  for (int k = 0; k < 8; ++k) { total += (NK[k] / 64) * (KK[k] / 64); cum[k + 1] = total; }
  for (int jp = blockIdx.x; 2 * jp < 2 * total; jp += gridDim.x) {
    const int job = 2 * jp + half;
    const bool act = job < 2 * total;
    int layer = job >= total ? 1 : 0;
    int j = job - layer * total;
    int kind = 0;
#pragma unroll
    for (int k = 1; k < 8; ++k) if (j >= cum[k]) kind = k;
    int jj = j;
    int K = 1024, ld = 1024;
    const float* src = p.w_in; const float* gain = nullptr; u16* dst = p.wts + (size_t)layer * LAYER_W;
    switch (kind) {
      case 0: jj -= cum[0]; K = 1024; ld = DIN; src = p.w_in + (size_t)layer * DM * DIN; gain = p.attn_norm + layer * DM; dst += OFF_WIN; break;
      case 1: jj -= cum[1]; K = 1024; ld = DIN; src = p.w_in + (size_t)layer * DM * DIN; gain = p.attn_norm + layer * DM; dst += OFF_WG; break;
      case 2: jj -= cum[2]; K = 256; ld = 1024; src = p.w_br_sb + (size_t)layer * 256 * 1024; dst += OFF_BRSB; break;
      case 3: jj -= cum[3]; K = 256; ld = 1024; src = p.w_br_sp + (size_t)layer * 256 * 1024; dst += OFF_BRSP; break;
      case 4: jj -= cum[4]; K = 512; ld = 1024; src = p.w_br_df + (size_t)layer * 512 * 1024; dst += OFF_BRDF; break;
      case 5: jj -= cum[5]; K = 1024; ld = 1024; src = p.w_out + (size_t)layer * 1024 * 1024; dst += OFF_OUT; break;
      case 6: jj -= cum[6]; K = 1024; ld = 2 * DFF; src = p.w_up + (size_t)layer * DM * 2 * DFF; gain = p.ffn_norm + layer * DM; dst += OFF_UP; break;
      default: jj -= cum[7]; K = DFF; ld = 1024; src = p.w_down + (size_t)layer * DFF * 1024; dst += OFF_DOWN; break;
    }
    int nkt = K / 64;
    int n0 = (jj / nkt) * 64, k0 = (jj % nkt) * 64;
    if (act) {
      const int nn = t2 & 63, kq = t2 >> 6;
      const int col = wt_srccol(kind, n0 + nn);
      const float* sp = src + (size_t)(k0 + kq) * ld + (col >= 0 ? col : 0);
      float v[16];
#pragma unroll
      for (int i = 0; i < 16; ++i) v[i] = sp[(size_t)(4 * i) * ld];
#pragma unroll
      for (int i = 0; i < 16; ++i) {
        float x = col >= 0 ? v[i] : 0.f;
        if (gain) x *= gain[k0 + kq + 4 * i];
        tl[nn * 65 + kq + 4 * i] = x;
      }
    }
    __syncthreads();
    if (act) {
#pragma unroll
      for (int i = 0; i < 2; ++i) {
        int idx = t2 + 256 * i, nn = idx >> 3, c = idx & 7;
        const float* s = tl + nn * 65 + c * 8;
        u32x4 pk = {pack2bf(s[0], s[1]), pack2bf(s[2], s[3]), pack2bf(s[4], s[5]), pack2bf(s[6], s[7])};
        *(u32x4*)(dst + (size_t)(n0 + nn) * K + k0 + c * 8) = pk;
      }
    }
    __syncthreads();
  }
}

template <int MI, int NI>
DI void gemm_kloop(const u16* Au, int lda, const u16* Bu, int ldb, int K, f32x4 (&acc)[NI][MI], unsigned char* smem) {
  int tid_ = threadIdx.x; asm volatile("" : "+v"(tid_));
  const int tid = tid_, lane = tid & 63, wave = tid >> 6, wm = wave >> 1, wn = wave & 1;
  const int lr = tid >> 3, lc = tid & 7;
  const int voa = lr * lda + lc * 8, vob = lr * ldb + lc * 8;
  constexpr int NB2 = NI / 2;
  u32x4 ra[MI], rb[NB2];
  const int nk = K >> 6;
  const int fsw = (lane & 15) >> 1;
  const int fro0 = (lane & 15) * 128 + (((lane >> 4) ^ fsw) << 4);
  const int fro1 = (lane & 15) * 128 + ((((lane >> 4) + 4) ^ fsw) << 4);
  const int wof = lr * 128 + ((lc ^ ((lr >> 1) & 7)) << 4);
#define GLOAD(K0)                                                                                        \
  {                                                                                                      \
    _Pragma("unroll") for (int q = 0; q < MI; ++q) ra[q] = *(const u32x4*)((Au + (size_t)(q * 64) * lda + (K0)) + voa); \
    _Pragma("unroll") for (int q = 0; q < NB2; ++q) rb[q] = *(const u32x4*)((Bu + (size_t)(q * 64) * ldb + (K0)) + vob); \
  }
#define SWRITE(BUF)                                                                                      \
  {                                                                                                      \
    unsigned char* d_ = smem + (BUF) * 65536 + wof;                                                      \
    _Pragma("unroll") for (int q = 0; q < MI; ++q) *(u32x4*)(d_ + q * 8192) = ra[q];                     \
    _Pragma("unroll") for (int q = 0; q < NB2; ++q) *(u32x4*)(d_ + 32768 + q * 8192) = rb[q];            \
  }
  GLOAD(0);
  SWRITE(0);
  if (nk > 1) GLOAD(64);
  for (int kt = 0; kt < nk; ++kt) {
    __syncthreads();
    if (kt + 1 < nk) {
      SWRITE((kt + 1) & 1);
      if (kt + 2 < nk) GLOAD((kt + 2) << 6);
    }
    {
      const unsigned char* sa = smem + (kt & 1) * 65536;
      const unsigned char* sb = sa + 32768;
#pragma unroll
      for (int ks = 0; ks < 2; ++ks) {
        const int fo = ks ? fro1 : fro0;
        bf16x8 af[MI];
#pragma unroll
        for (int i = 0; i < MI; ++i) af[i] = *(const bf16x8*)(sa + (wm * 16 * MI + i * 16) * 128 + fo);
#pragma unroll
        for (int nh = 0; nh < NI; nh += 4) {
          bf16x8 wf[4];
#pragma unroll
          for (int i = 0; i < 4; ++i) wf[i] = *(const bf16x8*)(sb + (wn * 16 * NI + (nh + i) * 16) * 128 + fo);
#pragma unroll
          for (int ni = 0; ni < 4; ++ni)
#pragma unroll
            for (int mi = 0; mi < MI; ++mi) acc[nh + ni][mi] = mfma16(wf[ni], af[mi], acc[nh + ni][mi]);
        }
      }
    }
  }
  __syncthreads();
#undef GLOAD
#undef SWRITE
}

template <int MI, int NI>
DI void zero_acc(f32x4 (&acc)[NI][MI]) {
#pragma unroll
  for (int i = 0; i < NI; ++i)
#pragma unroll
    for (int j = 0; j < MI; ++j) acc[i][j] = f32x4{0.f, 0.f, 0.f, 0.f};
}

DI void phase_g1(const Params& p, int layer, unsigned char* smem) {
  int tid_ = threadIdx.x; asm volatile("" : "+v"(tid_));
  const int tid = tid_, lane = tid & 63, wave = tid >> 6, wm = wave >> 1, wn = wave & 1;
  const int lr = tid >> 3, lc = tid & 7, lm = lane & 15, lg = lane >> 4;
  const u16* W = p.wts + (size_t)layer * LAYER_W + OFF_WIN;
  const float* rowss = p.rowss + (size_t)(2 * layer) * R;
  constexpr int NT = 13, NTILES = 132 * NT;
  for (int it = vblock(); it < NTILES; it += gridDim.x) {
    const int g = it / (4 * NT), rem = it - g * (4 * NT), nt = rem >> 2, mt = g * 4 + (rem & 3);
    f32x4 acc[8][4];
    zero_acc<4, 8>(acc);
    gemm_kloop<4, 8>(p.hb + (size_t)(mt * 256) * DM, DM, W + (size_t)(nt * 256) * DM, DM, DM, acc, smem);
    int mrow[4];
#pragma unroll
    for (int mi = 0; mi < 4; ++mi) {
      mrow[mi] = mt * 256 + wm * 64 + mi * 16 + lm;
      float rs = rsqrtf(rowss[mrow[mi]] * (1.f / DM) + EPS);
#pragma unroll
      for (int ni = 0; ni < 8; ++ni) acc[ni][mi] *= rs;
    }
    int kind;
    u16* dst = nullptr; int ld = 256, col0 = 0, vrows = 256; const float* gn = nullptr;
    if (nt == 0) { kind = 0; dst = p.qsb; }
    else if (nt == 1) { kind = 0; dst = p.ksb; }
    else if (nt == 2) { kind = 2; dst = p.vtsb; vrows = 256; }
    else if (nt == 3) { kind = 1; dst = p.qsp; gn = p.qn_sp + layer * 64; }
    else if (nt == 4) { kind = 1; dst = p.ksp; gn = p.kn_sp + layer * 64; }
    else if (nt == 5) { kind = 2; dst = p.vtsp; vrows = 256; }
    else if (nt < 8) { kind = 1; dst = p.qdf; ld = 512; col0 = (nt - 6) * 256; gn = p.qn_df + layer * 64; }
    else if (nt < 10) { kind = 1; dst = p.kdf; ld = 512; col0 = (nt - 8) * 256; gn = p.kn_df + layer * 64; }
    else if (nt < 12) { kind = 2; dst = p.vtdf; col0 = (nt - 10) * 256; vrows = 512; }
    else { kind = 0; dst = p.qix; }
    if (kind == 1) {
#pragma unroll
      for (int mi = 0; mi < 4; ++mi)
#pragma unroll
        for (int hh = 0; hh < 2; ++hh) {
          float ss = 0.f;
#pragma unroll
          for (int n4 = 0; n4 < 4; ++n4)
#pragma unroll
            for (int r = 0; r < 4; ++r) ss += acc[hh * 4 + n4][mi][r] * acc[hh * 4 + n4][mi][r];
          ss += __shfl_xor(ss, 16);
          ss += __shfl_xor(ss, 32);
          float sc = rsqrtf(ss * (1.f / 64.f) + EPS);
#pragma unroll
          for (int n4 = 0; n4 < 4; ++n4)
#pragma unroll
            for (int r = 0; r < 4; ++r) acc[hh * 4 + n4][mi][r] *= sc * gn[n4 * 16 + lg * 4 + r];
        }
    }
    if (kind == 0 || kind == 1) {
#pragma unroll
      for (int mi = 0; mi < 4; ++mi)
#pragma unroll
        for (int ni = 0; ni < 8; ++ni) {
          u32x2 pk = {pack2bf(acc[ni][mi][0], acc[ni][mi][1]), pack2bf(acc[ni][mi][2], acc[ni][mi][3])};
          *(u32x2*)(dst + (size_t)mrow[mi] * ld + col0 + wn * 128 + ni * 16 + lg * 4) = pk;
        }
    } else if (kind == 2) {
#pragma unroll
      for (int mi = 0; mi < 4; ++mi) {
        int b = mrow[mi] / TP, t = mrow[mi] - b * TP;
#pragma unroll
        for (int ni = 0; ni < 8; ++ni)
#pragma unroll
          for (int r = 0; r < 4; ++r) {
            int row = col0 + wn * 128 + ni * 16 + lg * 4 + r;
            dst[((size_t)(b * vrows + row)) * TP + t] = f2bf(acc[ni][mi][r]);
          }
      }
    }
  }
  {
    const int v = vblock(), first = NTILES % gridDim.x, nfree = gridDim.x - first;
    if (v >= first) {
      for (int s = v - first; s < 132; s += nfree) {
        const int mt = s;
        f32x4 acc[4][4];
        zero_acc<4, 4>(acc);
        gemm_kloop<4, 4>(p.hb + (size_t)(mt * 256) * DM, DM, W + (size_t)(13 * 256) * DM, DM, DM, acc, smem);
        if (wn == 0) {
#pragma unroll
          for (int mi = 0; mi < 4; ++mi) {
            const int m = mt * 256 + wm * 64 + mi * 16 + lm;
            const float rs = rsqrtf(rowss[m] * (1.f / DM) + EPS);
#pragma unroll
            for (int ni = 0; ni < 2; ++ni) {
              u32x2 pk = {pack2bf(acc[ni][mi][0] * rs, acc[ni][mi][1] * rs), pack2bf(acc[ni][mi][2] * rs, acc[ni][mi][3] * rs)};
              *(u32x2*)(p.kix + (size_t)m * 32 + ni * 16 + lg * 4) = pk;
            }
            if (lg < 2) {
              float4 w4 = make_float4(acc[2][mi][0] * rs, acc[2][mi][1] * rs, acc[2][mi][2] * rs, acc[2][mi][3] * rs);
              *(float4*)(p.wix + (size_t)m * 8 + lg * 4) = w4;
            }
          }
        }
      }
    }
  }
}

template <int MI, int NI>
DI void resid_epilogue(const Params& p, int from_x, const f32x4 (&acc)[NI][MI], int row0, int n0, float* rowss_next, bool last, int lm, int lg) {
#pragma unroll
  for (int mi = 0; mi < MI; ++mi) {
    const int m = row0 + mi * 16 + lm;
    const float* hr = hrow_r(p, from_x == 1 ? 0 : 1, m);
    float* hw = hrow_w(p, m);
    u16* hbr = p.hb + (size_t)m * DM;
    float ss = 0.f;
#pragma unroll
    for (int ni = 0; ni < NI; ++ni) {
      const int n = n0 + ni * 16 + lg * 4;
      float4 h;
      if (from_x == 2) {
        const u32x2 pk = *(const u32x2*)(hbr + n);
        h = make_float4(__uint_as_float(pk[0] << 16), __uint_as_float(pk[0] & 0xffff0000u), __uint_as_float(pk[1] << 16), __uint_as_float(pk[1] & 0xffff0000u));
      } else h = *(const float4*)(hr + n);
      h.x += acc[ni][mi][0]; h.y += acc[ni][mi][1]; h.z += acc[ni][mi][2]; h.w += acc[ni][mi][3];
      if (from_x == 2) *(float4*)(hw + n) = h;
      if (!last) {
        u32x2 pk = {pack2bf(h.x, h.y), pack2bf(h.z, h.w)};
        *(u32x2*)(hbr + n) = pk;
        ss += h.x * h.x + h.y * h.y + h.z * h.z + h.w * h.w;
      }
    }
    if (!last) {
      ss += __shfl_xor(ss, 16);
      ss += __shfl_xor(ss, 32);
      if (lg == 0) atomicAdd(rowss_next + m, ss);
    }
  }
}

DI void phase_resid(const Params& p, int from_x, const u16* A, int K, const u16* W, float* rowss_next, bool last,
                    unsigned char* smem) {
  int tid_ = threadIdx.x; asm volatile("" : "+v"(tid_));
  const int tid = tid_, lane = tid & 63, wave = tid >> 6, wm = wave >> 1, wn = wave & 1;
  const int lm = lane & 15, lg = lane >> 4;
  constexpr int NT = 4, NTILES = 132 * NT;
  const int nfull = (NTILES / (int)gridDim.x) * (int)gridDim.x;
  for (int it = vblock(); it < nfull; it += gridDim.x) {
    const int g = it / (4 * NT), rem = it - g * (4 * NT), nt = rem >> 2, mt = g * 4 + (rem & 3);
    f32x4 acc[8][4];
    zero_acc<4, 8>(acc);
    gemm_kloop<4, 8>(A + (size_t)(mt * 256) * K, K, W + (size_t)(nt * 256) * K, K, K, acc, smem);
    resid_epilogue<4, 8>(p, from_x, acc, mt * 256 + wm * 64, nt * 256 + wn * 128, rowss_next, last, lm, lg);
  }
  for (int s = vblock(); s < 4 * (NTILES - nfull); s += gridDim.x) {
    const int it = nfull + (s >> 2), hm = s & 1, hn = (s >> 1) & 1;
    const int g = it / (4 * NT), rem = it - g * (4 * NT), nt = rem >> 2, mt = g * 4 + (rem & 3);
    f32x4 acc[4][2];
    zero_acc<2, 4>(acc);
    gemm_kloop<2, 4>(A + (size_t)(mt * 256 + hm * 128) * K, K, W + (size_t)(nt * 256 + hn * 128) * K, K, K, acc, smem);
    resid_epilogue<2, 4>(p, from_x, acc, mt * 256 + hm * 128 + wm * 32, nt * 256 + hn * 128 + wn * 64, rowss_next, last, lm, lg);
  }
}

template <int MI>
DI void merge_tile(const Params& p, int layer, int rowbase, int nt, unsigned char* smem) {
  int tid_ = threadIdx.x; asm volatile("" : "+v"(tid_));
  const int tid = tid_, lane = tid & 63, wave = tid >> 6, wm = wave >> 1, wn = wave & 1;
  const int lm = lane & 15, lg = lane >> 4;
  const u16* WL = p.wts + (size_t)layer * LAYER_W;
  const float* rowss = p.rowss + (size_t)(2 * layer) * R;
  const float* bg = p.b_gate + layer * 3 * DM;
  u32 mp[4][MI][2];
#pragma unroll
  for (int ni = 0; ni < 4; ++ni)
#pragma unroll
    for (int mi = 0; mi < MI; ++mi) { mp[ni][mi][0] = 0u; mp[ni][mi][1] = 0u; }
#pragma unroll 1
  for (int br = 0; br < 3; ++br) {
    const u16* Y = br == 0 ? p.ysb : (br == 1 ? p.ysp : p.ydf);
    const int Kb = br == 2 ? 512 : 256;
    const u16* Wb = WL + (br == 0 ? OFF_BRSB : (br == 1 ? OFF_BRSP : OFF_BRDF));
    f32x4 acc[4][MI];
    zero_acc<MI, 4>(acc);
    gemm_kloop<MI, 4>(Y + (size_t)rowbase * Kb, Kb, Wb + (size_t)(nt * 128) * Kb, Kb, Kb, acc, smem);
    u32 brp[4][MI][2];
#pragma unroll
    for (int ni = 0; ni < 4; ++ni)
#pragma unroll
      for (int mi = 0; mi < MI; ++mi) {
        brp[ni][mi][0] = pack2bf(acc[ni][mi][0], acc[ni][mi][1]);
        brp[ni][mi][1] = pack2bf(acc[ni][mi][2], acc[ni][mi][3]);
      }
    zero_acc<MI, 4>(acc);
    gemm_kloop<MI, 4>(p.hb + (size_t)rowbase * DM, DM, WL + OFF_WG + (size_t)(br * 1024 + nt * 128) * DM, DM, DM, acc, smem);
    int m0 = rowbase + wm * 16 * MI + lm, n0 = nt * 128 + wn * 64 + lg * 4;
    asm volatile("" : "+v"(m0), "+v"(n0));
#pragma unroll
    for (int mi = 0; mi < MI; ++mi) {
      const float rs = rsqrtf(rowss[m0 + mi * 16] * (1.f / DM) + EPS);
#pragma unroll
      for (int ni = 0; ni < 4; ++ni) {
        const float4 b4 = *(const float4*)(bg + br * DM + n0 + ni * 16);
        const float bb[4] = {b4.x, b4.y, b4.z, b4.w};
        float mv[4];
#pragma unroll
        for (int r = 0; r < 4; ++r) {
          const float gv = acc[ni][mi][r] * rs + bb[r];
          const float sg = 1.f / (1.f + __expf(-gv));
          const u32 w = brp[ni][mi][r >> 1], mw = mp[ni][mi][r >> 1];
          const float bv = __uint_as_float((r & 1) ? (w & 0xffff0000u) : (w << 16));
          const float mo = __uint_as_float((r & 1) ? (mw & 0xffff0000u) : (mw << 16));
          mv[r] = mo + sg * bv;
        }
        mp[ni][mi][0] = pack2bf(mv[0], mv[1]);
        mp[ni][mi][1] = pack2bf(mv[2], mv[3]);
      }
    }
  }
  int m0 = rowbase + wm * 16 * MI + lm, n0 = nt * 128 + wn * 64 + lg * 4;
  asm volatile("" : "+v"(m0), "+v"(n0));
#pragma unroll
  for (int mi = 0; mi < MI; ++mi)
#pragma unroll
    for (int ni = 0; ni < 4; ++ni) {
      u32x2 pk = {mp[ni][mi][0], mp[ni][mi][1]};
      *(u32x2*)(p.merged + (size_t)(m0 + mi * 16) * DM + n0 + ni * 16) = pk;
    }
}

DI void phase_merge(const Params& p, int layer, unsigned char* smem) {
  constexpr int NT = 8, NTILES = 132 * NT;
  const int nfull = (NTILES / (int)gridDim.x) * (int)gridDim.x;
  for (int it = vblock(); it < nfull; it += gridDim.x) {
    const int g = it / (4 * NT), rem = it - g * (4 * NT), nt = rem >> 2, mt = g * 4 + (rem & 3);
    merge_tile<4>(p, layer, mt * 256, nt, smem);
  }
  for (int s = vblock(); s < 2 * (NTILES - nfull); s += gridDim.x) {
    const int it = nfull + (s >> 1), hf = s & 1;
    const int g = it / (4 * NT), rem = it - g * (4 * NT), nt = rem >> 2, mt = g * 4 + (rem & 3);
    merge_tile<2>(p, layer, mt * 256 + hf * 128, nt, smem);
  }
}

DI void phase_ffnup(const Params& p, int layer, unsigned char* smem) {
  int tid_ = threadIdx.x; asm volatile("" : "+v"(tid_));
  const int tid = tid_, lane = tid & 63, wave = tid >> 6, wm = wave >> 1, wn = wave & 1;
  const int lr = tid >> 3, lc = tid & 7, lm = lane & 15, lg = lane >> 4;
  const u16* W = p.wts + (size_t)layer * LAYER_W + OFF_UP;
  const float* rowss = p.rowss + (size_t)(2 * layer + 1) * R;
  const float* cw = p.conv_w + layer * 3 * DFF;
  const float* cb = p.conv_b + layer * DFF;
  constexpr int NT = 22, MT = 136, NTILES = MT * NT;
  float* G = (float*)smem;
  for (int it = vblock(); it < NTILES; it += gridDim.x) {
    const int g = it / (4 * NT), rem = it - g * (4 * NT), nt = rem >> 2, mt = g * 4 + (rem & 3);
    const int b = mt / 17, ti = mt - b * 17, tbase = 254 * ti - 2;
    f32x4 acc[8][4];
    zero_acc<4, 8>(acc);
    gemm_kloop<4, 8>(p.hb + ((ptrdiff_t)(b * TP + tbase)) * DM, DM, W + (size_t)(nt * 256) * DM, DM, DM, acc, smem);
    int r0 = wm * 64 + lm, gc0 = 64 * wn + 4 * lg;
    asm volatile("" : "+v"(r0), "+v"(gc0));
    int tt[4];
#pragma unroll
    for (int mi = 0; mi < 4; ++mi) {
      const int r = r0 + mi * 16;
      tt[mi] = tbase + r;
      float rs = (tt[mi] >= 0 && tt[mi] < TP) ? rsqrtf(rowss[b * TP + tt[mi]] * (1.f / DM) + EPS) : 0.f;
#pragma unroll
      for (int ni = 0; ni < 8; ++ni) acc[ni][mi] *= rs;
#pragma unroll
      for (int n2 = 0; n2 < 4; ++n2) {
        float4 g4 = make_float4(acc[2 * n2][mi][0], acc[2 * n2][mi][1], acc[2 * n2][mi][2], acc[2 * n2][mi][3]);
        *(float4*)(G + r * 132 + gc0 + 16 * n2) = g4;
      }
    }
    __syncthreads();
#pragma unroll
    for (int n2 = 0; n2 < 4; ++n2) {
      const int gc = gc0 + 16 * n2;
      const int ff = 128 * nt + gc;
      const float4 w0 = *(const float4*)(cw + ff), w1 = *(const float4*)(cw + DFF + ff), w2 = *(const float4*)(cw + 2 * DFF + ff);
      const float4 c4 = *(const float4*)(cb + ff);
#pragma unroll
      for (int mi = 0; mi < 4; ++mi) {
        const int r = r0 + mi * 16;
        if (r >= 2 && tt[mi] < TP) {
          const float4 g1 = *(const float4*)(G + (r - 1) * 132 + gc);
          const float4 g2 = *(const float4*)(G + (r - 2) * 132 + gc);
          float cv[4];
          cv[0] = c4.x + w0.x * g2.x + w1.x * g1.x + w2.x * acc[2 * n2][mi][0];
          cv[1] = c4.y + w0.y * g2.y + w1.y * g1.y + w2.y * acc[2 * n2][mi][1];
          cv[2] = c4.z + w0.z * g2.z + w1.z * g1.z + w2.z * acc[2 * n2][mi][2];
          cv[3] = c4.w + w0.w * g2.w + w1.w * g1.w + w2.w * acc[2 * n2][mi][3];
          float a[4];
#pragma unroll
          for (int e = 0; e < 4; ++e) a[e] = cv[e] / (1.f + __expf(-cv[e])) * acc[2 * n2 + 1][mi][e];
          u32x2 pk = {pack2bf(a[0], a[1]), pack2bf(a[2], a[3])};
          *(u32x2*)(p.act + (size_t)(b * TP + tt[mi]) * DFF + ff) = pk;
        }
      }
    }
    __syncthreads();
  }
}

DI int swap23(int k) { return (k & ~12) | ((k & 4) << 1) | ((k & 8) >> 1); }

DI void build_lut(const Params& p, int bias_head, unsigned char* smem, int tid) {
  float* lut = (float*)(smem + LUT_OFF);
  const int d = tid;
  if (d <= 128) {
    int bucket;
    if (d < 16) bucket = d;
    else {
      float nf = (float)d;
      int large = 16 + (int)(logf(nf / 16.f) / 2.0794415416798357f * 16.f);
      bucket = large < 31 ? large : 31;
    }
    lut[d] = p.rel_bias[bucket * 8 + bias_head] * LOG2E;
  }
}

template <int NCH>
DI void ld_tile_g(u32x4 (&r)[NCH], const u16* base, size_t rstride, int k0, bool is_vt, int tid) {
#pragma unroll
  for (int i = 0; i < NCH; ++i) {
    int id = tid + 256 * i, row = id >> 3, c = id & 7;
    const u16* s = is_vt ? base + (size_t)row * rstride + k0 + c * 8 : base + (size_t)(k0 + row) * rstride + c * 8;
    r[i] = *(const u32x4*)s;
  }
}
template <int NCH>
DI void st_tile_s(const u32x4 (&r)[NCH], unsigned char* dst, bool permute, int tid) {
#pragma unroll
  for (int i = 0; i < NCH; ++i) {
    int id = tid + 256 * i, row = id >> 3, c = id & 7;
    int rr = permute ? swap23(row) : row;
    *(u32x4*)(dst + rr * 144 + c * 16) = r[i];
  }
}

DI bf16x8 pack8(const f32x16& v, int s2) {
  u32x4 pk;
  if (s2 == 0) pk = u32x4{pack2bf(v[0], v[1]), pack2bf(v[2], v[3]), pack2bf(v[4], v[5]), pack2bf(v[6], v[7])};
  else pk = u32x4{pack2bf(v[8], v[9]), pack2bf(v[10], v[11]), pack2bf(v[12], v[13]), pack2bf(v[14], v[15])};
  return __builtin_bit_cast(bf16x8, pk);
}
DI f32x16 zero16() {
  f32x16 z;
#pragma unroll
  for (int i = 0; i < 16; ++i) z[i] = 0.f;
  return z;
}

DI void diff_map(const unsigned char* sk, const bf16x8 (&qf)[4], const unsigned char* sv, const float* lut, bool far,
                 bool diag, int ks0, int tq, int h, int lq, f32x16 (&O)[4], float& m, float& l) {
  const float csc = 0.125f * LOG2E;
  f32x16 S = zero16();
#pragma unroll
  for (int s = 0; s < 4; ++s) {
    bf16x8 kf = *(const bf16x8*)(sk + lq * 144 + (16 * s + 8 * h) * 2);
    S = mfma32(kf, qf[s], S);
  }
  if (far) {
    const float cbias = lut[128];
    float mx = fmaxf(fmaxf(S[0], S[1]), S[2]);
#pragma unroll
    for (int i = 3; i < 15; i += 2) mx = fmaxf(fmaxf(mx, S[i]), S[i + 1]);
    mx = fmaxf(mx, S[15]);
    mx = fmaxf(mx, __shfl_xor(mx, 32));
    const float mn = fmaxf(m, mx * csc + cbias);
    if (__any(mn > m)) {
      const float a = __builtin_amdgcn_exp2f(m - mn);
      l *= a; m = mn;
#pragma unroll
      for (int d = 0; d < 4; ++d) O[d] *= a;
    }
    const float off = cbias - m;
#pragma unroll
    for (int i = 0; i < 16; ++i) { float pv = __builtin_amdgcn_exp2f(S[i] * csc + off); l += pv; S[i] = pv; }
  } else {
    float mx = -1e30f;
#pragma unroll
    for (int i = 0; i < 16; ++i) {
      const int key = ks0 + 16 * (i >> 3) + 8 * h + (i & 7);
      int d = tq - key;
      const bool msk = diag && d < 0;
      d = d < 0 ? 0 : (d > 128 ? 128 : d);
      float x = S[i] * csc + lut[d];
      if (msk) x = -1e30f;
      S[i] = x;
      mx = fmaxf(mx, x);
    }
    mx = fmaxf(mx, __shfl_xor(mx, 32));
    const float mn = fmaxf(m, mx);
    if (__any(mn > m)) {
      const float a = __builtin_amdgcn_exp2f(m - mn);
      l *= a; m = mn;
#pragma unroll
      for (int d = 0; d < 4; ++d) O[d] *= a;
    }
#pragma unroll
    for (int i = 0; i < 16; ++i) { float pv = __builtin_amdgcn_exp2f(S[i] - m); l += pv; S[i] = pv; }
  }
  const bf16x8 p0 = pack8(S, 0), p1 = pack8(S, 1);
#pragma unroll
  for (int d = 0; d < 4; ++d) {
    bf16x8 v0 = *(const bf16x8*)(sv + (d * 32 + lq) * 144 + 16 * h);
    bf16x8 v1 = *(const bf16x8*)(sv + (d * 32 + lq) * 144 + 32 + 16 * h);
    O[d] = mfma32(v0, p0, O[d]);
    O[d] = mfma32(v1, p1, O[d]);
  }
}

DI void diff_map_far2(const unsigned char* sk, const bf16x8 (&qf)[4], const unsigned char* sv, float cbias, int h, int lq,
                      f32x16 (&O)[4], float& m, float& l) {
  const float csc = 0.125f * LOG2E;
  f32x16 S0 = zero16(), S1 = zero16();
#pragma unroll
  for (int s = 0; s < 4; ++s) {
    bf16x8 k0 = *(const bf16x8*)(sk + lq * 144 + (16 * s + 8 * h) * 2);
    bf16x8 k1 = *(const bf16x8*)(sk + (32 + lq) * 144 + (16 * s + 8 * h) * 2);
    S0 = mfma32(k0, qf[s], S0);
    S1 = mfma32(k1, qf[s], S1);
  }
  float mx = fmaxf(fmaxf(S0[0], S0[1]), S0[2]);
#pragma unroll
  for (int i = 3; i < 15; i += 2) mx = fmaxf(fmaxf(mx, S0[i]), S0[i + 1]);
  mx = fmaxf(mx, S0[15]);
#pragma unroll
  for (int i = 0; i < 16; i += 2) mx = fmaxf(fmaxf(mx, S1[i]), S1[i + 1]);
  mx = fmaxf(mx, __shfl_xor(mx, 32));
  const float mn = fmaxf(m, mx * csc + cbias);
  if (__any(mn > m)) {
    const float a = __builtin_amdgcn_exp2f(m - mn);
    l *= a; m = mn;
#pragma unroll
    for (int d = 0; d < 4; ++d) O[d] *= a;
  }
  const float off = cbias - m;
  float la = 0.f, lb = 0.f;
#pragma unroll
  for (int i = 0; i < 16; ++i) {
    float pa = __builtin_amdgcn_exp2f(S0[i] * csc + off), pb = __builtin_amdgcn_exp2f(S1[i] * csc + off);
    la += pa; lb += pb; S0[i] = pa; S1[i] = pb;
  }
  l += la + lb;
  const bf16x8 p0 = pack8(S0, 0), p1 = pack8(S0, 1), p2 = pack8(S1, 0), p3 = pack8(S1, 1);
#pragma unroll
  for (int d = 0; d < 4; ++d) {
    const unsigned char* vr = sv + (d * 32 + lq) * 144 + 16 * h;
    bf16x8 v0 = *(const bf16x8*)(vr), v1 = *(const bf16x8*)(vr + 32), v2 = *(const bf16x8*)(vr + 64), v3 = *(const bf16x8*)(vr + 96);
    O[d] = mfma32(v0, p0, O[d]);
    O[d] = mfma32(v1, p1, O[d]);
    O[d] = mfma32(v2, p2, O[d]);
    O[d] = mfma32(v3, p3, O[d]);
  }
}

DI void diff_job8(const Params& p, int layer, int b, int head, int qb, unsigned char* smem) {
  int tid_ = threadIdx.x; asm volatile("" : "+v"(tid_));
  const int tid = tid_, lane = tid & 63, wave = tid >> 6, h = lane >> 5, lq = lane & 31;
  const int map = wave >> 2, qg = wave & 3;
  const int t0 = qb * 128, tw0 = t0 + 32 * qg, tq = tw0 + lq;
  const float* lut = (const float*)(smem + LUT_OFF);
  build_lut(p, 4 + head, smem, tid);
  bf16x8 qf[4];
  {
    const u16* qr = p.qdf + (size_t)(b * TP + tq) * 512 + head * 128 + 64 * map + 8 * h;
#pragma unroll
    for (int s = 0; s < 4; ++s) qf[s] = *(const bf16x8*)(qr + 16 * s);
  }
  f32x16 O[4];
#pragma unroll
  for (int i = 0; i < 4; ++i) O[i] = zero16();
  float m = -1e30f, l = 0.f;
  const u16* K1 = p.kdf + (size_t)b * TP * 512 + head * 128;
  const u16* VT = p.vtdf + (size_t)(b * 512 + head * 128) * TP;
  const int ntile = 2 * (qb + 1);
  const int krow = tid >> 3, kc = tid & 7, krs = swap23(krow);
  u32x4 rk1, rk2, rv[2];
  auto gl = [&](int k0) {
    const u16* s = K1 + (size_t)(k0 + krow) * 512 + kc * 8;
    rk1 = *(const u32x4*)s; rk2 = *(const u32x4*)(s + 64);
#pragma unroll
    for (int i = 0; i < 2; ++i) rv[i] = *(const u32x4*)(VT + (size_t)(krow + 64 * i) * TP + k0 + kc * 8);
  };
  auto sl = [&](unsigned char* d) {
    *(u32x4*)(d + krs * 144 + kc * 16) = rk1;
    *(u32x4*)(d + 9216 + krs * 144 + kc * 16) = rk2;
#pragma unroll
    for (int i = 0; i < 2; ++i) *(u32x4*)(d + 18432 + (krow + 64 * i) * 144 + kc * 16) = rv[i];
  };
  gl(0); sl(smem);
  if (ntile > 1) gl(64);
  __syncthreads();
  const float cbias = lut[128];
  for (int j = 0; j < ntile; ++j) {
    __syncthreads();
    if (j + 1 < ntile) { sl(smem + ((j + 1) & 1) * 36864); if (j + 2 < ntile) gl((j + 2) * 64); }
    const unsigned char* sb = smem + (j & 1) * 36864;
    const unsigned char* sk = sb + 9216 * map;
    const int k0 = j * 64;
    if (tw0 - (k0 + 63) >= 113) {
      diff_map_far2(sk, qf, sb + 18432, cbias, h, lq, O, m, l);
    } else {
#pragma unroll 1
      for (int sub = 0; sub < 2; ++sub) {
        const int ks0 = k0 + sub * 32;
        if (ks0 > tw0 + 31) break;
        const bool far = (tw0 - (ks0 + 31)) >= 113;
        const bool diag = (ks0 + 31) > tw0;
        diff_map(sk + sub * 32 * 144, qf, sb + 18432 + sub * 64, lut, far, diag, ks0, tq, h, lq, O, m, l);
      }
    }
  }
  __syncthreads();
  float lam;
  const float lam_init = 0.8f - 0.6f * expf(-0.3f * (float)layer);
  {
    float a = p.lq1[layer * 64 + lane] * p.lk1[layer * 64 + lane];
    float c = p.lq2[layer * 64 + lane] * p.lk2[layer * 64 + lane];
    a = wave_sum(a); c = wave_sum(c);
    lam = expf(a) - expf(c) + lam_init;
  }
  l += __shfl_xor(l, 32);
  const float il = (map ? lam : 1.f) / l;
  float* X = (float*)smem + (size_t)(qg * 32 + lq) * 132;
  if (map == 1) {
#pragma unroll
    for (int d = 0; d < 4; ++d)
#pragma unroll
      for (int g = 0; g < 4; ++g) {
        float4 v = make_float4(O[d][4 * g] * il, O[d][4 * g + 1] * il, O[d][4 * g + 2] * il, O[d][4 * g + 3] * il);
        *(float4*)(X + 32 * d + 8 * g + 4 * h) = v;
      }
  }
  __syncthreads();
  if (map == 0) {
    float ss = 0.f;
#pragma unroll
    for (int d = 0; d < 4; ++d)
#pragma unroll
      for (int g = 0; g < 4; ++g) {
        const float4 v = *(const float4*)(X + 32 * d + 8 * g + 4 * h);
        float y0 = O[d][4 * g] * il - v.x, y1 = O[d][4 * g + 1] * il - v.y, y2 = O[d][4 * g + 2] * il - v.z, y3 = O[d][4 * g + 3] * il - v.w;
        O[d][4 * g] = y0; O[d][4 * g + 1] = y1; O[d][4 * g + 2] = y2; O[d][4 * g + 3] = y3;
        ss += y0 * y0 + y1 * y1 + y2 * y2 + y3 * y3;
      }
    ss += __shfl_xor(ss, 32);
    const float sc = rsqrtf(ss * (1.f / 128.f) + EPS) * (1.f - lam_init);
    const float* sg = p.subln + layer * 128;
    u16* yr = p.ydf + (size_t)(b * TP + tq) * 512 + head * 128;
#pragma unroll
    for (int d = 0; d < 4; ++d)
#pragma unroll
      for (int g = 0; g < 4; ++g) {
        const int dv = 32 * d + 8 * g + 4 * h;
        const float4 g4 = *(const float4*)(sg + dv);
        u32x2 pk = {pack2bf(O[d][4 * g] * sc * g4.x, O[d][4 * g + 1] * sc * g4.y),
                    pack2bf(O[d][4 * g + 2] * sc * g4.z, O[d][4 * g + 3] * sc * g4.w)};
        *(u32x2*)(yr + dv) = pk;
      }
  }
  __syncthreads();
}

DI void sparse_job(const Params& p, int layer, int b, int head, int qb, unsigned char* smem) {
  int tid_ = threadIdx.x & 255; asm volatile("" : "+v"(tid_));
  const int tid = tid_, lane = tid & 63, wave = tid >> 6, h = lane >> 5, lq = lane & 31;
  const int t0 = qb * 128, tw0 = t0 + 32 * wave, tq = tw0 + lq;
  const float* lut = (const float*)(smem + LUT_OFF);
  build_lut(p, head, smem, tid);
  bf16x8 qf[4];
  {
    const u16* qr = p.qsp + (size_t)(b * TP + tq) * 256 + head * 64 + 8 * h;
#pragma unroll
    for (int s = 0; s < 4; ++s) qf[s] = *(const bf16x8*)(qr + 16 * s);
  }
  f32x16 O[2] = {zero16(), zero16()};
  float m = -1e30f, l = 0.f;
  const u16* Kp = p.ksp + (size_t)b * TP * 256 + head * 64;
  const u16* VT = p.vtsp + (size_t)(b * 256 + head * 64) * TP;
  const u32* mrow = p.mask + (size_t)(b * TP + tq) * MW;
  const int ntile = 2 * (qb + 1);
  const float csc = 0.125f * LOG2E;
  u32x4 rk[2], rv[2];
  ld_tile_g<2>(rk, Kp, 256, 0, false, tid); ld_tile_g<2>(rv, VT, TP, 0, true, tid);
  u32x2 mnext = *(const u32x2*)(mrow);
  st_tile_s<2>(rk, smem, true, tid); st_tile_s<2>(rv, smem + 9216, false, tid);
  if (ntile > 1) { ld_tile_g<2>(rk, Kp, 256, 64, false, tid); ld_tile_g<2>(rv, VT, TP, 64, true, tid); }
  for (int j = 0; j < ntile; ++j) {
    const bool more = j + 1 < ntile;
    const u32x2 mcur = mnext;
    __syncthreads();
    if (more) {
      unsigned char* d = smem + ((j + 1) & 1) * 18432; st_tile_s<2>(rk, d, true, tid); st_tile_s<2>(rv, d + 9216, false, tid);
      mnext = *(const u32x2*)(mrow + 2 * (j + 1));
      if (j + 2 < ntile) { const int k0 = (j + 2) * 64; ld_tile_g<2>(rk, Kp, 256, k0, false, tid); ld_tile_g<2>(rv, VT, TP, k0, true, tid); }
    }
    const unsigned char* sb = smem + (j & 1) * 18432;
#pragma unroll 1
    for (int sub = 0; sub < 2; ++sub) {
      const int ks0 = j * 64 + sub * 32;
      if (ks0 > tw0 + 31) break;
      const u32 mw = sub ? mcur[1] : mcur[0];
      if (!__any(mw != 0u)) continue;
      f32x16 S = zero16();
#pragma unroll
      for (int s = 0; s < 4; ++s) {
        bf16x8 k1 = *(const bf16x8*)(sb + (sub * 32 + lq) * 144 + (16 * s + 8 * h) * 2);
        S = mfma32(k1, qf[s], S);
      }
      const bool far = (tw0 - (ks0 + 31)) >= 113;
      const float cbias = lut[128];
      const u32 sel16 = ((mw >> (8 * h)) & 0xffu) | (((mw >> (16 + 8 * h)) & 0xffu) << 8);
      if (far) {
        float mx = -1e30f;
#pragma unroll
        for (int i = 0; i < 16; ++i) mx = fmaxf(mx, (sel16 & (1u << i)) ? S[i] : -1e30f);
        mx = fmaxf(mx, __shfl_xor(mx, 32));
        const float mn = mx > -1e29f ? fmaxf(m, mx * csc + cbias) : m;
        if (__any(mn > m)) {
          const float a = __builtin_amdgcn_exp2f(m - mn);
          l *= a; O[0] *= a; O[1] *= a;
          m = mn;
        }
        const float off = cbias - m;
#pragma unroll
        for (int i = 0; i < 16; ++i) {
          float pv = (sel16 & (1u << i)) ? __builtin_amdgcn_exp2f(S[i] * csc + off) : 0.f;
          l += pv;
          S[i] = pv;
        }
      } else {
        float mx = -1e30f;
#pragma unroll
        for (int i = 0; i < 16; ++i) {
          const int ko = 16 * (i >> 3) + 8 * h + (i & 7);
          int d = tq - (ks0 + ko); d = d < 0 ? 0 : (d > 128 ? 128 : d);
          float x = S[i] * csc + lut[d];
          if (!(sel16 & (1u << i))) x = -1e30f;
          S[i] = x;
          mx = fmaxf(mx, x);
        }
        mx = fmaxf(mx, __shfl_xor(mx, 32));
        const float mn = fmaxf(m, mx);
        if (__any(mn > m)) {
          const float a = __builtin_amdgcn_exp2f(m - mn);
          l *= a; O[0] *= a; O[1] *= a;
          m = mn;
        }
#pragma unroll
        for (int i = 0; i < 16; ++i) {
          float pv = S[i] > -1e29f ? __builtin_amdgcn_exp2f(S[i] - m) : 0.f;
          l += pv;
          S[i] = pv;
        }
      }
      bf16x8 pa0 = pack8(S, 0), pa1 = pack8(S, 1);
#pragma unroll
      for (int d = 0; d < 2; ++d) {
        bf16x8 v0 = *(const bf16x8*)(sb + 9216 + (d * 32 + lq) * 144 + (sub * 32 + 8 * h) * 2);
        bf16x8 v1 = *(const bf16x8*)(sb + 9216 + (d * 32 + lq) * 144 + (sub * 32 + 16 + 8 * h) * 2);
        O[d] = mfma32(v0, pa0, O[d]);
        O[d] = mfma32(v1, pa1, O[d]);
      }
    }
  }
  __syncthreads();
  l += __shfl_xor(l, 32);
  const float il = 1.f / l;
  u16* yr = p.ysp + (size_t)(b * TP + tq) * 256 + head * 64;
#pragma unroll
  for (int d = 0; d < 2; ++d)
#pragma unroll
    for (int g = 0; g < 4; ++g) {
      u32x2 pk = {pack2bf(O[d][4 * g] * il, O[d][4 * g + 1] * il), pack2bf(O[d][4 * g + 2] * il, O[d][4 * g + 3] * il)};
      *(u32x2*)(yr + 32 * d + 8 * g + 4 * h) = pk;
    }
  __syncthreads();
}

DI void sb_job(const Params& p, int b, int head, int qb, unsigned char* smem) {
  int tid_ = threadIdx.x & 255; asm volatile("" : "+v"(tid_));
  const int tid = tid_, lane = tid & 63, wave = tid >> 6, h = lane >> 5, lq = lane & 31;
  const int t0 = qb * 128, tw0 = t0 + 32 * wave, tq = tw0 + lq;
  bf16x8 qf[4];
  {
    const u16* qr = p.qsb + (size_t)(b * TP + tq) * 256 + head * 64 + 8 * h;
#pragma unroll
    for (int s = 0; s < 4; ++s) qf[s] = *(const bf16x8*)(qr + 16 * s);
  }
  f32x16 O[2] = {zero16(), zero16()};
  float carry = 0.f;
  const u16* Kp = p.ksb + (size_t)b * TP * 256 + head * 64;
  const u16* VT = p.vtsb + (size_t)(b * 256 + head * 64) * TP;
  const int ntile = 2 * (qb + 1);
  u32x4 rk[2], rv[2];
  ld_tile_g<2>(rk, Kp, 256, (ntile - 1) * 64, false, tid); ld_tile_g<2>(rv, VT, TP, (ntile - 1) * 64, true, tid);
  st_tile_s<2>(rk, smem, true, tid); st_tile_s<2>(rv, smem + 9216, false, tid);
  __syncthreads();
  for (int jj = 0; jj < ntile; ++jj) {
    const int j = ntile - 1 - jj;
    const bool more = jj + 1 < ntile;
    if (more) { const int k0 = (j - 1) * 64; ld_tile_g<2>(rk, Kp, 256, k0, false, tid); ld_tile_g<2>(rv, VT, TP, k0, true, tid); }
    __builtin_amdgcn_sched_barrier(0);
    const unsigned char* sb = smem + (jj & 1) * 18432;
    const bool wdone = !__any(carry >= -104.f);
    if (!wdone) {
#pragma unroll 1
      for (int sub = 1; sub >= 0; --sub) {
        const int ks0 = j * 64 + sub * 32;
        if (ks0 > tw0) continue;
        f32x16 S = zero16();
#pragma unroll
        for (int s = 0; s < 4; ++s) {
          bf16x8 k1 = *(const bf16x8*)(sb + (sub * 32 + lq) * 144 + (16 * s + 8 * h) * 2);
          S = mfma32(k1, qf[s], S);
        }
        const bool diag = (ks0 + 31) >= tw0;
        float lsm[16];
        float sA = 0.f, sB = 0.f;
#pragma unroll
        for (int i = 0; i < 16; ++i) {
          const int key = ks0 + 16 * (i >> 3) + 8 * h + (i & 7);
          const float z = S[i] * 0.125f;
          const float sp = fmaxf(z, 0.f) + __logf(1.f + __expf(-fabsf(z)));
          const bool valid = !diag || key < tq;
          lsm[i] = valid ? -sp : 0.f;
          S[i] = valid ? z - sp : -1e30f;
          if (i < 8) sA += lsm[i]; else sB += lsm[i];
        }
        const float oA = __shfl_xor(sA, 32), oB = __shfl_xor(sB, 32);
        const float aboveB = h == 0 ? oB : 0.f;
        const float aboveA = h == 0 ? (oA + sB + oB) : (oB + sB);
        float run = carry + aboveB;
#pragma unroll
        for (int i = 15; i >= 8; --i) { float lw = S[i] + run; run += lsm[i]; S[i] = lw > -1e29f ? __expf(lw) : 0.f; }
        run = carry + aboveA;
#pragma unroll
        for (int i = 7; i >= 0; --i) { float lw = S[i] + run; run += lsm[i]; S[i] = lw > -1e29f ? __expf(lw) : 0.f; }
        carry += sA + sB + oA + oB;
        bf16x8 pa0 = pack8(S, 0), pa1 = pack8(S, 1);
#pragma unroll
        for (int d = 0; d < 2; ++d) {
          bf16x8 v0 = *(const bf16x8*)(sb + 9216 + (d * 32 + lq) * 144 + (sub * 32 + 8 * h) * 2);
          bf16x8 v1 = *(const bf16x8*)(sb + 9216 + (d * 32 + lq) * 144 + (sub * 32 + 16 + 8 * h) * 2);
          O[d] = mfma32(v0, pa0, O[d]);
          O[d] = mfma32(v1, pa1, O[d]);
        }
      }
    }
    if (more) { unsigned char* d = smem + ((jj + 1) & 1) * 18432; st_tile_s<2>(rk, d, true, tid); st_tile_s<2>(rv, d + 9216, false, tid); }
    const int alldone = __syncthreads_and((int)(!__any(carry >= -104.f)));
    if (alldone) break;
  }
  u16* yr = p.ysb + (size_t)(b * TP + tq) * 256 + head * 64;
#pragma unroll
  for (int d = 0; d < 2; ++d)
#pragma unroll
    for (int g = 0; g < 4; ++g) {
      u32x2 pk = {pack2bf(O[d][4 * g], O[d][4 * g + 1]), pack2bf(O[d][4 * g + 2], O[d][4 * g + 3])};
      *(u32x2*)(yr + 32 * d + 8 * g + 4 * h) = pk;
    }
  __syncthreads();
}

DI void idx_scan(const u32* hq, int need, u32* outbin, u32* outneed, int q, int lane) {
  u32 c = 0;
#pragma unroll
  for (int w = 0; w < 8; ++w) { u32 v = hq[8 * lane + w]; c += (v & 0xffffu) + (v >> 16); }
  u32 incl = c;
#pragma unroll
  for (int o = 1; o < 64; o <<= 1) { u32 v = __shfl_down(incl, o); if (lane + o < 64) incl += v; }
  const u32 above = incl - c;
  if ((int)above < need && need <= (int)incl) {
    u32 cum = above;
    for (int bin = 16 * lane + 15; bin >= 16 * lane; --bin) {
      u32 cnt = (hq[bin >> 1] >> ((bin & 1) * 16)) & 0xffffu;
      if ((int)(cum + cnt) >= need) { outbin[q] = (u32)bin; outneed[q] = (u32)need - cum; break; }
      cum += cnt;
    }
  }
}

template <int PASS, bool DIAG>
DI void idx_tile(const bf16x8 kf, const bf16x8 (&qf)[8], const float (&wq)[8], int kt, int lm, int lg, int tq, bool selall, u32 bA, u32 pfx,
                 u32* hist, u32* maskw, u32* cand, u32* ccnt) {
  const f32x4 z4 = {0.f, 0.f, 0.f, 0.f};
  f32x4 sc = z4;
#pragma unroll
  for (int j = 0; j < 8; ++j) {
    f32x4 d = mfma16(kf, qf[j], z4);
#pragma unroll
    for (int r = 0; r < 4; ++r) sc[r] += wq[j] * fmaxf(d[r], 0.f);
  }
  u32 selbits = 0u;
#pragma unroll
  for (int r = 0; r < 4; ++r) {
    const int key = kt * 16 + lg * 4 + r;
    const bool valid = !DIAG || key <= tq;
    const u32 bits = __float_as_uint(sc[r]);
    const u32 u = bits ^ ((u32)((int)bits >> 31) | 0x80000000u);
    if (PASS == 0) {
      if (valid) { const u32 bin = u >> 22; atomicAdd(&hist[lm * 512 + (bin >> 1)], 1u << ((bin & 1) * 16)); }
    } else if (PASS == 1) {
      if (valid && (u >> 22) == bA) { const u32 bin = (u >> 12) & 1023u; atomicAdd(&hist[lm * 512 + (bin >> 1)], 1u << ((bin & 1) * 16)); }
    } else {
      const u32 pp = u >> 12;
      if (valid && (selall || pp > pfx)) selbits |= 1u << r;
      if (valid && !selall && pp == pfx) {
        const u32 ix = atomicAdd(&ccnt[lm], 1u);
        if (ix < 64u) { cand[(lm * 64 + ix) * 2] = u; cand[(lm * 64 + ix) * 2 + 1] = (u32)key; }
      }
    }
  }
  if (PASS == 2 && selbits) {
    const int kb = kt * 16 + lg * 4;
    atomicOr(&maskw[lm * MW + (kb >> 5)], selbits << (kb & 31));
  }
}
template <int PASS>
DI void idx_pass(const u16* kp, const bf16x8 (&qf)[8], const float (&wq)[8], int wave, int ntile, int lm, int lg, int tq, bool selall,
                 u32 bA, u32 pfx, u32* hist, u32* maskw, u32* cand, u32* ccnt) {
  auto ldk = [&](int t) { return *(const bf16x8*)(kp + (size_t)(t < ntile ? t : 0) * 512); };
  int kt = wave;
  bf16x8 ka = ldk(kt), kb = ldk(kt + 4);
  for (; kt + 4 < ntile - 1; kt += 8) {
    const bf16x8 kc = ldk(kt + 8), kd = ldk(kt + 12);
    idx_tile<PASS, false>(ka, qf, wq, kt, lm, lg, tq, selall, bA, pfx, hist, maskw, cand, ccnt);
    idx_tile<PASS, false>(kb, qf, wq, kt + 4, lm, lg, tq, selall, bA, pfx, hist, maskw, cand, ccnt);
    ka = kc; kb = kd;
  }
  if (kt < ntile - 1) { idx_tile<PASS, false>(ka, qf, wq, kt, lm, lg, tq, selall, bA, pfx, hist, maskw, cand, ccnt); kt += 4; ka = kb; }
  if (kt == ntile - 1) idx_tile<PASS, true>(ka, qf, wq, kt, lm, lg, tq, selall, bA, pfx, hist, maskw, cand, ccnt);
}

DI void idx_job(const Params& p, int b, int qg, unsigned char* smem) {
  int tid_ = threadIdx.x & 255; asm volatile("" : "+v"(tid_));
  const int tid = tid_, lane = tid & 63, wave = tid >> 6, lm = lane & 15, lg = lane >> 4;
  u32* hist = (u32*)smem;
  u32* maskw = (u32*)(smem + 32768);
  u32* cand = (u32*)(smem + 41216);
  u32* ccnt = (u32*)(smem + 49408);
  u32* binA = ccnt + 16; u32* needB = ccnt + 32; u32* binB = ccnt + 48; u32* needC = ccnt + 64;
  const int t0 = qg * 16, ntile = qg + 1, tq = t0 + lm;
  const bool selall = tq + 1 <= 256;
  bf16x8 qf[8];
  float wq[8];
  {
    const u16* qr = p.qix + (size_t)(b * TP + tq) * 256 + lg * 8;
    const float* wr = p.wix + (size_t)(b * TP + tq) * 8;
#pragma unroll
    for (int j = 0; j < 8; ++j) { qf[j] = *(const bf16x8*)(qr + j * 32); wq[j] = wr[j]; }
  }
  for (int i = tid; i < 8192 + 2112; i += 256) hist[i] = 0u;
  if (tid < 80) ccnt[tid] = 0u;
  __syncthreads();
  const u16* kbase = p.kix + (size_t)b * TP * 32;
  const f32x4 z4 = {0.f, 0.f, 0.f, 0.f};
  const u16* kp = kbase + (size_t)lm * 32 + lg * 8;
  idx_pass<0>(kp, qf, wq, wave, ntile, lm, lg, tq, selall, 0u, 0u, hist, maskw, cand, ccnt);
  __syncthreads();
  for (int qq = 0; qq < 4; ++qq) idx_scan(hist + (wave * 4 + qq) * 512, 256, binA, needB, wave * 4 + qq, lane);
  __syncthreads();
  for (int i = tid; i < 8192; i += 256) hist[i] = 0u;
  __syncthreads();
  idx_pass<1>(kp, qf, wq, wave, ntile, lm, lg, tq, selall, binA[lm], 0u, hist, maskw, cand, ccnt);
  __syncthreads();
  for (int qq = 0; qq < 4; ++qq) idx_scan(hist + (wave * 4 + qq) * 512, (int)needB[wave * 4 + qq], binB, needC, wave * 4 + qq, lane);
  __syncthreads();
  idx_pass<2>(kp, qf, wq, wave, ntile, lm, lg, tq, selall, binA[lm], (binA[lm] << 10) | binB[lm], hist, maskw, cand, ccnt);
  __syncthreads();
  {
    const int q = tid >> 4, i0 = tid & 15;
    u32 cnt = ccnt[q]; if (cnt > 64u) cnt = 64u;
    const u32 need = needC[q];
    for (u32 c = i0; c < cnt; c += 16) {
      const u32 u = cand[(q * 64 + c) * 2], key = cand[(q * 64 + c) * 2 + 1];
      u32 rank = 0;
      for (u32 e = 0; e < cnt; ++e) {
        const u32 u2 = cand[(q * 64 + e) * 2], k2 = cand[(q * 64 + e) * 2 + 1];
        rank += (u2 > u || (u2 == u && k2 < key)) ? 1u : 0u;
      }
      if (rank < need) atomicOr(&maskw[q * MW + (key >> 5)], 1u << (key & 31));
    }
  }
  __syncthreads();
  for (int i = tid; i < 16 * MW; i += 256) p.mask[(size_t)(b * TP + t0) * MW + i] = maskw[i];
  __syncthreads();
}

DI int next_job(u32* ctr, unsigned char* smem) {
  int* sj = (int*)(smem + SJOB_OFF);
  __syncthreads();
  if (threadIdx.x == 0) *sj = (int)atomicAdd(ctr, 1u);
  __syncthreads();
  return *sj;
}

DI void phase_attn(const Params& p, int layer, int phase, unsigned char* smem) {
  u32* ctr = p.ctr + phase;
  for (;;) {
    const int jp = next_job(ctr, smem);
    if (jp >= 2640) break;
    if (jp < 1056) { const int qb = 32 - jp / 32, r = jp & 31; diff_job8(p, layer, r >> 2, r & 3, qb, smem); continue; }
    int half = threadIdx.x >> 8; asm volatile("" : "+v"(half));
    unsigned char* sm = smem + half * HALF_BYTES;
    const int job = 2 * (jp - 1056) + half;
    if (job < 2112) { idx_job(p, job & 7, 263 - (job >> 3), sm); }
    else { const int i = job - 2112; const int qb = 32 - i / 32, r = i & 31; sb_job(p, r >> 2, r & 3, qb, sm); }
  }
}
DI void phase_sparse(const Params& p, int layer, int phase, unsigned char* smem) {
  u32* ctr = p.ctr + phase;
  for (;;) {
    const int jp = next_job(ctr, smem);
    if (jp >= 528) break;
    int half = threadIdx.x >> 8; asm volatile("" : "+v"(half));
    unsigned char* sm = smem + half * HALF_BYTES;
    const int job = 2 * jp + half;
    const int qb = 32 - job / 32, r = job & 31;
    sparse_job(p, layer, r >> 2, r & 3, qb, sm);
  }
}

DI void run_phase(const Params& p, int ph, unsigned char* smem, int rep = 0) {
  if (ph == 0) { phase_prep(p, smem); return; }
  const int layer = (ph - 1) / 7, s = (ph - 1) % 7;
  const u16* WL = p.wts + (size_t)layer * LAYER_W;
  switch (s) {
    case 0: phase_g1(p, layer, smem); break;
    case 1: phase_attn(p, layer, ph + 16 * rep, smem); break;
    case 2: phase_sparse(p, layer, ph + 16 * rep, smem); break;
    case 3: phase_merge(p, layer, smem); break;
    case 4: phase_resid(p, layer == 0 ? 1 : 0, p.merged, DM, WL + OFF_OUT, p.rowss + (size_t)(2 * layer + 1) * R, false, smem); break;
    case 5: phase_ffnup(p, layer, smem); break;
    default: phase_resid(p, 2, p.act, DFF, WL + OFF_DOWN, p.rowss + (size_t)(2 * layer + 2) * R, layer == 1, smem); break;
  }
}


#define XB_TMO      128
#define XB_XCNT(j)  (256  + 64 * (j))
#define XB_XSUB(j)  (1280 + 64 * (j))
#define XB_XGEN(j)  (2304 + 64 * (j))
#define XB_TOP      3328
#define XB_TOPGEN   3392
#define XCD_BAR_WORDS 3456
#define XB_SPIN_CAP (1u << 20)
#define LAS __attribute__((address_space(3)))
DI unsigned xb_ld(unsigned* p) { return __hip_atomic_load(p, __ATOMIC_RELAXED, __HIP_MEMORY_SCOPE_AGENT); }
DI unsigned xb_add(unsigned* p, unsigned v) { return __hip_atomic_fetch_add(p, v, __ATOMIC_RELAXED, __HIP_MEMORY_SCOPE_AGENT); }
DI unsigned xb_xcc_id() { return (unsigned)__builtin_amdgcn_s_getreg((3 << 11) | 20) & 0xFu; }
#define XB_SPIN(cond, bar) do { unsigned _sp = 0; while (cond) { __builtin_amdgcn_s_sleep(1); \
    if ((++_sp & 255u) == 0u) { if (xb_ld(&(bar)[XB_TMO])) break; if (_sp > XB_SPIN_CAP) { atomicAdd(&(bar)[XB_TMO], 1u); break; } } } } while (0)
struct XcdBarrier { unsigned* bar; unsigned x; volatile LAS unsigned* st; };
DI XcdBarrier xcd_barrier_post(unsigned* bar, volatile LAS unsigned* st) {
  XcdBarrier b; b.bar = bar; b.x = xb_xcc_id(); b.st = st;
  if (threadIdx.x == 0) (void)xb_add(&bar[XB_XCNT(b.x)], 1u);
  return b;
}
DI void xcd_barrier_complete(unsigned* bar, unsigned x, unsigned& nloc, unsigned& nx) {
  const unsigned G = gridDim.x * gridDim.y * gridDim.z;
  unsigned sum, cnt, mine, sp = 0u;
  for (;;) {
    sum = 0u; cnt = 0u; mine = 0u;
#pragma unroll
    for (unsigned j = 0; j < 16; ++j) { const unsigned c = xb_ld(&bar[XB_XCNT(j)]); sum += c; cnt += (c > 0u) ? 1u : 0u; mine = (j == x) ? c : mine; }
    if (sum == G) break;
    __builtin_amdgcn_s_sleep(1);
    if ((++sp & 255u) == 0u) { if (xb_ld(&bar[XB_TMO])) break; if (sp > XB_SPIN_CAP) { atomicAdd(&bar[XB_TMO], 1u); break; } }
  }
  nloc = mine > 0u ? mine : 1u; nx = cnt > 0u ? cnt : 1u;
}
DI void xcd_barrier(const XcdBarrier& b) {
  asm volatile("s_waitcnt vmcnt(0)" ::: "memory");
  __syncthreads();
  if (threadIdx.x == 0) {
    unsigned* bar = b.bar;
    __builtin_amdgcn_s_waitcnt(0);
    unsigned nloc = b.st[0], nx = b.st[1];
    if (nloc == 0u) { xcd_barrier_complete(bar, b.x, nloc, nx); b.st[0] = nloc; b.st[1] = nx; }
    const unsigned old = xb_add(&bar[XB_XSUB(b.x)], 1u);
    const unsigned gen = old / nloc;
    if (old + 1u == (gen + 1u) * nloc) {
      __builtin_amdgcn_fence(__ATOMIC_RELEASE, "agent");
      asm volatile("s_waitcnt vmcnt(0)" ::: "memory");
      const unsigned og = xb_add(&bar[XB_TOP], 1u);
      const unsigned tg = og / nx;
      if (og + 1u == (tg + 1u) * nx) xb_add(&bar[XB_TOPGEN], 1u);
      else XB_SPIN(xb_ld(&bar[XB_TOPGEN]) == tg, bar);
      __builtin_amdgcn_fence(__ATOMIC_ACQUIRE, "agent");
      xb_add(&bar[XB_XGEN(b.x)], 1u);
      asm volatile("s_waitcnt vmcnt(0)" ::: "memory");
    } else {
      XB_SPIN(xb_ld(&bar[XB_XGEN(b.x)]) == gen, bar);
      __builtin_amdgcn_fence(__ATOMIC_ACQUIRE, "agent");
      asm volatile("s_waitcnt vmcnt(0)" ::: "memory");
    }
  }
  __syncthreads();
}

constexpr int NPHASE = 15;

__global__ void __launch_bounds__(512) mega(Params p, int ph_lo, int ph_hi) {
  __shared__ __attribute__((aligned(16))) unsigned char smem[SMEM_BYTES];
  volatile LAS unsigned* xst = (volatile LAS unsigned*)(smem + (SMEM_BYTES - 16));
  if (threadIdx.x == 0) { xst[0] = 0u; xst[1] = 0u; }
  __syncthreads();
  const XcdBarrier xb = xcd_barrier_post(p.bar, xst);
  for (int ph = ph_lo; ph < ph_hi; ++ph) {
    run_phase(p, ph, smem);
#ifdef PROBE_MASK
    if (ph > 0 && ((PROBE_MASK >> ((ph - 1) % 7)) & 1)) { cg::this_grid().sync(); run_phase(p, ph, smem, 1); }
#endif
    if (ph + 1 < ph_hi) { if (ph_hi > 1000) cg::this_grid().sync(); else xcd_barrier(xb); }
  }
}

extern "C" void kernel_launch(void* const* d_in, const int* in_sizes, int n_in, void* d_out, int out_size, void* d_ws,
                              size_t ws_size, hipStream_t stream) {
  Params p{};
  const float* const* in = (const float* const*)d_in;
  p.x = in[0]; p.meta = in[1]; p.rel_bias = in[2]; p.attn_norm = in[3]; p.w_in = in[4]; p.b_gate = in[5];
  p.qn_sp = in[6]; p.kn_sp = in[7]; p.qn_df = in[8]; p.kn_df = in[9]; p.lq1 = in[10]; p.lk1 = in[11]; p.lq2 = in[12];
  p.lk2 = in[13]; p.subln = in[14]; p.w_br_sb = in[15]; p.w_br_sp = in[16]; p.w_br_df = in[17]; p.w_out = in[18];
  p.ffn_norm = in[19]; p.w_up = in[20]; p.conv_w = in[21]; p.conv_b = in[22]; p.w_down = in[23];
  p.out = (float*)d_out;
  unsigned char* w = (unsigned char*)d_ws;
  size_t off = 0;
  auto take = [&](size_t bytes) { unsigned char* r = w + off; off += (bytes + 255) & ~(size_t)255; return r; };
  p.ctr = (u32*)take(256);
  p.bar = (u32*)take((size_t)XCD_BAR_WORDS * 4);
  p.hb = (u16*)take((size_t)(R + 512) * DM * 2) + (size_t)256 * DM;
  p.rowss = (float*)take((size_t)4 * R * 4);
  p.side = (float*)take((size_t)NB * 128 * DM * 4);
  p.wts = (u16*)take((size_t)2 * LAYER_W * 2);
  p.mask = (u32*)take((size_t)R * MW * 4);
  unsigned char* region = w + off;
  p.qsb = (u16*)take((size_t)R * 256 * 2); p.ksb = (u16*)take((size_t)R * 256 * 2);
  p.qsp = (u16*)take((size_t)R * 256 * 2); p.ksp = (u16*)take((size_t)R * 256 * 2);
  p.qdf = (u16*)take((size_t)R * 512 * 2); p.kdf = (u16*)take((size_t)R * 512 * 2);
  p.vtsb = (u16*)take((size_t)R * 256 * 2); p.vtsp = (u16*)take((size_t)R * 256 * 2); p.vtdf = (u16*)take((size_t)R * 512 * 2);
  p.qix = (u16*)take((size_t)R * 256 * 2); p.kix = (u16*)take((size_t)R * 32 * 2); p.wix = (float*)take((size_t)R * 8 * 4);
  p.ysb = (u16*)take((size_t)R * 256 * 2); p.ysp = (u16*)take((size_t)R * 256 * 2); p.ydf = (u16*)take((size_t)R * 512 * 2);
  p.merged = (u16*)region;
  p.act = (u16*)region;
  if (off > ws_size) { fprintf(stderr, "workspace too small: need %zu have %zu\n", off, ws_size); return; }
#if FUSED
  static int grid_blocks = 0;
  if (!grid_blocks) {
    int dev = 0, cus = 0, per_cu = 0;
    hipGetDevice(&dev);
    hipDeviceGetAttribute(&cus, hipDeviceAttributeMultiprocessorCount, dev);
    hipOccupancyMaxActiveBlocksPerMultiprocessor(&per_cu, mega, 512, 0);
    if (per_cu > 1) per_cu = 1;
    grid_blocks = cus * per_cu;
  }
  int lo = 0, hi = NPHASE;
  (void)hipMemsetAsync(p.bar, 0, (size_t)XCD_BAR_WORDS * 4, stream);
  void* args[] = {&p, &lo, &hi};
  hipError_t e = hipLaunchCooperativeKernel((void*)mega, dim3(grid_blocks), dim3(512), args, 0, stream);
  if (e != hipSuccess) fprintf(stderr, "cooperative launch failed: %s (grid %d)\n", hipGetErrorString(e), grid_blocks);
#else
  for (int ph = 0; ph < NPHASE; ++ph) mega<<<256, 512, 0, stream>>>(p, ph, ph + 1);
#endif
}
```

```cpp
#include <hip/hip_runtime.h>
#include <hip/hip_cooperative_groups.h>
#include <cstdio>
namespace cg = cooperative_groups;

#ifndef FUSED
#define FUSED 1
#endif

#define DI __device__ __forceinline__
typedef unsigned short u16;
typedef unsigned int u32;
using bf16x8 = __attribute__((ext_vector_type(8))) short;
using f32x4 = __attribute__((ext_vector_type(4))) float;
using f32x16 = __attribute__((ext_vector_type(16))) float;
using u32x4 = __attribute__((ext_vector_type(4))) unsigned;
using u32x2 = __attribute__((ext_vector_type(2))) unsigned;
typedef __bf16 bf2_t __attribute__((ext_vector_type(2)));
typedef float f2_t __attribute__((ext_vector_type(2)));

constexpr int NB = 8, SEQ = 4096, DM = 1024, TP = 4224, TREAL = 4112, NMETA = 16, R = NB * TP;
constexpr int DFF = 2816, DIN = 6440, MW = 132;
constexpr float EPS = 1e-6f;
constexpr float LOG2E = 1.4426950408889634f;
constexpr int HALF_BYTES = 75776;
constexpr int SMEM_BYTES = 2 * HALF_BYTES;
constexpr int LUT_OFF = 73728;
constexpr int SJOB_OFF = 75000;

constexpr int NWIN = 3584;
constexpr size_t OFF_WIN = 0, OFF_WG = OFF_WIN + (size_t)NWIN * 1024, OFF_BRSB = OFF_WG + (size_t)3072 * 1024, OFF_BRSP = OFF_BRSB + 262144,
                 OFF_BRDF = OFF_BRSP + 262144, OFF_OUT = OFF_BRDF + 524288, OFF_UP = OFF_OUT + 1048576, OFF_DOWN = OFF_UP + (size_t)5632 * 1024,
                 LAYER_W = OFF_DOWN + (size_t)1024 * 2816;

struct Params {
  const float *x, *meta, *rel_bias, *attn_norm, *w_in, *b_gate, *qn_sp, *kn_sp, *qn_df, *kn_df, *lq1, *lk1, *lq2, *lk2,
      *subln, *w_br_sb, *w_br_sp, *w_br_df, *w_out, *ffn_norm, *w_up, *conv_w, *conv_b, *w_down;
  float* out;
  u16* hb; float* rowss; float* side; u16* wts;
  u16 *qsb, *ksb, *qsp, *ksp, *qdf, *kdf, *vtsb, *vtsp, *vtdf, *qix, *kix; float* wix;
  u16 *ysb, *ysp, *ydf; u32* mask; u16* merged; u16* act; u32* ctr; u32* bar;
};

DI u32 pack2bf(float a, float b) {
  f2_t v = {a, b};
  bf2_t r = __builtin_convertvector(v, bf2_t);
  return __builtin_bit_cast(u32, r);
}
DI u16 f2bf(float a) { return (u16)(pack2bf(a, 0.f) & 0xffffu); }
DI float wave_sum(float v) {
#pragma unroll
  for (int o = 32; o; o >>= 1) v += __shfl_xor(v, o);
  return v;
}
DI f32x4 mfma16(bf16x8 a, bf16x8 b, f32x4 c) { return __builtin_amdgcn_mfma_f32_16x16x32_bf16(a, b, c, 0, 0, 0); }
DI f32x16 mfma32(bf16x8 a, bf16x8 b, f32x16 c) { return __builtin_amdgcn_mfma_f32_32x32x16_bf16(a, b, c, 0, 0, 0); }

DI int vblock() {
  int g = gridDim.x, b = blockIdx.x;
  if ((g & 7) == 0) return (b & 7) * (g >> 3) + (b >> 3);
  return b;
}

DI float* hrow_w(const Params& p, int gr) {
  int b = gr / TP, t = gr - b * TP;
  if (t >= NMETA && t < TREAL) return p.out + ((size_t)(b * SEQ + t - NMETA)) * DM;
  int s = t < NMETA ? t : t - TREAL + NMETA;
  return p.side + ((size_t)(b * 128 + s)) * DM;
}
DI const float* hrow_r(const Params& p, int layer, int gr) {
  int b = gr / TP, t = gr - b * TP;
  if (t >= NMETA && t < TREAL) {
    size_t o = ((size_t)(b * SEQ + t - NMETA)) * DM;
    return layer == 0 ? p.x + o : p.out + o;
  }
  int s = t < NMETA ? t : t - TREAL + NMETA;
  return p.side + ((size_t)(b * 128 + s)) * DM;
}

DI int wt_srccol(int kind, int n) {
  if (kind == 0) {
    if (n < 1536) return n;
    if (n < 3072) return 1832 + n - 1536;
    if (n < 3328) return 1536 + n - 3072;
    if (n < 3360) return 1792 + n - 3328;
    if (n < 3368) return 1824 + n - 3360;
    return -1;
  }
  if (kind == 1) return 3368 + n;
  if (kind == 6) {
    int j = n >> 8, w = n & 255, wn = w >> 7, ni = (w & 127) >> 4, c = w & 15;
    int ff = 128 * j + 64 * wn + 16 * (ni >> 1) + c;
    return (ni & 1) ? DFF + ff : ff;
  }
  return n;
}

DI void phase_prep(const Params& p, unsigned char* smem) {
  int tid_ = threadIdx.x; asm volatile("" : "+v"(tid_));
  const int tid = tid_, wave = tid >> 6, lane = tid & 63;
  for (int gr = blockIdx.x * 8 + wave; gr < R; gr += gridDim.x * 8) {
    int b = gr / TP, t = gr - b * TP;
    const float* src = nullptr;
    if (t < NMETA) src = p.meta + (size_t)t * DM;
    else if (t < TREAL) src = p.x + ((size_t)(b * SEQ + t - NMETA)) * DM;
    float4 v[4];
    float ss = 0.f;
#pragma unroll
    for (int i = 0; i < 4; ++i) {
      v[i] = src ? ((const float4*)src)[lane + 64 * i] : make_float4(0.f, 0.f, 0.f, 0.f);
      ss += v[i].x * v[i].x + v[i].y * v[i].y + v[i].z * v[i].z + v[i].w * v[i].w;
    }
    ss = wave_sum(ss);
#pragma unroll
    for (int i = 0; i < 4; ++i) {
      u32x2 pk = {pack2bf(v[i].x, v[i].y), pack2bf(v[i].z, v[i].w)};
      *(u32x2*)(p.hb + (size_t)gr * DM + (lane + 64 * i) * 4) = pk;
    }
    if (lane == 0) { p.rowss[gr] = ss; p.rowss[R + gr] = 0.f; p.rowss[2 * R + gr] = 0.f; p.rowss[3 * R + gr] = 0.f; }
    if (t < NMETA || t >= TREAL) {
      int s = t < NMETA ? t : t - TREAL + NMETA;
      float* d = p.side + ((size_t)(b * 128 + s)) * DM;
#pragma unroll
      for (int i = 0; i < 4; ++i) ((float4*)d)[lane + 64 * i] = v[i];
    }
  }
  if (blockIdx.x == 0 && tid < 64) p.ctr[tid] = 0;
  for (int i = blockIdx.x * 512 + tid; i < 2 * 256 * DM / 8; i += gridDim.x * 512) {
    const int hf = i / (256 * DM / 8), o = i - hf * (256 * DM / 8);
    u16* d = hf ? p.hb + (size_t)R * DM : p.hb - (size_t)256 * DM;
    *(u32x4*)(d + (size_t)o * 8) = u32x4{0u, 0u, 0u, 0u};
  }
  const int half = tid >> 8, t2 = tid & 255;
  float* tl = (float*)(smem + half * HALF_BYTES);
  constexpr int NK[8] = {NWIN, 3072, 1024, 1024, 1024, 1024, 5632, 1024};
  constexpr int KK[8] = {1024, 1024, 256, 256, 512, 1024, 1024, 2816};
  int total = 0;
  int cum[9];
  cum[0] = 0;
#pragma unroll
  for (int k = 0; k < 8; ++k) { total += (NK[k] / 64) * (KK[k] / 64); cum[k + 1] = total; }
  for (int jp = blockIdx.x; 2 * jp < 2 * total; jp += gridDim.x) {
    const int job = 2 * jp + half;
    const bool act = job < 2 * total;
    int layer = job >= total ? 1 : 0;
    int j = job - layer * total;
    int kind = 0;
#pragma unroll
    for (int k = 1; k < 8; ++k) if (j >= cum[k]) kind = k;
    int jj = j;
    int K = 1024, ld = 1024;
    const float* src = p.w_in; const float* gain = nullptr; u16* dst = p.wts + (size_t)layer * LAYER_W;
    switch (kind) {
      case 0: jj -= cum[0]; K = 1024; ld = DIN; src = p.w_in + (size_t)layer * DM * DIN; gain = p.attn_norm + layer * DM; dst += OFF_WIN; break;
      case 1: jj -= cum[1]; K = 1024; ld = DIN; src = p.w_in + (size_t)layer * DM * DIN; gain = p.attn_norm + layer * DM; dst += OFF_WG; break;
      case 2: jj -= cum[2]; K = 256; ld = 1024; src = p.w_br_sb + (size_t)layer * 256 * 1024; dst += OFF_BRSB; break;
      case 3: jj -= cum[3]; K = 256; ld = 1024; src = p.w_br_sp + (size_t)layer * 256 * 1024; dst += OFF_BRSP; break;
      case 4: jj -= cum[4]; K = 512; ld = 1024; src = p.w_br_df + (size_t)layer * 512 * 1024; dst += OFF_BRDF; break;
      case 5: jj -= cum[5]; K = 1024; ld = 1024; src = p.w_out + (size_t)layer * 1024 * 1024; dst += OFF_OUT; break;
      case 6: jj -= cum[6]; K = 1024; ld = 2 * DFF; src = p.w_up + (size_t)layer * DM * 2 * DFF; gain = p.ffn_norm + layer * DM; dst += OFF_UP; break;
      default: jj -= cum[7]; K = DFF; ld = 1024; src = p.w_down + (size_t)layer * DFF * 1024; dst += OFF_DOWN; break;
    }
    int nkt = K / 64;
    int n0 = (jj / nkt) * 64, k0 = (jj % nkt) * 64;
    if (act) {
      const int nn = t2 & 63, kq = t2 >> 6;
      const int col = wt_srccol(kind, n0 + nn);
      const float* sp = src + (size_t)(k0 + kq) * ld + (col >= 0 ? col : 0);
      float v[16];
#pragma unroll
      for (int i = 0; i < 16; ++i) v[i] = sp[(size_t)(4 * i) * ld];
#pragma unroll
      for (int i = 0; i < 16; ++i) {
        float x = col >= 0 ? v[i] : 0.f;
        if (gain) x *= gain[k0 + kq + 4 * i];
        tl[nn * 65 + kq + 4 * i] = x;
      }
    }
    __syncthreads();
    if (act) {
#pragma unroll
      for (int i = 0; i < 2; ++i) {
        int idx = t2 + 256 * i, nn = idx >> 3, c = idx & 7;
        const float* s = tl + nn * 65 + c * 8;
        u32x4 pk = {pack2bf(s[0], s[1]), pack2bf(s[2], s[3]), pack2bf(s[4], s[5]), pack2bf(s[6], s[7])};
        *(u32x4*)(dst + (size_t)(n0 + nn) * K + k0 + c * 8) = pk;
      }
    }
    __syncthreads();
  }
}

template <int MI, int NI>
DI void gemm_kloop(const u16* Au, int lda, const u16* Bu, int ldb, int K, f32x4 (&acc)[NI][MI], unsigned char* smem) {
  int tid_ = threadIdx.x; asm volatile("" : "+v"(tid_));
  const int tid = tid_, lane = tid & 63, wave = tid >> 6, wm = wave >> 1, wn = wave & 1;
  const int lr = tid >> 3, lc = tid & 7;
  const int voa = lr * lda + lc * 8, vob = lr * ldb + lc * 8;
  constexpr int NB2 = NI / 2;
  u32x4 ra[MI], rb[NB2];
  const int nk = K >> 6;
  const int fsw = (lane & 15) >> 1;
  const int fro0 = (lane & 15) * 128 + (((lane >> 4) ^ fsw) << 4);
  const int fro1 = (lane & 15) * 128 + ((((lane >> 4) + 4) ^ fsw) << 4);
  const int wof = lr * 128 + ((lc ^ ((lr >> 1) & 7)) << 4);
#define GLOAD(K0)                                                                                        \
  {                                                                                                      \
    _Pragma("unroll") for (int q = 0; q < MI; ++q) ra[q] = *(const u32x4*)((Au + (size_t)(q * 64) * lda + (K0)) + voa); \
    _Pragma("unroll") for (int q = 0; q < NB2; ++q) rb[q] = *(const u32x4*)((Bu + (size_t)(q * 64) * ldb + (K0)) + vob); \
  }
#define SWRITE(BUF)                                                                                      \
  {                                                                                                      \
    unsigned char* d_ = smem + (BUF) * 65536 + wof;                                                      \
    _Pragma("unroll") for (int q = 0; q < MI; ++q) *(u32x4*)(d_ + q * 8192) = ra[q];                     \
    _Pragma("unroll") for (int q = 0; q < NB2; ++q) *(u32x4*)(d_ + 32768 + q * 8192) = rb[q];            \
  }
  GLOAD(0);
  SWRITE(0);
  if (nk > 1) GLOAD(64);
  for (int kt = 0; kt < nk; ++kt) {
    __syncthreads();
    if (kt + 1 < nk) {
      SWRITE((kt + 1) & 1);
      if (kt + 2 < nk) GLOAD((kt + 2) << 6);
    }
    {
      const unsigned char* sa = smem + (kt & 1) * 65536;
      const unsigned char* sb = sa + 32768;
#pragma unroll
      for (int ks = 0; ks < 2; ++ks) {
        const int fo = ks ? fro1 : fro0;
        bf16x8 af[MI];
#pragma unroll
        for (int i = 0; i < MI; ++i) af[i] = *(const bf16x8*)(sa + (wm * 16 * MI + i * 16) * 128 + fo);
#pragma unroll
        for (int nh = 0; nh < NI; nh += 4) {
          bf16x8 wf[4];
#pragma unroll
          for (int i = 0; i < 4; ++i) wf[i] = *(const bf16x8*)(sb + (wn * 16 * NI + (nh + i) * 16) * 128 + fo);
#pragma unroll
          for (int ni = 0; ni < 4; ++ni)
#pragma unroll
            for (int mi = 0; mi < MI; ++mi) acc[nh + ni][mi] = mfma16(wf[ni], af[mi], acc[nh + ni][mi]);
        }
      }
    }
  }
  __syncthreads();
#undef GLOAD
#undef SWRITE
}

template <int MI, int NI>
DI void zero_acc(f32x4 (&acc)[NI][MI]) {
#pragma unroll
  for (int i = 0; i < NI; ++i)
#pragma unroll
    for (int j = 0; j < MI; ++j) acc[i][j] = f32x4{0.f, 0.f, 0.f, 0.f};
}

DI void phase_g1(const Params& p, int layer, unsigned char* smem) {
  int tid_ = threadIdx.x; asm volatile("" : "+v"(tid_));
  const int tid = tid_, lane = tid & 63, wave = tid >> 6, wm = wave >> 1, wn = wave & 1;
  const int lr = tid >> 3, lc = tid & 7, lm = lane & 15, lg = lane >> 4;
  const u16* W = p.wts + (size_t)layer * LAYER_W + OFF_WIN;
  const float* rowss = p.rowss + (size_t)(2 * layer) * R;
  constexpr int NT = 13, NTILES = 132 * NT;
  for (int it = vblock(); it < NTILES; it += gridDim.x) {
    const int g = it / (4 * NT), rem = it - g * (4 * NT), nt = rem >> 2, mt = g * 4 + (rem & 3);
    f32x4 acc[8][4];
    zero_acc<4, 8>(acc);
    gemm_kloop<4, 8>(p.hb + (size_t)(mt * 256) * DM, DM, W + (size_t)(nt * 256) * DM, DM, DM, acc, smem);
    int mrow[4];
#pragma unroll
    for (int mi = 0; mi < 4; ++mi) {
      mrow[mi] = mt * 256 + wm * 64 + mi * 16 + lm;
      float rs = rsqrtf(rowss[mrow[mi]] * (1.f / DM) + EPS);
#pragma unroll
      for (int ni = 0; ni < 8; ++ni) acc[ni][mi] *= rs;
    }
    int kind;
    u16* dst = nullptr; int ld = 256, col0 = 0, vrows = 256; const float* gn = nullptr;
    if (nt == 0) { kind = 0; dst = p.qsb; }
    else if (nt == 1) { kind = 0; dst = p.ksb; }
    else if (nt == 2) { kind = 2; dst = p.vtsb; vrows = 256; }
    else if (nt == 3) { kind = 1; dst = p.qsp; gn = p.qn_sp + layer * 64; }
    else if (nt == 4) { kind = 1; dst = p.ksp; gn = p.kn_sp + layer * 64; }
    else if (nt == 5) { kind = 2; dst = p.vtsp; vrows = 256; }
    else if (nt < 8) { kind = 1; dst = p.qdf; ld = 512; col0 = (nt - 6) * 256; gn = p.qn_df + layer * 64; }
    else if (nt < 10) { kind = 1; dst = p.kdf; ld = 512; col0 = (nt - 8) * 256; gn = p.kn_df + layer * 64; }
    else if (nt < 12) { kind = 2; dst = p.vtdf; col0 = (nt - 10) * 256; vrows = 512; }
    else { kind = 0; dst = p.qix; }
    if (kind == 1) {
#pragma unroll
      for (int mi = 0; mi < 4; ++mi)
#pragma unroll
        for (int hh = 0; hh < 2; ++hh) {
          float ss = 0.f;
#pragma unroll
          for (int n4 = 0; n4 < 4; ++n4)
#pragma unroll
            for (int r = 0; r < 4; ++r) ss += acc[hh * 4 + n4][mi][r] * acc[hh * 4 + n4][mi][r];
          ss += __shfl_xor(ss, 16);
          ss += __shfl_xor(ss, 32);
          float sc = rsqrtf(ss * (1.f / 64.f) + EPS);
#pragma unroll
          for (int n4 = 0; n4 < 4; ++n4)
#pragma unroll
            for (int r = 0; r < 4; ++r) acc[hh * 4 + n4][mi][r] *= sc * gn[n4 * 16 + lg * 4 + r];
        }
    }
    if (kind == 0 || kind == 1) {
#pragma unroll
      for (int mi = 0; mi < 4; ++mi)
#pragma unroll
        for (int ni = 0; ni < 8; ++ni) {
          u32x2 pk = {pack2bf(acc[ni][mi][0], acc[ni][mi][1]), pack2bf(acc[ni][mi][2], acc[ni][mi][3])};
          *(u32x2*)(dst + (size_t)mrow[mi] * ld + col0 + wn * 128 + ni * 16 + lg * 4) = pk;
        }
    } else if (kind == 2) {
#pragma unroll
      for (int mi = 0; mi < 4; ++mi) {
        int b = mrow[mi] / TP, t = mrow[mi] - b * TP;
#pragma unroll
        for (int ni = 0; ni < 8; ++ni)
#pragma unroll
          for (int r = 0; r < 4; ++r) {
            int row = col0 + wn * 128 + ni * 16 + lg * 4 + r;
            dst[((size_t)(b * vrows + row)) * TP + t] = f2bf(acc[ni][mi][r]);
          }
      }
    }
  }
  {
    const int v = vblock(), first = NTILES % gridDim.x, nfree = gridDim.x - first;
    if (v >= first) {
      for (int s = v - first; s < 132; s += nfree) {
        const int mt = s;
        f32x4 acc[4][4];
        zero_acc<4, 4>(acc);
        gemm_kloop<4, 4>(p.hb + (size_t)(mt * 256) * DM, DM, W + (size_t)(13 * 256) * DM, DM, DM, acc, smem);
        if (wn == 0) {
#pragma unroll
          for (int mi = 0; mi < 4; ++mi) {
            const int m = mt * 256 + wm * 64 + mi * 16 + lm;
            const float rs = rsqrtf(rowss[m] * (1.f / DM) + EPS);
#pragma unroll
            for (int ni = 0; ni < 2; ++ni) {
              u32x2 pk = {pack2bf(acc[ni][mi][0] * rs, acc[ni][mi][1] * rs), pack2bf(acc[ni][mi][2] * rs, acc[ni][mi][3] * rs)};
              *(u32x2*)(p.kix + (size_t)m * 32 + ni * 16 + lg * 4) = pk;
            }
            if (lg < 2) {
              float4 w4 = make_float4(acc[2][mi][0] * rs, acc[2][mi][1] * rs, acc[2][mi][2] * rs, acc[2][mi][3] * rs);
              *(float4*)(p.wix + (size_t)m * 8 + lg * 4) = w4;
            }
          }
        }
      }
    }
  }
}

template <int MI, int NI>
DI void resid_epilogue(const Params& p, int from_x, const f32x4 (&acc)[NI][MI], int row0, int n0, float* rowss_next, bool last, int lm, int lg) {
#pragma unroll
  for (int mi = 0; mi < MI; ++mi) {
    const int m = row0 + mi * 16 + lm;
    const float* hr = hrow_r(p, from_x == 1 ? 0 : 1, m);
    float* hw = hrow_w(p, m);
    u16* hbr = p.hb + (size_t)m * DM;
    float ss = 0.f;
#pragma unroll
    for (int ni = 0; ni < NI; ++ni) {
      const int n = n0 + ni * 16 + lg * 4;
      float4 h;
      if (from_x >= 2) {
        const u32x2 pk = *(const u32x2*)(hbr + n);
        h = make_float4(__uint_as_float(pk[0] << 16), __uint_as_float(pk[0] & 0xffff0000u), __uint_as_float(pk[1] << 16), __uint_as_float(pk[1] & 0xffff0000u));
      } else h = *(const float4*)(hr + n);
      h.x += acc[ni][mi][0]; h.y += acc[ni][mi][1]; h.z += acc[ni][mi][2]; h.w += acc[ni][mi][3];
      if (last) *(float4*)(hw + n) = h;
      if (!last) {
        u32x2 pk = {pack2bf(h.x, h.y), pack2bf(h.z, h.w)};
        *(u32x2*)(hbr + n) = pk;
        ss += h.x * h.x + h.y * h.y + h.z * h.z + h.w * h.w;
      }
    }
    if (!last) {
      ss += __shfl_xor(ss, 16);
      ss += __shfl_xor(ss, 32);
      if (lg == 0) atomicAdd(rowss_next + m, ss);
    }
  }
}

DI void phase_resid(const Params& p, int from_x, const u16* A, int K, const u16* W, float* rowss_next, bool last,
                    unsigned char* smem) {
  int tid_ = threadIdx.x; asm volatile("" : "+v"(tid_));
  const int tid = tid_, lane = tid & 63, wave = tid >> 6, wm = wave >> 1, wn = wave & 1;
  const int lm = lane & 15, lg = lane >> 4;
  constexpr int NT = 4, NTILES = 132 * NT;
  const int nfull = (NTILES / (int)gridDim.x) * (int)gridDim.x;
  for (int it = vblock(); it < nfull; it += gridDim.x) {
    const int g = it / (4 * NT), rem = it - g * (4 * NT), nt = rem >> 2, mt = g * 4 + (rem & 3);
    f32x4 acc[8][4];
    zero_acc<4, 8>(acc);
    gemm_kloop<4, 8>(A + (size_t)(mt * 256) * K, K, W + (size_t)(nt * 256) * K, K, K, acc, smem);
    resid_epilogue<4, 8>(p, from_x, acc, mt * 256 + wm * 64, nt * 256 + wn * 128, rowss_next, last, lm, lg);
  }
  for (int s = vblock(); s < 4 * (NTILES - nfull); s += gridDim.x) {
    const int it = nfull + (s >> 2), hm = s & 1, hn = (s >> 1) & 1;
    const int g = it / (4 * NT), rem = it - g * (4 * NT), nt = rem >> 2, mt = g * 4 + (rem & 3);
    f32x4 acc[4][2];
    zero_acc<2, 4>(acc);
    gemm_kloop<2, 4>(A + (size_t)(mt * 256 + hm * 128) * K, K, W + (size_t)(nt * 256 + hn * 128) * K, K, K, acc, smem);
    resid_epilogue<2, 4>(p, from_x, acc, mt * 256 + hm * 128 + wm * 32, nt * 256 + hn * 128 + wn * 64, rowss_next, last, lm, lg);
  }
}

template <int MI>
DI void merge_tile(const Params& p, int layer, int rowbase, int nt, unsigned char* smem) {
  int tid_ = threadIdx.x; asm volatile("" : "+v"(tid_));
  const int tid = tid_, lane = tid & 63, wave = tid >> 6, wm = wave >> 1, wn = wave & 1;
  const int lm = lane & 15, lg = lane >> 4;
  const u16* WL = p.wts + (size_t)layer * LAYER_W;
  const float* rowss = p.rowss + (size_t)(2 * layer) * R;
  const float* bg = p.b_gate + layer * 3 * DM;
  u32 mp[4][MI][2];
#pragma unroll
  for (int ni = 0; ni < 4; ++ni)
#pragma unroll
    for (int mi = 0; mi < MI; ++mi) { mp[ni][mi][0] = 0u; mp[ni][mi][1] = 0u; }
#pragma unroll 1
  for (int br = 0; br < 3; ++br) {
    const u16* Y = br == 0 ? p.ysb : (br == 1 ? p.ysp : p.ydf);
    const int Kb = br == 2 ? 512 : 256;
    const u16* Wb = WL + (br == 0 ? OFF_BRSB : (br == 1 ? OFF_BRSP : OFF_BRDF));
    f32x4 acc[4][MI];
    zero_acc<MI, 4>(acc);
    gemm_kloop<MI, 4>(Y + (size_t)rowbase * Kb, Kb, Wb + (size_t)(nt * 128) * Kb, Kb, Kb, acc, smem);
    u32 brp[4][MI][2];
#pragma unroll
    for (int ni = 0; ni < 4; ++ni)
#pragma unroll
      for (int mi = 0; mi < MI; ++mi) {
        brp[ni][mi][0] = pack2bf(acc[ni][mi][0], acc[ni][mi][1]);
        brp[ni][mi][1] = pack2bf(acc[ni][mi][2], acc[ni][mi][3]);
      }
    zero_acc<MI, 4>(acc);
    gemm_kloop<MI, 4>(p.hb + (size_t)rowbase * DM, DM, WL + OFF_WG + (size_t)(br * 1024 + nt * 128) * DM, DM, DM, acc, smem);
    int m0 = rowbase + wm * 16 * MI + lm, n0 = nt * 128 + wn * 64 + lg * 4;
    asm volatile("" : "+v"(m0), "+v"(n0));
#pragma unroll
    for (int mi = 0; mi < MI; ++mi) {
      const float rs = rsqrtf(rowss[m0 + mi * 16] * (1.f / DM) + EPS);
#pragma unroll
      for (int ni = 0; ni < 4; ++ni) {
        const float4 b4 = *(const float4*)(bg + br * DM + n0 + ni * 16);
        const float bb[4] = {b4.x, b4.y, b4.z, b4.w};
        float mv[4];
#pragma unroll
        for (int r = 0; r < 4; ++r) {
          const float gv = acc[ni][mi][r] * rs + bb[r];
          const float sg = 1.f / (1.f + __expf(-gv));
          const u32 w = brp[ni][mi][r >> 1], mw = mp[ni][mi][r >> 1];
          const float bv = __uint_as_float((r & 1) ? (w & 0xffff0000u) : (w << 16));
          const float mo = __uint_as_float((r & 1) ? (mw & 0xffff0000u) : (mw << 16));
          mv[r] = mo + sg * bv;
        }
        mp[ni][mi][0] = pack2bf(mv[0], mv[1]);
        mp[ni][mi][1] = pack2bf(mv[2], mv[3]);
      }
    }
  }
  int m0 = rowbase + wm * 16 * MI + lm, n0 = nt * 128 + wn * 64 + lg * 4;
  asm volatile("" : "+v"(m0), "+v"(n0));
#pragma unroll
  for (int mi = 0; mi < MI; ++mi)
#pragma unroll
    for (int ni = 0; ni < 4; ++ni) {
      u32x2 pk = {mp[ni][mi][0], mp[ni][mi][1]};
      *(u32x2*)(p.merged + (size_t)(m0 + mi * 16) * DM + n0 + ni * 16) = pk;
    }
}

DI void phase_merge(const Params& p, int layer, unsigned char* smem) {
  constexpr int NT = 8, NTILES = 132 * NT;
  const int nfull = (NTILES / (int)gridDim.x) * (int)gridDim.x;
  for (int it = vblock(); it < nfull; it += gridDim.x) {
    const int g = it / (4 * NT), rem = it - g * (4 * NT), nt = rem >> 2, mt = g * 4 + (rem & 3);
    merge_tile<4>(p, layer, mt * 256, nt, smem);
  }
  for (int s = vblock(); s < 2 * (NTILES - nfull); s += gridDim.x) {
    const int it = nfull + (s >> 1), hf = s & 1;
    const int g = it / (4 * NT), rem = it - g * (4 * NT), nt = rem >> 2, mt = g * 4 + (rem & 3);
    merge_tile<2>(p, layer, mt * 256 + hf * 128, nt, smem);
  }
}

DI void phase_ffnup(const Params& p, int layer, unsigned char* smem) {
  int tid_ = threadIdx.x; asm volatile("" : "+v"(tid_));
  const int tid = tid_, lane = tid & 63, wave = tid >> 6, wm = wave >> 1, wn = wave & 1;
  const int lr = tid >> 3, lc = tid & 7, lm = lane & 15, lg = lane >> 4;
  const u16* W = p.wts + (size_t)layer * LAYER_W + OFF_UP;
  const float* rowss = p.rowss + (size_t)(2 * layer + 1) * R;
  const float* cw = p.conv_w + layer * 3 * DFF;
  const float* cb = p.conv_b + layer * DFF;
  constexpr int NT = 22, MT = 136, NTILES = MT * NT;
  float* G = (float*)smem;
  for (int it = vblock(); it < NTILES; it += gridDim.x) {
    const int g = it / (4 * NT), rem = it - g * (4 * NT), nt = rem >> 2, mt = g * 4 + (rem & 3);
    const int b = mt / 17, ti = mt - b * 17, tbase = 254 * ti - 2;
    f32x4 acc[8][4];
    zero_acc<4, 8>(acc);
    gemm_kloop<4, 8>(p.hb + ((ptrdiff_t)(b * TP + tbase)) * DM, DM, W + (size_t)(nt * 256) * DM, DM, DM, acc, smem);
    int r0 = wm * 64 + lm, gc0 = 64 * wn + 4 * lg;
    asm volatile("" : "+v"(r0), "+v"(gc0));
    int tt[4];
#pragma unroll
    for (int mi = 0; mi < 4; ++mi) {
      const int r = r0 + mi * 16;
      tt[mi] = tbase + r;
      float rs = (tt[mi] >= 0 && tt[mi] < TP) ? rsqrtf(rowss[b * TP + tt[mi]] * (1.f / DM) + EPS) : 0.f;
#pragma unroll
      for (int ni = 0; ni < 8; ++ni) acc[ni][mi] *= rs;
#pragma unroll
      for (int n2 = 0; n2 < 4; ++n2) {
        float4 g4 = make_float4(acc[2 * n2][mi][0], acc[2 * n2][mi][1], acc[2 * n2][mi][2], acc[2 * n2][mi][3]);
        *(float4*)(G + r * 132 + gc0 + 16 * n2) = g4;
      }
    }
    __syncthreads();
#pragma unroll
    for (int n2 = 0; n2 < 4; ++n2) {
      const int gc = gc0 + 16 * n2;
      const int ff = 128 * nt + gc;
      const float4 w0 = *(const float4*)(cw + ff), w1 = *(const float4*)(cw + DFF + ff), w2 = *(const float4*)(cw + 2 * DFF + ff);
      const float4 c4 = *(const float4*)(cb + ff);
#pragma unroll
      for (int mi = 0; mi < 4; ++mi) {
        const int r = r0 + mi * 16;
        if (r >= 2 && tt[mi] < TP) {
          const float4 g1 = *(const float4*)(G + (r - 1) * 132 + gc);
          const float4 g2 = *(const float4*)(G + (r - 2) * 132 + gc);
          float cv[4];
          cv[0] = c4.x + w0.x * g2.x + w1.x * g1.x + w2.x * acc[2 * n2][mi][0];
          cv[1] = c4.y + w0.y * g2.y + w1.y * g1.y + w2.y * acc[2 * n2][mi][1];
          cv[2] = c4.z + w0.z * g2.z + w1.z * g1.z + w2.z * acc[2 * n2][mi][2];
          cv[3] = c4.w + w0.w * g2.w + w1.w * g1.w + w2.w * acc[2 * n2][mi][3];
          float a[4];
#pragma unroll
          for (int e = 0; e < 4; ++e) a[e] = cv[e] / (1.f + __expf(-cv[e])) * acc[2 * n2 + 1][mi][e];
          u32x2 pk = {pack2bf(a[0], a[1]), pack2bf(a[2], a[3])};
          *(u32x2*)(p.act + (size_t)(b * TP + tt[mi]) * DFF + ff) = pk;
        }
      }
    }
    __syncthreads();
  }
}

DI int swap23(int k) { return (k & ~12) | ((k & 4) << 1) | ((k & 8) >> 1); }

DI void build_lut(const Params& p, int bias_head, unsigned char* smem, int tid) {
  float* lut = (float*)(smem + LUT_OFF);
  const int d = tid;
  if (d <= 128) {
    int bucket;
    if (d < 16) bucket = d;
    else {
      float nf = (float)d;
      int large = 16 + (int)(logf(nf / 16.f) / 2.0794415416798357f * 16.f);
      bucket = large < 31 ? large : 31;
    }
    lut[d] = p.rel_bias[bucket * 8 + bias_head] * LOG2E;
  }
}

template <int NCH>
DI void ld_tile_g(u32x4 (&r)[NCH], const u16* base, size_t rstride, int k0, bool is_vt, int tid) {
#pragma unroll
  for (int i = 0; i < NCH; ++i) {
    int id = tid + 256 * i, row = id >> 3, c = id & 7;
    const u16* s = is_vt ? base + (size_t)row * rstride + k0 + c * 8 : base + (size_t)(k0 + row) * rstride + c * 8;
    r[i] = *(const u32x4*)s;
  }
}
template <int NCH>
DI void st_tile_s(const u32x4 (&r)[NCH], unsigned char* dst, bool permute, int tid) {
#pragma unroll
  for (int i = 0; i < NCH; ++i) {
    int id = tid + 256 * i, row = id >> 3, c = id & 7;
    int rr = permute ? swap23(row) : row;
    *(u32x4*)(dst + rr * 144 + c * 16) = r[i];
  }
}

DI bf16x8 pack8(const f32x16& v, int s2) {
  u32x4 pk;
  if (s2 == 0) pk = u32x4{pack2bf(v[0], v[1]), pack2bf(v[2], v[3]), pack2bf(v[4], v[5]), pack2bf(v[6], v[7])};
  else pk = u32x4{pack2bf(v[8], v[9]), pack2bf(v[10], v[11]), pack2bf(v[12], v[13]), pack2bf(v[14], v[15])};
  return __builtin_bit_cast(bf16x8, pk);
}
DI f32x16 zero16() {
  f32x16 z;
#pragma unroll
  for (int i = 0; i < 16; ++i) z[i] = 0.f;
  return z;
}

DI void diff_map(const unsigned char* sk, const bf16x8 (&qf)[4], const unsigned char* sv, const float* lut, bool far,
                 bool diag, int ks0, int tq, int h, int lq, f32x16 (&O)[4], float& m, float& l) {
  const float csc = 0.125f * LOG2E;
  f32x16 S = zero16();
#pragma unroll
  for (int s = 0; s < 4; ++s) {
    bf16x8 kf = *(const bf16x8*)(sk + lq * 144 + (16 * s + 8 * h) * 2);
    S = mfma32(kf, qf[s], S);
  }
  if (far) {
    const float cbias = lut[128];
    float mx = fmaxf(fmaxf(S[0], S[1]), S[2]);
#pragma unroll
    for (int i = 3; i < 15; i += 2) mx = fmaxf(fmaxf(mx, S[i]), S[i + 1]);
    mx = fmaxf(mx, S[15]);
    mx = fmaxf(mx, __shfl_xor(mx, 32));
    const float mn = fmaxf(m, mx * csc + cbias);
    if (__any(mn > m)) {
      const float a = __builtin_amdgcn_exp2f(m - mn);
      l *= a; m = mn;
#pragma unroll
      for (int d = 0; d < 4; ++d) O[d] *= a;
    }
    const float off = cbias - m;
#pragma unroll
    for (int i = 0; i < 16; ++i) { float pv = __builtin_amdgcn_exp2f(S[i] * csc + off); l += pv; S[i] = pv; }
  } else {
    float mx = -1e30f;
#pragma unroll
    for (int i = 0; i < 16; ++i) {
      const int key = ks0 + 16 * (i >> 3) + 8 * h + (i & 7);
      int d = tq - key;
      const bool msk = diag && d < 0;
      d = d < 0 ? 0 : (d > 128 ? 128 : d);
      float x = S[i] * csc + lut[d];
      if (msk) x = -1e30f;
      S[i] = x;
      mx = fmaxf(mx, x);
    }
    mx = fmaxf(mx, __shfl_xor(mx, 32));
    const float mn = fmaxf(m, mx);
    if (__any(mn > m)) {
      const float a = __builtin_amdgcn_exp2f(m - mn);
      l *= a; m = mn;
#pragma unroll
      for (int d = 0; d < 4; ++d) O[d] *= a;
    }
#pragma unroll
    for (int i = 0; i < 16; ++i) { float pv = __builtin_amdgcn_exp2f(S[i] - m); l += pv; S[i] = pv; }
  }
  const bf16x8 p0 = pack8(S, 0), p1 = pack8(S, 1);
#pragma unroll
  for (int d = 0; d < 4; ++d) {
    bf16x8 v0 = *(const bf16x8*)(sv + (d * 32 + lq) * 144 + 16 * h);
    bf16x8 v1 = *(const bf16x8*)(sv + (d * 32 + lq) * 144 + 32 + 16 * h);
    O[d] = mfma32(v0, p0, O[d]);
    O[d] = mfma32(v1, p1, O[d]);
  }
}

DI void diff_map_far2(const unsigned char* sk, const bf16x8 (&qf)[4], const unsigned char* sv, float cbias, int h, int lq,
                      f32x16 (&O)[4], float& m, float& l) {
  const float csc = 0.125f * LOG2E;
  f32x16 S0 = zero16(), S1 = zero16();
#pragma unroll
  for (int s = 0; s < 4; ++s) {
    bf16x8 k0 = *(const bf16x8*)(sk + lq * 144 + (16 * s + 8 * h) * 2);
    bf16x8 k1 = *(const bf16x8*)(sk + (32 + lq) * 144 + (16 * s + 8 * h) * 2);
    S0 = mfma32(k0, qf[s], S0);
    S1 = mfma32(k1, qf[s], S1);
  }
  float mx = fmaxf(fmaxf(S0[0], S0[1]), S0[2]);
#pragma unroll
  for (int i = 3; i < 15; i += 2) mx = fmaxf(fmaxf(mx, S0[i]), S0[i + 1]);
  mx = fmaxf(mx, S0[15]);
#pragma unroll
  for (int i = 0; i < 16; i += 2) mx = fmaxf(fmaxf(mx, S1[i]), S1[i + 1]);
  mx = fmaxf(mx, __shfl_xor(mx, 32));
  const float mn = fmaxf(m, mx * csc + cbias);
  if (__any(mn > m)) {
    const float a = __builtin_amdgcn_exp2f(m - mn);
    l *= a; m = mn;
#pragma unroll
    for (int d = 0; d < 4; ++d) O[d] *= a;
  }
  const float off = cbias - m;
  float la = 0.f, lb = 0.f;
#pragma unroll
  for (int i = 0; i < 16; ++i) {
    float pa = __builtin_amdgcn_exp2f(S0[i] * csc + off), pb = __builtin_amdgcn_exp2f(S1[i] * csc + off);
    la += pa; lb += pb; S0[i] = pa; S1[i] = pb;
  }
  l += la + lb;
  const bf16x8 p0 = pack8(S0, 0), p1 = pack8(S0, 1), p2 = pack8(S1, 0), p3 = pack8(S1, 1);
#pragma unroll
  for (int d = 0; d < 4; ++d) {
    const unsigned char* vr = sv + (d * 32 + lq) * 144 + 16 * h;
    bf16x8 v0 = *(const bf16x8*)(vr), v1 = *(const bf16x8*)(vr + 32), v2 = *(const bf16x8*)(vr + 64), v3 = *(const bf16x8*)(vr + 96);
    O[d] = mfma32(v0, p0, O[d]);
    O[d] = mfma32(v1, p1, O[d]);
    O[d] = mfma32(v2, p2, O[d]);
    O[d] = mfma32(v3, p3, O[d]);
  }
}

DI void diff_job8(const Params& p, int layer, int b, int head, int qb, unsigned char* smem) {
  int tid_ = threadIdx.x; asm volatile("" : "+v"(tid_));
  const int tid = tid_, lane = tid & 63, wave = tid >> 6, h = lane >> 5, lq = lane & 31;
  const int map = wave >> 2, qg = wave & 3;
  const int t0 = qb * 128, tw0 = t0 + 32 * qg, tq = tw0 + lq;
  const float* lut = (const float*)(smem + LUT_OFF);
  build_lut(p, 4 + head, smem, tid);
  bf16x8 qf[4];
  {
    const u16* qr = p.qdf + (size_t)(b * TP + tq) * 512 + head * 128 + 64 * map + 8 * h;
#pragma unroll
    for (int s = 0; s < 4; ++s) qf[s] = *(const bf16x8*)(qr + 16 * s);
  }
  f32x16 O[4];
#pragma unroll
  for (int i = 0; i < 4; ++i) O[i] = zero16();
  float m = -1e30f, l = 0.f;
  const u16* K1 = p.kdf + (size_t)b * TP * 512 + head * 128;
  const u16* VT = p.vtdf + (size_t)(b * 512 + head * 128) * TP;
  const int ntile = 2 * (qb + 1);
  const int krow = tid >> 3, kc = tid & 7, krs = swap23(krow);
  u32x4 rk1, rk2, rv[2];
  auto gl = [&](int k0) {
    const u16* s = K1 + (size_t)(k0 + krow) * 512 + kc * 8;
    rk1 = *(const u32x4*)s; rk2 = *(const u32x4*)(s + 64);
#pragma unroll
    for (int i = 0; i < 2; ++i) rv[i] = *(const u32x4*)(VT + (size_t)(krow + 64 * i) * TP + k0 + kc * 8);
  };
  auto sl = [&](unsigned char* d) {
    *(u32x4*)(d + krs * 144 + kc * 16) = rk1;
    *(u32x4*)(d + 9216 + krs * 144 + kc * 16) = rk2;
#pragma unroll
    for (int i = 0; i < 2; ++i) *(u32x4*)(d + 18432 + (krow + 64 * i) * 144 + kc * 16) = rv[i];
  };
  gl(0); sl(smem);
  if (ntile > 1) gl(64);
  __syncthreads();
  const float cbias = lut[128];
  for (int j = 0; j < ntile; ++j) {
    __syncthreads();
    if (j + 1 < ntile) { sl(smem + ((j + 1) & 1) * 36864); if (j + 2 < ntile) gl((j + 2) * 64); }
    const unsigned char* sb = smem + (j & 1) * 36864;
    const unsigned char* sk = sb + 9216 * map;
    const int k0 = j * 64;
    if (tw0 - (k0 + 63) >= 113) {
      diff_map_far2(sk, qf, sb + 18432, cbias, h, lq, O, m, l);
    } else {
#pragma unroll 1
      for (int sub = 0; sub < 2; ++sub) {
        const int ks0 = k0 + sub * 32;
        if (ks0 > tw0 + 31) break;
        const bool far = (tw0 - (ks0 + 31)) >= 113;
        const bool diag = (ks0 + 31) > tw0;
        diff_map(sk + sub * 32 * 144, qf, sb + 18432 + sub * 64, lut, far, diag, ks0, tq, h, lq, O, m, l);
      }
    }
  }
  __syncthreads();
  float lam;
  const float lam_init = 0.8f - 0.6f * expf(-0.3f * (float)layer);
  {
    float a = p.lq1[layer * 64 + lane] * p.lk1[layer * 64 + lane];
    float c = p.lq2[layer * 64 + lane] * p.lk2[layer * 64 + lane];
    a = wave_sum(a); c = wave_sum(c);
    lam = expf(a) - expf(c) + lam_init;
  }
  l += __shfl_xor(l, 32);
  const float il = (map ? lam : 1.f) / l;
  float* X = (float*)smem + (size_t)(qg * 32 + lq) * 132;
  if (map == 1) {
#pragma unroll
    for (int d = 0; d < 4; ++d)
#pragma unroll
      for (int g = 0; g < 4; ++g) {
        float4 v = make_float4(O[d][4 * g] * il, O[d][4 * g + 1] * il, O[d][4 * g + 2] * il, O[d][4 * g + 3] * il);
        *(float4*)(X + 32 * d + 8 * g + 4 * h) = v;
      }
  }
  __syncthreads();
  if (map == 0) {
    float ss = 0.f;
#pragma unroll
    for (int d = 0; d < 4; ++d)
#pragma unroll
      for (int g = 0; g < 4; ++g) {
        const float4 v = *(const float4*)(X + 32 * d + 8 * g + 4 * h);
        float y0 = O[d][4 * g] * il - v.x, y1 = O[d][4 * g + 1] * il - v.y, y2 = O[d][4 * g + 2] * il - v.z, y3 = O[d][4 * g + 3] * il - v.w;
        O[d][4 * g] = y0; O[d][4 * g + 1] = y1; O[d][4 * g + 2] = y2; O[d][4 * g + 3] = y3;
        ss += y0 * y0 + y1 * y1 + y2 * y2 + y3 * y3;
      }
    ss += __shfl_xor(ss, 32);
    const float sc = rsqrtf(ss * (1.f / 128.f) + EPS) * (1.f - lam_init);
    const float* sg = p.subln + layer * 128;
    u16* yr = p.ydf + (size_t)(b * TP + tq) * 512 + head * 128;
#pragma unroll
    for (int d = 0; d < 4; ++d)
#pragma unroll
      for (int g = 0; g < 4; ++g) {
        const int dv = 32 * d + 8 * g + 4 * h;
        const float4 g4 = *(const float4*)(sg + dv);
        u32x2 pk = {pack2bf(O[d][4 * g] * sc * g4.x, O[d][4 * g + 1] * sc * g4.y),
                    pack2bf(O[d][4 * g + 2] * sc * g4.z, O[d][4 * g + 3] * sc * g4.w)};
        *(u32x2*)(yr + dv) = pk;
      }
  }
  __syncthreads();
}

DI void sparse_job(const Params& p, int layer, int b, int head, int qb, unsigned char* smem) {
  int tid_ = threadIdx.x & 255; asm volatile("" : "+v"(tid_));
  const int tid = tid_, lane = tid & 63, wave = tid >> 6, h = lane >> 5, lq = lane & 31;
  const int t0 = qb * 128, tw0 = t0 + 32 * wave, tq = tw0 + lq;
  const float* lut = (const float*)(smem + LUT_OFF);
  build_lut(p, head, smem, tid);
  bf16x8 qf[4];
  {
    const u16* qr = p.qsp + (size_t)(b * TP + tq) * 256 + head * 64 + 8 * h;
#pragma unroll
    for (int s = 0; s < 4; ++s) qf[s] = *(const bf16x8*)(qr + 16 * s);
  }
  f32x16 O[2] = {zero16(), zero16()};
  float m = -1e30f, l = 0.f;
  const u16* Kp = p.ksp + (size_t)b * TP * 256 + head * 64;
  const u16* VT = p.vtsp + (size_t)(b * 256 + head * 64) * TP;
  const u32* mrow = p.mask + (size_t)(b * TP + tq) * MW;
  const int ntile = 2 * (qb + 1);
  const float csc = 0.125f * LOG2E;
  u32x4 rk[2], rv[2];
  ld_tile_g<2>(rk, Kp, 256, 0, false, tid); ld_tile_g<2>(rv, VT, TP, 0, true, tid);
  u32x2 mnext = *(const u32x2*)(mrow);
  st_tile_s<2>(rk, smem, true, tid); st_tile_s<2>(rv, smem + 9216, false, tid);
  if (ntile > 1) { ld_tile_g<2>(rk, Kp, 256, 64, false, tid); ld_tile_g<2>(rv, VT, TP, 64, true, tid); }
  for (int j = 0; j < ntile; ++j) {
    const bool more = j + 1 < ntile;
    const u32x2 mcur = mnext;
    __syncthreads();
    if (more) {
      unsigned char* d = smem + ((j + 1) & 1) * 18432; st_tile_s<2>(rk, d, true, tid); st_tile_s<2>(rv, d + 9216, false, tid);
      mnext = *(const u32x2*)(mrow + 2 * (j + 1));
      if (j + 2 < ntile) { const int k0 = (j + 2) * 64; ld_tile_g<2>(rk, Kp, 256, k0, false, tid); ld_tile_g<2>(rv, VT, TP, k0, true, tid); }
    }
    const unsigned char* sb = smem + (j & 1) * 18432;
#pragma unroll 1
    for (int sub = 0; sub < 2; ++sub) {
      const int ks0 = j * 64 + sub * 32;
      if (ks0 > tw0 + 31) break;
      const u32 mw = sub ? mcur[1] : mcur[0];
      if (!__any(mw != 0u)) continue;
      f32x16 S = zero16();
#pragma unroll
      for (int s = 0; s < 4; ++s) {
        bf16x8 k1 = *(const bf16x8*)(sb + (sub * 32 + lq) * 144 + (16 * s + 8 * h) * 2);
        S = mfma32(k1, qf[s], S);
      }
      const bool far = (tw0 - (ks0 + 31)) >= 113;
      const float cbias = lut[128];
      const u32 sel16 = ((mw >> (8 * h)) & 0xffu) | (((mw >> (16 + 8 * h)) & 0xffu) << 8);
      if (far) {
        float mx = -1e30f;
#pragma unroll
        for (int i = 0; i < 16; ++i) mx = fmaxf(mx, (sel16 & (1u << i)) ? S[i] : -1e30f);
        mx = fmaxf(mx, __shfl_xor(mx, 32));
        const float mn = mx > -1e29f ? fmaxf(m, mx * csc + cbias) : m;
        if (__any(mn > m)) {
          const float a = __builtin_amdgcn_exp2f(m - mn);
          l *= a; O[0] *= a; O[1] *= a;
          m = mn;
        }
        const float off = cbias - m;
#pragma unroll
        for (int i = 0; i < 16; ++i) {
          float pv = (sel16 & (1u << i)) ? __builtin_amdgcn_exp2f(S[i] * csc + off) : 0.f;
          l += pv;
          S[i] = pv;
        }
      } else {
        float mx = -1e30f;
#pragma unroll
        for (int i = 0; i < 16; ++i) {
          const int ko = 16 * (i >> 3) + 8 * h + (i & 7);
          int d = tq - (ks0 + ko); d = d < 0 ? 0 : (d > 128 ? 128 : d);
          float x = S[i] * csc + lut[d];
          if (!(sel16 & (1u << i))) x = -1e30f;
          S[i] = x;
          mx = fmaxf(mx, x);
        }
        mx = fmaxf(mx, __shfl_xor(mx, 32));
        const float mn = fmaxf(m, mx);
        if (__any(mn > m)) {
          const float a = __builtin_amdgcn_exp2f(m - mn);
          l *= a; O[0] *= a; O[1] *= a;
          m = mn;
        }
#pragma unroll
        for (int i = 0; i < 16; ++i) {
          float pv = S[i] > -1e29f ? __builtin_amdgcn_exp2f(S[i] - m) : 0.f;
          l += pv;
          S[i] = pv;
        }
      }
      bf16x8 pa0 = pack8(S, 0), pa1 = pack8(S, 1);
#pragma unroll
      for (int d = 0; d < 2; ++d) {
        bf16x8 v0 = *(const bf16x8*)(sb + 9216 + (d * 32 + lq) * 144 + (sub * 32 + 8 * h) * 2);
        bf16x8 v1 = *(const bf16x8*)(sb + 9216 + (d * 32 + lq) * 144 + (sub * 32 + 16 + 8 * h) * 2);
        O[d] = mfma32(v0, pa0, O[d]);
        O[d] = mfma32(v1, pa1, O[d]);
      }
    }
  }
  __syncthreads();
  l += __shfl_xor(l, 32);
  const float il = 1.f / l;
  u16* yr = p.ysp + (size_t)(b * TP + tq) * 256 + head * 64;
#pragma unroll
  for (int d = 0; d < 2; ++d)
#pragma unroll
    for (int g = 0; g < 4; ++g) {
      u32x2 pk = {pack2bf(O[d][4 * g] * il, O[d][4 * g + 1] * il), pack2bf(O[d][4 * g + 2] * il, O[d][4 * g + 3] * il)};
      *(u32x2*)(yr + 32 * d + 8 * g + 4 * h) = pk;
    }
  __syncthreads();
}

DI void sb_job(const Params& p, int b, int head, int qb, unsigned char* smem) {
  int tid_ = threadIdx.x & 255; asm volatile("" : "+v"(tid_));
  const int tid = tid_, lane = tid & 63, wave = tid >> 6, h = lane >> 5, lq = lane & 31;
  const int t0 = qb * 128, tw0 = t0 + 32 * wave, tq = tw0 + lq;
  bf16x8 qf[4];
  {
    const u16* qr = p.qsb + (size_t)(b * TP + tq) * 256 + head * 64 + 8 * h;
#pragma unroll
    for (int s = 0; s < 4; ++s) qf[s] = *(const bf16x8*)(qr + 16 * s);
  }
  f32x16 O[2] = {zero16(), zero16()};
  float carry = 0.f;
  const u16* Kp = p.ksb + (size_t)b * TP * 256 + head * 64;
  const u16* VT = p.vtsb + (size_t)(b * 256 + head * 64) * TP;
  const int ntile = 2 * (qb + 1);
  u32x4 rk[2], rv[2];
  ld_tile_g<2>(rk, Kp, 256, (ntile - 1) * 64, false, tid); ld_tile_g<2>(rv, VT, TP, (ntile - 1) * 64, true, tid);
  st_tile_s<2>(rk, smem, true, tid); st_tile_s<2>(rv, smem + 9216, false, tid);
  __syncthreads();
  for (int jj = 0; jj < ntile; ++jj) {
    const int j = ntile - 1 - jj;
    const bool more = jj + 1 < ntile;
    if (more) { const int k0 = (j - 1) * 64; ld_tile_g<2>(rk, Kp, 256, k0, false, tid); ld_tile_g<2>(rv, VT, TP, k0, true, tid); }
    __builtin_amdgcn_sched_barrier(0);
    const unsigned char* sb = smem + (jj & 1) * 18432;
    const bool wdone = !__any(carry >= -104.f);
    if (!wdone) {
#pragma unroll 1
      for (int sub = 1; sub >= 0; --sub) {
        const int ks0 = j * 64 + sub * 32;
        if (ks0 > tw0) continue;
        f32x16 S = zero16();
#pragma unroll
        for (int s = 0; s < 4; ++s) {
          bf16x8 k1 = *(const bf16x8*)(sb + (sub * 32 + lq) * 144 + (16 * s + 8 * h) * 2);
          S = mfma32(k1, qf[s], S);
        }
        const bool diag = (ks0 + 31) >= tw0;
        float lsm[16];
        float sA = 0.f, sB = 0.f;
#pragma unroll
        for (int i = 0; i < 16; ++i) {
          const int key = ks0 + 16 * (i >> 3) + 8 * h + (i & 7);
          const float z = S[i] * 0.125f;
          const float sp = fmaxf(z, 0.f) + __logf(1.f + __expf(-fabsf(z)));
          const bool valid = !diag || key < tq;
          lsm[i] = valid ? -sp : 0.f;
          S[i] = valid ? z - sp : -1e30f;
          if (i < 8) sA += lsm[i]; else sB += lsm[i];
        }
        const float oA = __shfl_xor(sA, 32), oB = __shfl_xor(sB, 32);
        const float aboveB = h == 0 ? oB : 0.f;
        const float aboveA = h == 0 ? (oA + sB + oB) : (oB + sB);
        float run = carry + aboveB;
#pragma unroll
        for (int i = 15; i >= 8; --i) { float lw = S[i] + run; run += lsm[i]; S[i] = lw > -1e29f ? __expf(lw) : 0.f; }
        run = carry + aboveA;
#pragma unroll
        for (int i = 7; i >= 0; --i) { float lw = S[i] + run; run += lsm[i]; S[i] = lw > -1e29f ? __expf(lw) : 0.f; }
        carry += sA + sB + oA + oB;
        bf16x8 pa0 = pack8(S, 0), pa1 = pack8(S, 1);
#pragma unroll
        for (int d = 0; d < 2; ++d) {
          bf16x8 v0 = *(const bf16x8*)(sb + 9216 + (d * 32 + lq) * 144 + (sub * 32 + 8 * h) * 2);
          bf16x8 v1 = *(const bf16x8*)(sb + 9216 + (d * 32 + lq) * 144 + (sub * 32 + 16 + 8 * h) * 2);
          O[d] = mfma32(v0, pa0, O[d]);
          O[d] = mfma32(v1, pa1, O[d]);
        }
      }
    }
    if (more) { unsigned char* d = smem + ((jj + 1) & 1) * 18432; st_tile_s<2>(rk, d, true, tid); st_tile_s<2>(rv, d + 9216, false, tid); }
    const int alldone = __syncthreads_and((int)(!__any(carry >= -104.f)));
    if (alldone) break;
  }
  u16* yr = p.ysb + (size_t)(b * TP + tq) * 256 + head * 64;
#pragma unroll
  for (int d = 0; d < 2; ++d)
#pragma unroll
    for (int g = 0; g < 4; ++g) {
      u32x2 pk = {pack2bf(O[d][4 * g], O[d][4 * g + 1]), pack2bf(O[d][4 * g + 2], O[d][4 * g + 3])};
      *(u32x2*)(yr + 32 * d + 8 * g + 4 * h) = pk;
    }
  __syncthreads();
}

DI void idx_scan(const u32* hq, int need, u32* outbin, u32* outneed, int q, int lane) {
  u32 c = 0;
#pragma unroll
  for (int w = 0; w < 8; ++w) { u32 v = hq[8 * lane + w]; c += (v & 0xffffu) + (v >> 16); }
  u32 incl = c;
#pragma unroll
  for (int o = 1; o < 64; o <<= 1) { u32 v = __shfl_down(incl, o); if (lane + o < 64) incl += v; }
  const u32 above = incl - c;
  if ((int)above < need && need <= (int)incl) {
    u32 cum = above;
    for (int bin = 16 * lane + 15; bin >= 16 * lane; --bin) {
      u32 cnt = (hq[bin >> 1] >> ((bin & 1) * 16)) & 0xffffu;
      if ((int)(cum + cnt) >= need) { outbin[q] = (u32)bin; outneed[q] = (u32)need - cum; break; }
      cum += cnt;
    }
  }
}

template <int PASS, bool DIAG>
DI void idx_tile(const bf16x8 kf, const bf16x8 (&qf)[8], const float (&wq)[8], int kt, int lm, int lg, int tq, bool selall, u32 bA, u32 pfx,
                 u32* hist, u32* maskw, u32* cand, u32* ccnt) {
  const f32x4 z4 = {0.f, 0.f, 0.f, 0.f};
  f32x4 sc = z4;
#pragma unroll
  for (int j = 0; j < 8; ++j) {
    f32x4 d = mfma16(kf, qf[j], z4);
#pragma unroll
    for (int r = 0; r < 4; ++r) sc[r] += wq[j] * fmaxf(d[r], 0.f);
  }
  u32 selbits = 0u;
#pragma unroll
  for (int r = 0; r < 4; ++r) {
    const int key = kt * 16 + lg * 4 + r;
    const bool valid = !DIAG || key <= tq;
    const u32 bits = __float_as_uint(sc[r]);
    const u32 u = bits ^ ((u32)((int)bits >> 31) | 0x80000000u);
    if (PASS == 0) {
      if (valid) { const u32 bin = u >> 22; atomicAdd(&hist[lm * 512 + (bin >> 1)], 1u << ((bin & 1) * 16)); }
    } else if (PASS == 1) {
      if (valid && (u >> 22) == bA) { const u32 bin = (u >> 12) & 1023u; atomicAdd(&hist[lm * 512 + (bin >> 1)], 1u << ((bin & 1) * 16)); }
    } else {
      const u32 pp = u >> 12;
      if (valid && (selall || pp > pfx)) selbits |= 1u << r;
      if (valid && !selall && pp == pfx) {
        const u32 ix = atomicAdd(&ccnt[lm], 1u);
        if (ix < 64u) { cand[(lm * 64 + ix) * 2] = u; cand[(lm * 64 + ix) * 2 + 1] = (u32)key; }
      }
    }
  }
  if (PASS == 2 && selbits) {
    const int kb = kt * 16 + lg * 4;
    atomicOr(&maskw[lm * MW + (kb >> 5)], selbits << (kb & 31));
  }
}
template <int PASS>
DI void idx_pass(const u16* kp, const bf16x8 (&qf)[8], const float (&wq)[8], int wave, int ntile, int lm, int lg, int tq, bool selall,
                 u32 bA, u32 pfx, u32* hist, u32* maskw, u32* cand, u32* ccnt) {
  auto ldk = [&](int t) { return *(const bf16x8*)(kp + (size_t)(t < ntile ? t : 0) * 512); };
  int kt = wave;
  bf16x8 ka = ldk(kt), kb = ldk(kt + 4);
  for (; kt + 4 < ntile - 1; kt += 8) {
    const bf16x8 kc = ldk(kt + 8), kd = ldk(kt + 12);
    idx_tile<PASS, false>(ka, qf, wq, kt, lm, lg, tq, selall, bA, pfx, hist, maskw, cand, ccnt);
    idx_tile<PASS, false>(kb, qf, wq, kt + 4, lm, lg, tq, selall, bA, pfx, hist, maskw, cand, ccnt);
    ka = kc; kb = kd;
  }
  if (kt < ntile - 1) { idx_tile<PASS, false>(ka, qf, wq, kt, lm, lg, tq, selall, bA, pfx, hist, maskw, cand, ccnt); kt += 4; ka = kb; }
  if (kt == ntile - 1) idx_tile<PASS, true>(ka, qf, wq, kt, lm, lg, tq, selall, bA, pfx, hist, maskw, cand, ccnt);
}

DI void idx_job(const Params& p, int b, int qg, unsigned char* smem) {
  int tid_ = threadIdx.x & 255; asm volatile("" : "+v"(tid_));
  const int tid = tid_, lane = tid & 63, wave = tid >> 6, lm = lane & 15, lg = lane >> 4;
  u32* hist = (u32*)smem;
  u32* maskw = (u32*)(smem + 32768);
  u32* cand = (u32*)(smem + 41216);
  u32* ccnt = (u32*)(smem + 49408);
  u32* binA = ccnt + 16; u32* needB = ccnt + 32; u32* binB = ccnt + 48; u32* needC = ccnt + 64;
  const int t0 = qg * 16, ntile = qg + 1, tq = t0 + lm;
  const bool selall = tq + 1 <= 256;
  bf16x8 qf[8];
  float wq[8];
  {
    const u16* qr = p.qix + (size_t)(b * TP + tq) * 256 + lg * 8;
    const float* wr = p.wix + (size_t)(b * TP + tq) * 8;
#pragma unroll
    for (int j = 0; j < 8; ++j) { qf[j] = *(const bf16x8*)(qr + j * 32); wq[j] = wr[j]; }
  }
  for (int i = tid; i < 8192 + 2112; i += 256) hist[i] = 0u;
  if (tid < 80) ccnt[tid] = 0u;
  __syncthreads();
  const u16* kbase = p.kix + (size_t)b * TP * 32;
  const f32x4 z4 = {0.f, 0.f, 0.f, 0.f};
  const u16* kp = kbase + (size_t)lm * 32 + lg * 8;
  idx_pass<0>(kp, qf, wq, wave, ntile, lm, lg, tq, selall, 0u, 0u, hist, maskw, cand, ccnt);
  __syncthreads();
  for (int qq = 0; qq < 4; ++qq) idx_scan(hist + (wave * 4 + qq) * 512, 256, binA, needB, wave * 4 + qq, lane);
  __syncthreads();
  for (int i = tid; i < 8192; i += 256) hist[i] = 0u;
  __syncthreads();
  idx_pass<1>(kp, qf, wq, wave, ntile, lm, lg, tq, selall, binA[lm], 0u, hist, maskw, cand, ccnt);
  __syncthreads();
  for (int qq = 0; qq < 4; ++qq) idx_scan(hist + (wave * 4 + qq) * 512, (int)needB[wave * 4 + qq], binB, needC, wave * 4 + qq, lane);
  __syncthreads();
  idx_pass<2>(kp, qf, wq, wave, ntile, lm, lg, tq, selall, binA[lm], (binA[lm] << 10) | binB[lm], hist, maskw, cand, ccnt);
  __syncthreads();
  {
    const int q = tid >> 4, i0 = tid & 15;
    u32 cnt = ccnt[q]; if (cnt > 64u) cnt = 64u;
    const u32 need = needC[q];
    for (u32 c = i0; c < cnt; c += 16) {
      const u32 u = cand[(q * 64 + c) * 2], key = cand[(q * 64 + c) * 2 + 1];
      u32 rank = 0;
      for (u32 e = 0; e < cnt; ++e) {
        const u32 u2 = cand[(q * 64 + e) * 2], k2 = cand[(q * 64 + e) * 2 + 1];
        rank += (u2 > u || (u2 == u && k2 < key)) ? 1u : 0u;
      }
      if (rank < need) atomicOr(&maskw[q * MW + (key >> 5)], 1u << (key & 31));
    }
  }
  __syncthreads();
  for (int i = tid; i < 16 * MW; i += 256) p.mask[(size_t)(b * TP + t0) * MW + i] = maskw[i];
  __syncthreads();
}

DI int next_job(u32* ctr, unsigned char* smem) {
  int* sj = (int*)(smem + SJOB_OFF);
  __syncthreads();
  if (threadIdx.x == 0) *sj = (int)atomicAdd(ctr, 1u);
  __syncthreads();
  return *sj;
}

DI void phase_attn(const Params& p, int layer, int phase, unsigned char* smem) {
  u32* ctr = p.ctr + phase;
  for (;;) {
    const int jp = next_job(ctr, smem);
    if (jp >= 2640) break;
    if (jp < 1056) { const int qb = 32 - jp / 32, r = jp & 31; diff_job8(p, layer, r >> 2, r & 3, qb, smem); continue; }
    int half = threadIdx.x >> 8; asm volatile("" : "+v"(half));
    unsigned char* sm = smem + half * HALF_BYTES;
    const int job = 2 * (jp - 1056) + half;
    if (job < 2112) { idx_job(p, job & 7, 263 - (job >> 3), sm); }
    else { const int i = job - 2112; const int qb = 32 - i / 32, r = i & 31; sb_job(p, r >> 2, r & 3, qb, sm); }
  }
}
DI void phase_sparse(const Params& p, int layer, int phase, unsigned char* smem) {
  u32* ctr = p.ctr + phase;
  for (;;) {
    const int jp = next_job(ctr, smem);
    if (jp >= 528) break;
    int half = threadIdx.x >> 8; asm volatile("" : "+v"(half));
    unsigned char* sm = smem + half * HALF_BYTES;
    const int job = 2 * jp + half;
    const int qb = 32 - job / 32, r = job & 31;
    sparse_job(p, layer, r >> 2, r & 3, qb, sm);
  }
}

DI void run_phase(const Params& p, int ph, unsigned char* smem, int rep = 0) {
  if (ph == 0) { phase_prep(p, smem); return; }
  const int layer = (ph - 1) / 7, s = (ph - 1) % 7;
  const u16* WL = p.wts + (size_t)layer * LAYER_W;
  switch (s) {
    case 0: phase_g1(p, layer, smem); break;
    case 1: phase_attn(p, layer, ph + 16 * rep, smem); break;
    case 2: phase_sparse(p, layer, ph + 16 * rep, smem); break;
    case 3: phase_merge(p, layer, smem); break;
    case 4: phase_resid(p, layer == 0 ? 1 : 3, p.merged, DM, WL + OFF_OUT, p.rowss + (size_t)(2 * layer + 1) * R, false, smem); break;
    case 5: phase_ffnup(p, layer, smem); break;
    default: phase_resid(p, 2, p.act, DFF, WL + OFF_DOWN, p.rowss + (size_t)(2 * layer + 2) * R, layer == 1, smem); break;
  }
}


#define XB_TMO      128
#define XB_XCNT(j)  (256  + 64 * (j))
#define XB_XSUB(j)  (1280 + 64 * (j))
#define XB_XGEN(j)  (2304 + 64 * (j))
#define XB_TOP      3328
#define XB_TOPGEN   3392
#define XCD_BAR_WORDS 3456
#define XB_SPIN_CAP (1u << 20)
#define LAS __attribute__((address_space(3)))
DI unsigned xb_ld(unsigned* p) { return __hip_atomic_load(p, __ATOMIC_RELAXED, __HIP_MEMORY_SCOPE_AGENT); }
DI unsigned xb_add(unsigned* p, unsigned v) { return __hip_atomic_fetch_add(p, v, __ATOMIC_RELAXED, __HIP_MEMORY_SCOPE_AGENT); }
DI unsigned xb_xcc_id() { return (unsigned)__builtin_amdgcn_s_getreg((3 << 11) | 20) & 0xFu; }
#define XB_SPIN(cond, bar) do { unsigned _sp = 0; while (cond) { __builtin_amdgcn_s_sleep(1); \
    if ((++_sp & 255u) == 0u) { if (xb_ld(&(bar)[XB_TMO])) break; if (_sp > XB_SPIN_CAP) { atomicAdd(&(bar)[XB_TMO], 1u); break; } } } } while (0)
struct XcdBarrier { unsigned* bar; unsigned x; volatile LAS unsigned* st; };
DI XcdBarrier xcd_barrier_post(unsigned* bar, volatile LAS unsigned* st) {
  XcdBarrier b; b.bar = bar; b.x = xb_xcc_id(); b.st = st;
  if (threadIdx.x == 0) (void)xb_add(&bar[XB_XCNT(b.x)], 1u);
  return b;
}
DI void xcd_barrier_complete(unsigned* bar, unsigned x, unsigned& nloc, unsigned& nx) {
  const unsigned G = gridDim.x * gridDim.y * gridDim.z;
  unsigned sum, cnt, mine, sp = 0u;
  for (;;) {
    sum = 0u; cnt = 0u; mine = 0u;
#pragma unroll
    for (unsigned j = 0; j < 16; ++j) { const unsigned c = xb_ld(&bar[XB_XCNT(j)]); sum += c; cnt += (c > 0u) ? 1u : 0u; mine = (j == x) ? c : mine; }
    if (sum == G) break;
    __builtin_amdgcn_s_sleep(1);
    if ((++sp & 255u) == 0u) { if (xb_ld(&bar[XB_TMO])) break; if (sp > XB_SPIN_CAP) { atomicAdd(&bar[XB_TMO], 1u); break; } }
  }
  nloc = mine > 0u ? mine : 1u; nx = cnt > 0u ? cnt : 1u;
}
DI void xcd_barrier(const XcdBarrier& b) {
  asm volatile("s_waitcnt vmcnt(0)" ::: "memory");
  __syncthreads();
  if (threadIdx.x == 0) {
    unsigned* bar = b.bar;
    __builtin_amdgcn_s_waitcnt(0);
    unsigned nloc = b.st[0], nx = b.st[1];
    if (nloc == 0u) { xcd_barrier_complete(bar, b.x, nloc, nx); b.st[0] = nloc; b.st[1] = nx; }
    const unsigned old = xb_add(&bar[XB_XSUB(b.x)], 1u);
    const unsigned gen = old / nloc;
    if (old + 1u == (gen + 1u) * nloc) {
      __builtin_amdgcn_fence(__ATOMIC_RELEASE, "agent");
      asm volatile("s_waitcnt vmcnt(0)" ::: "memory");
      const unsigned og = xb_add(&bar[XB_TOP], 1u);
      const unsigned tg = og / nx;
      if (og + 1u == (tg + 1u) * nx) xb_add(&bar[XB_TOPGEN], 1u);
      else XB_SPIN(xb_ld(&bar[XB_TOPGEN]) == tg, bar);
      __builtin_amdgcn_fence(__ATOMIC_ACQUIRE, "agent");
      xb_add(&bar[XB_XGEN(b.x)], 1u);
      asm volatile("s_waitcnt vmcnt(0)" ::: "memory");
    } else {
      XB_SPIN(xb_ld(&bar[XB_XGEN(b.x)]) == gen, bar);
      __builtin_amdgcn_fence(__ATOMIC_ACQUIRE, "agent");
      asm volatile("s_waitcnt vmcnt(0)" ::: "memory");
    }
  }
  __syncthreads();
}

constexpr int NPHASE = 15;

__global__ void __launch_bounds__(512) mega(Params p, int ph_lo, int ph_hi) {
  __shared__ __attribute__((aligned(16))) unsigned char smem[SMEM_BYTES];
  volatile LAS unsigned* xst = (volatile LAS unsigned*)(smem + (SMEM_BYTES - 16));
  if (threadIdx.x == 0) { xst[0] = 0u; xst[1] = 0u; }
  __syncthreads();
  const XcdBarrier xb = xcd_barrier_post(p.bar, xst);
  for (int ph = ph_lo; ph < ph_hi; ++ph) {
    run_phase(p, ph, smem);
#ifdef PROBE_MASK
    if (ph > 0 && ((PROBE_MASK >> ((ph - 1) % 7)) & 1)) { cg::this_grid().sync(); run_phase(p, ph, smem, 1); }
#endif
    if (ph + 1 < ph_hi) { if (ph_hi > 1000) cg::this_grid().sync(); else xcd_barrier(xb); }
  }
}

extern "C" void kernel_launch(void* const* d_in, const int* in_sizes, int n_in, void* d_out, int out_size, void* d_ws,
                              size_t ws_size, hipStream_t stream) {
  Params p{};
  const float* const* in = (const float* const*)d_in;
  p.x = in[0]; p.meta = in[1]; p.rel_bias = in[2]; p.attn_norm = in[3]; p.w_in = in[4]; p.b_gate = in[5];
  p.qn_sp = in[6]; p.kn_sp = in[7]; p.qn_df = in[8]; p.kn_df = in[9]; p.lq1 = in[10]; p.lk1 = in[11]; p.lq2 = in[12];
  p.lk2 = in[13]; p.subln = in[14]; p.w_br_sb = in[15]; p.w_br_sp = in[16]; p.w_br_df = in[17]; p.w_out = in[18];
  p.ffn_norm = in[19]; p.w_up = in[20]; p.conv_w = in[21]; p.conv_b = in[22]; p.w_down = in[23];
  p.out = (float*)d_out;
  unsigned char* w = (unsigned char*)d_ws;
  size_t off = 0;
  auto take = [&](size_t bytes) { unsigned char* r = w + off; off += (bytes + 255) & ~(size_t)255; return r; };
  p.ctr = (u32*)take(256);
  p.bar = (u32*)take((size_t)XCD_BAR_WORDS * 4);
  p.hb = (u16*)take((size_t)(R + 512) * DM * 2) + (size_t)256 * DM;
  p.rowss = (float*)take((size_t)4 * R * 4);
  p.side = (float*)take((size_t)NB * 128 * DM * 4);
  p.wts = (u16*)take((size_t)2 * LAYER_W * 2);
  p.mask = (u32*)take((size_t)R * MW * 4);
  unsigned char* region = w + off;
  p.qsb = (u16*)take((size_t)R * 256 * 2); p.ksb = (u16*)take((size_t)R * 256 * 2);
  p.qsp = (u16*)take((size_t)R * 256 * 2); p.ksp = (u16*)take((size_t)R * 256 * 2);
  p.qdf = (u16*)take((size_t)R * 512 * 2); p.kdf = (u16*)take((size_t)R * 512 * 2);
  p.vtsb = (u16*)take((size_t)R * 256 * 2); p.vtsp = (u16*)take((size_t)R * 256 * 2); p.vtdf = (u16*)take((size_t)R * 512 * 2);
  p.qix = (u16*)take((size_t)R * 256 * 2); p.kix = (u16*)take((size_t)R * 32 * 2); p.wix = (float*)take((size_t)R * 8 * 4);
  p.ysb = (u16*)take((size_t)R * 256 * 2); p.ysp = (u16*)take((size_t)R * 256 * 2); p.ydf = (u16*)take((size_t)R * 512 * 2);
  p.merged = (u16*)region;
  p.act = (u16*)region;
  if (off > ws_size) { fprintf(stderr, "workspace too small: need %zu have %zu\n", off, ws_size); return; }
#if FUSED
  static int grid_blocks = 0;
  if (!grid_blocks) {
    int dev = 0, cus = 0, per_cu = 0;
    hipGetDevice(&dev);
    hipDeviceGetAttribute(&cus, hipDeviceAttributeMultiprocessorCount, dev);
    hipOccupancyMaxActiveBlocksPerMultiprocessor(&per_cu, mega, 512, 0);
    if (per_cu > 1) per_cu = 1;
    grid_blocks = cus * per_cu;
  }
  int lo = 0, hi = NPHASE;
  (void)hipMemsetAsync(p.bar, 0, (size_t)XCD_BAR_WORDS * 4, stream);
  void* args[] = {&p, &lo, &hi};
  hipError_t e = hipLaunchCooperativeKernel((void*)mega, dim3(grid_blocks), dim3(512), args, 0, stream);
  if (e != hipSuccess) fprintf(stderr, "cooperative launch failed: %s (grid %d)\n", hipGetErrorString(e), grid_blocks);
#else
  for (int ph = 0; ph < NPHASE; ++ph) mega<<<256, 512, 0, stream>>>(p, ph, ph + 1);
#endif
}
```

```cpp
#include <hip/hip_runtime.h>
#include <hip/hip_cooperative_groups.h>
#include <cstdio>
namespace cg = cooperative_groups;

#ifndef FUSED
#define FUSED 1
#endif

#define DI __device__ __forceinline__
typedef unsigned short u16;
typedef unsigned int u32;
using bf16x8 = __attribute__((ext_vector_type(8))) short;
using f32x4 = __attribute__((ext_vector_type(4))) float;
using f32x16 = __attribute__((ext_vector_type(16))) float;
using u32x4 = __attribute__((ext_vector_type(4))) unsigned;
using u32x2 = __attribute__((ext_vector_type(2))) unsigned;
typedef __bf16 bf2_t __attribute__((ext_vector_type(2)));
typedef float f2_t __attribute__((ext_vector_type(2)));

constexpr int NB = 8, SEQ = 4096, DM = 1024, TP = 4224, TREAL = 4112, NMETA = 16, R = NB * TP;
constexpr int DFF = 2816, DIN = 6440, MW = 132;
constexpr float EPS = 1e-6f;
constexpr float LOG2E = 1.4426950408889634f;
constexpr int HALF_BYTES = 75776;
constexpr int SMEM_BYTES = 2 * HALF_BYTES;
constexpr int LUT_OFF = 73728;
constexpr int SJOB_OFF = 75000;

constexpr int NWIN = 3584;
constexpr size_t OFF_WIN = 0, OFF_WG = OFF_WIN + (size_t)NWIN * 1024, OFF_BRSB = OFF_WG + (size_t)3072 * 1024, OFF_BRSP = OFF_BRSB + 262144,
                 OFF_BRDF = OFF_BRSP + 262144, OFF_OUT = OFF_BRDF + 524288, OFF_UP = OFF_OUT + 1048576, OFF_DOWN = OFF_UP + (size_t)5632 * 1024,
                 LAYER_W = OFF_DOWN + (size_t)1024 * 2816;

struct Params {
  const float *x, *meta, *rel_bias, *attn_norm, *w_in, *b_gate, *qn_sp, *kn_sp, *qn_df, *kn_df, *lq1, *lk1, *lq2, *lk2,
      *subln, *w_br_sb, *w_br_sp, *w_br_df, *w_out, *ffn_norm, *w_up, *conv_w, *conv_b, *w_down;
  float* out;
  u16* hb; float* rowss; float* side; u16* wts;
  u16 *qsb, *ksb, *qsp, *ksp, *qdf, *kdf, *vtsb, *vtsp, *vtdf, *qix, *kix; float* wix;
  u16 *ysb, *ysp, *ydf; u32* mask; u16* merged; u16* act; u32* ctr; u32* bar;
};

DI u32 pack2bf(float a, float b) {
  f2_t v = {a, b};
  bf2_t r = __builtin_convertvector(v, bf2_t);
  return __builtin_bit_cast(u32, r);
}
DI u16 f2bf(float a) { return (u16)(pack2bf(a, 0.f) & 0xffffu); }
DI float wave_sum(float v) {
#pragma unroll
  for (int o = 32; o; o >>= 1) v += __shfl_xor(v, o);
  return v;
}
DI f32x4 mfma16(bf16x8 a, bf16x8 b, f32x4 c) { return __builtin_amdgcn_mfma_f32_16x16x32_bf16(a, b, c, 0, 0, 0); }
DI f32x16 mfma32(bf16x8 a, bf16x8 b, f32x16 c) { return __builtin_amdgcn_mfma_f32_32x32x16_bf16(a, b, c, 0, 0, 0); }

DI int vblock() {
  int g = gridDim.x, b = blockIdx.x;
  if ((g & 7) == 0) return (b & 7) * (g >> 3) + (b >> 3);
  return b;
}

DI float* hrow_w(const Params& p, int gr) {
  int b = gr / TP, t = gr - b * TP;
  if (t >= NMETA && t < TREAL) return p.out + ((size_t)(b * SEQ + t - NMETA)) * DM;
  int s = t < NMETA ? t : t - TREAL + NMETA;
  return p.side + ((size_t)(b * 128 + s)) * DM;
}
DI const float* hrow_r(const Params& p, int layer, int gr) {
  int b = gr / TP, t = gr - b * TP;
  if (t >= NMETA && t < TREAL) {
    size_t o = ((size_t)(b * SEQ + t - NMETA)) * DM;
    return layer == 0 ? p.x + o : p.out + o;
  }
  int s = t < NMETA ? t : t - TREAL + NMETA;
  return p.side + ((size_t)(b * 128 + s)) * DM;
}

DI int wt_srccol(int kind, int n) {
  if (kind == 0) {
    if (n < 1536) return n;
    if (n < 3072) return 1832 + n - 1536;
    if (n < 3328) return 1536 + n - 3072;
    if (n < 3360) return 1792 + n - 3328;
    if (n < 3368) return 1824 + n - 3360;
    return -1;
  }
  if (kind == 1) return 3368 + n;
  if (kind == 6) {
    int j = n >> 8, w = n & 255, wn = w >> 7, ni = (w & 127) >> 4, c = w & 15;
    int ff = 128 * j + 64 * wn + 16 * (ni >> 1) + c;
    return (ni & 1) ? DFF + ff : ff;
  }
  return n;
}

DI void phase_prep(const Params& p, unsigned char* smem) {
  int tid_ = threadIdx.x; asm volatile("" : "+v"(tid_));
  const int tid = tid_, wave = tid >> 6, lane = tid & 63;
  for (int gr = blockIdx.x * 8 + wave; gr < R; gr += gridDim.x * 8) {
    int b = gr / TP, t = gr - b * TP;
    const float* src = nullptr;
    if (t < NMETA) src = p.meta + (size_t)t * DM;
    else if (t < TREAL) src = p.x + ((size_t)(b * SEQ + t - NMETA)) * DM;
    float4 v[4];
    float ss = 0.f;
#pragma unroll
    for (int i = 0; i < 4; ++i) {
      v[i] = src ? ((const float4*)src)[lane + 64 * i] : make_float4(0.f, 0.f, 0.f, 0.f);
      ss += v[i].x * v[i].x + v[i].y * v[i].y + v[i].z * v[i].z + v[i].w * v[i].w;
    }
    ss = wave_sum(ss);
#pragma unroll
    for (int i = 0; i < 4; ++i) {
      u32x2 pk = {pack2bf(v[i].x, v[i].y), pack2bf(v[i].z, v[i].w)};
      *(u32x2*)(p.hb + (size_t)gr * DM + (lane + 64 * i) * 4) = pk;
    }
    if (lane == 0) { p.rowss[gr] = ss; p.rowss[R + gr] = 0.f; p.rowss[2 * R + gr] = 0.f; p.rowss[3 * R + gr] = 0.f; }
    if (t < NMETA || t >= TREAL) {
      int s = t < NMETA ? t : t - TREAL + NMETA;
      float* d = p.side + ((size_t)(b * 128 + s)) * DM;
#pragma unroll
      for (int i = 0; i < 4; ++i) ((float4*)d)[lane + 64 * i] = v[i];
    }
  }
  if (blockIdx.x == 0 && tid < 64) p.ctr[tid] = 0;
  for (int i = blockIdx.x * 512 + tid; i < 2 * 256 * DM / 8; i += gridDim.x * 512) {
    const int hf = i / (256 * DM / 8), o = i - hf * (256 * DM / 8);
    u16* d = hf ? p.hb + (size_t)R * DM : p.hb - (size_t)256 * DM;
    *(u32x4*)(d + (size_t)o * 8) = u32x4{0u, 0u, 0u, 0u};
  }
  const int half = tid >> 8, t2 = tid & 255;
  float* tl = (float*)(smem + half * HALF_BYTES);
  constexpr int NK[8] = {NWIN, 3072, 1024, 1024, 1024, 1024, 5632, 1024};
  constexpr int KK[8] = {1024, 1024, 256, 256, 512, 1024, 1024, 2816};
  int total = 0;
  int cum[9];
  cum[0] = 0;
#pragma unroll
  for (int k = 0; k < 8; ++k) { total += (NK[k] / 64) * (KK[k] / 64); cum[k + 1] = total; }
  for (int jp = blockIdx.x; 2 * jp < 2 * total; jp += gridDim.x) {
    const int job = 2 * jp + half;
    const bool act = job < 2 * total;
    int layer = job >= total ? 1 : 0;
    int j = job - layer * total;
    int kind = 0;
#pragma unroll
    for (int k = 1; k < 8; ++k) if (j >= cum[k]) kind = k;
    int jj = j;
    int K = 1024, ld = 1024;
    const float* src = p.w_in; const float* gain = nullptr; u16* dst = p.wts + (size_t)layer * LAYER_W;
    switch (kind) {
      case 0: jj -= cum[0]; K = 1024; ld = DIN; src = p.w_in + (size_t)layer * DM * DIN; gain = p.attn_norm + layer * DM; dst += OFF_WIN; break;
      case 1: jj -= cum[1]; K = 1024; ld = DIN; src = p.w_in + (size_t)layer * DM * DIN; gain = p.attn_norm + layer * DM; dst += OFF_WG; break;
      case 2: jj -= cum[2]; K = 256; ld = 1024; src = p.w_br_sb + (size_t)layer * 256 * 1024; dst += OFF_BRSB; break;
      case 3: jj -= cum[3]; K = 256; ld = 1024; src = p.w_br_sp + (size_t)layer * 256 * 1024; dst += OFF_BRSP; break;
      case 4: jj -= cum[4]; K = 512; ld = 1024; src = p.w_br_df + (size_t)layer * 512 * 1024; dst += OFF_BRDF; break;
      case 5: jj -= cum[5]; K = 1024; ld = 1024; src = p.w_out + (size_t)layer * 1024 * 1024; dst += OFF_OUT; break;
      case 6: jj -= cum[6]; K = 1024; ld = 2 * DFF; src = p.w_up + (size_t)layer * DM * 2 * DFF; gain = p.ffn_norm + layer * DM; dst += OFF_UP; break;
      default: jj -= cum[7]; K = DFF; ld = 1024; src = p.w_down + (size_t)layer * DFF * 1024; dst += OFF_DOWN; break;
    }
    int nkt = K / 64;
    int n0 = (jj / nkt) * 64, k0 = (jj % nkt) * 64;
    if (act) {
      const int nn = t2 & 63, kq = t2 >> 6;
      const int col = wt_srccol(kind, n0 + nn);
      const float* sp = src + (size_t)(k0 + kq) * ld + (col >= 0 ? col : 0);
      float v[16];
#pragma unroll
      for (int i = 0; i < 16; ++i) v[i] = sp[(size_t)(4 * i) * ld];
#pragma unroll
      for (int i = 0; i < 16; ++i) {
        float x = col >= 0 ? v[i] : 0.f;
        if (gain) x *= gain[k0 + kq + 4 * i];
        tl[nn * 65 + kq + 4 * i] = x;
      }
    }
    __syncthreads();
    if (act) {
#pragma unroll
      for (int i = 0; i < 2; ++i) {
        int idx = t2 + 256 * i, nn = idx >> 3, c = idx & 7;
        const float* s = tl + nn * 65 + c * 8;
        u32x4 pk = {pack2bf(s[0], s[1]), pack2bf(s[2], s[3]), pack2bf(s[4], s[5]), pack2bf(s[6], s[7])};
        *(u32x4*)(dst + (size_t)(n0 + nn) * K + k0 + c * 8) = pk;
      }
    }
    __syncthreads();
  }
}

template <int MI, int NI>
DI void gemm_kloop(const u16* Au, int lda, const u16* Bu, int ldb, int K, f32x4 (&acc)[NI][MI], unsigned char* smem) {
  int tid_ = threadIdx.x; asm volatile("" : "+v"(tid_));
  const int tid = tid_, lane = tid & 63, wave = tid >> 6, wm = wave >> 1, wn = wave & 1;
  const int lr = tid >> 3, lc = tid & 7;
  const int voa = lr * lda + lc * 8, vob = lr * ldb + lc * 8;
  constexpr int NB2 = NI / 2;
  u32x4 ra[MI], rb[NB2];
  const int nk = K >> 6;
  const int fsw = (lane & 15) >> 1;
  const int fro0 = (lane & 15) * 128 + (((lane >> 4) ^ fsw) << 4);
  const int fro1 = (lane & 15) * 128 + ((((lane >> 4) + 4) ^ fsw) << 4);
  const int wof = lr * 128 + ((lc ^ ((lr >> 1) & 7)) << 4);
#define GLOAD(K0)                                                                                        \
  {                                                                                                      \
    _Pragma("unroll") for (int q = 0; q < MI; ++q) ra[q] = *(const u32x4*)((Au + (size_t)(q * 64) * lda + (K0)) + voa); \
    _Pragma("unroll") for (int q = 0; q < NB2; ++q) rb[q] = *(const u32x4*)((Bu + (size_t)(q * 64) * ldb + (K0)) + vob); \
  }
#define SWRITE(BUF)                                                                                      \
  {                                                                                                      \
    unsigned char* d_ = smem + (BUF) * 65536 + wof;                                                      \
    _Pragma("unroll") for (int q = 0; q < MI; ++q) *(u32x4*)(d_ + q * 8192) = ra[q];                     \
    _Pragma("unroll") for (int q = 0; q < NB2; ++q) *(u32x4*)(d_ + 32768 + q * 8192) = rb[q];            \
  }
  GLOAD(0);
  SWRITE(0);
  if (nk > 1) GLOAD(64);
  for (int kt = 0; kt < nk; ++kt) {
    __syncthreads();
    if (kt + 1 < nk) {
      SWRITE((kt + 1) & 1);
      if (kt + 2 < nk) GLOAD((kt + 2) << 6);
    }
    {
      const unsigned char* sa = smem + (kt & 1) * 65536;
      const unsigned char* sb = sa + 32768;
#pragma unroll
      for (int ks = 0; ks < 2; ++ks) {
        const int fo = ks ? fro1 : fro0;
        bf16x8 af[MI];
#pragma unroll
        for (int i = 0; i < MI; ++i) af[i] = *(const bf16x8*)(sa + (wm * 16 * MI + i * 16) * 128 + fo);
#pragma unroll
        for (int nh = 0; nh < NI; nh += 4) {
          bf16x8 wf[4];
#pragma unroll
          for (int i = 0; i < 4; ++i) wf[i] = *(const bf16x8*)(sb + (wn * 16 * NI + (nh + i) * 16) * 128 + fo);
#pragma unroll
          for (int ni = 0; ni < 4; ++ni)
#pragma unroll
            for (int mi = 0; mi < MI; ++mi) acc[nh + ni][mi] = mfma16(wf[ni], af[mi], acc[nh + ni][mi]);
        }
      }
    }
  }
  __syncthreads();
#undef GLOAD
#undef SWRITE
}

template <int MI, int NI>
DI void zero_acc(f32x4 (&acc)[NI][MI]) {
#pragma unroll
  for (int i = 0; i < NI; ++i)
#pragma unroll
    for (int j = 0; j < MI; ++j) acc[i][j] = f32x4{0.f, 0.f, 0.f, 0.f};
}

DI void phase_g1(const Params& p, int layer, unsigned char* smem) {
  int tid_ = threadIdx.x; asm volatile("" : "+v"(tid_));
  const int tid = tid_, lane = tid & 63, wave = tid >> 6, wm = wave >> 1, wn = wave & 1;
  const int lr = tid >> 3, lc = tid & 7, lm = lane & 15, lg = lane >> 4;
  const u16* W = p.wts + (size_t)layer * LAYER_W + OFF_WIN;
  const float* rowss = p.rowss + (size_t)(2 * layer) * R;
  constexpr int NT = 13, NTILES = 132 * NT;
  for (int it = vblock(); it < NTILES; it += gridDim.x) {
    const int g = it / (4 * NT), rem = it - g * (4 * NT), nt = rem >> 2, mt = g * 4 + (rem & 3);
    f32x4 acc[8][4];
    zero_acc<4, 8>(acc);
    gemm_kloop<4, 8>(p.hb + (size_t)(mt * 256) * DM, DM, W + (size_t)(nt * 256) * DM, DM, DM, acc, smem);
    int mrow[4];
#pragma unroll
    for (int mi = 0; mi < 4; ++mi) {
      mrow[mi] = mt * 256 + wm * 64 + mi * 16 + lm;
      float rs = rsqrtf(rowss[mrow[mi]] * (1.f / DM) + EPS);
#pragma unroll
      for (int ni = 0; ni < 8; ++ni) acc[ni][mi] *= rs;
    }
    int kind;
    u16* dst = nullptr; int ld = 256, col0 = 0, vrows = 256; const float* gn = nullptr;
    if (nt == 0) { kind = 0; dst = p.qsb; }
    else if (nt == 1) { kind = 0; dst = p.ksb; }
    else if (nt == 2) { kind = 2; dst = p.vtsb; vrows = 256; }
    else if (nt == 3) { kind = 1; dst = p.qsp; gn = p.qn_sp + layer * 64; }
    else if (nt == 4) { kind = 1; dst = p.ksp; gn = p.kn_sp + layer * 64; }
    else if (nt == 5) { kind = 2; dst = p.vtsp; vrows = 256; }
    else if (nt < 8) { kind = 1; dst = p.qdf; ld = 512; col0 = (nt - 6) * 256; gn = p.qn_df + layer * 64; }
    else if (nt < 10) { kind = 1; dst = p.kdf; ld = 512; col0 = (nt - 8) * 256; gn = p.kn_df + layer * 64; }
    else if (nt < 12) { kind = 2; dst = p.vtdf; col0 = (nt - 10) * 256; vrows = 512; }
    else { kind = 0; dst = p.qix; }
    if (kind == 1) {
#pragma unroll
      for (int mi = 0; mi < 4; ++mi)
#pragma unroll
        for (int hh = 0; hh < 2; ++hh) {
          float ss = 0.f;
#pragma unroll
          for (int n4 = 0; n4 < 4; ++n4)
#pragma unroll
            for (int r = 0; r < 4; ++r) ss += acc[hh * 4 + n4][mi][r] * acc[hh * 4 + n4][mi][r];
          ss += __shfl_xor(ss, 16);
          ss += __shfl_xor(ss, 32);
          float sc = rsqrtf(ss * (1.f / 64.f) + EPS);
#pragma unroll
          for (int n4 = 0; n4 < 4; ++n4)
#pragma unroll
            for (int r = 0; r < 4; ++r) acc[hh * 4 + n4][mi][r] *= sc * gn[n4 * 16 + lg * 4 + r];
        }
    }
    if (kind == 0 || kind == 1) {
#pragma unroll
      for (int mi = 0; mi < 4; ++mi)
#pragma unroll
        for (int ni = 0; ni < 8; ++ni) {
          u32x2 pk = {pack2bf(acc[ni][mi][0], acc[ni][mi][1]), pack2bf(acc[ni][mi][2], acc[ni][mi][3])};
          *(u32x2*)(dst + (size_t)mrow[mi] * ld + col0 + wn * 128 + ni * 16 + lg * 4) = pk;
        }
    } else if (kind == 2) {
#pragma unroll
      for (int mi = 0; mi < 4; ++mi) {
        int b = mrow[mi] / TP, t = mrow[mi] - b * TP;
#pragma unroll
        for (int ni = 0; ni < 8; ++ni)
#pragma unroll
          for (int r = 0; r < 4; ++r) {
            int row = col0 + wn * 128 + ni * 16 + lg * 4 + r;
            dst[((size_t)(b * vrows + row)) * TP + t] = f2bf(acc[ni][mi][r]);
          }
      }
    }
  }
  {
    const int v = vblock(), first = NTILES % gridDim.x, nfree = gridDim.x - first;
    if (v >= first) {
      for (int s = v - first; s < 132; s += nfree) {
        const int mt = s;
        f32x4 acc[4][4];
        zero_acc<4, 4>(acc);
        gemm_kloop<4, 4>(p.hb + (size_t)(mt * 256) * DM, DM, W + (size_t)(13 * 256) * DM, DM, DM, acc, smem);
        if (wn == 0) {
#pragma unroll
          for (int mi = 0; mi < 4; ++mi) {
            const int m = mt * 256 + wm * 64 + mi * 16 + lm;
            const float rs = rsqrtf(rowss[m] * (1.f / DM) + EPS);
#pragma unroll
            for (int ni = 0; ni < 2; ++ni) {
              u32x2 pk = {pack2bf(acc[ni][mi][0] * rs, acc[ni][mi][1] * rs), pack2bf(acc[ni][mi][2] * rs, acc[ni][mi][3] * rs)};
              *(u32x2*)(p.kix + (size_t)m * 32 + ni * 16 + lg * 4) = pk;
            }
            if (lg < 2) {
              float4 w4 = make_float4(acc[2][mi][0] * rs, acc[2][mi][1] * rs, acc[2][mi][2] * rs, acc[2][mi][3] * rs);
              *(float4*)(p.wix + (size_t)m * 8 + lg * 4) = w4;
            }
          }
        }
      }
    }
  }
}

template <int MI, int NI>
DI void resid_epilogue(const Params& p, int from_x, const f32x4 (&acc)[NI][MI], int row0, int n0, float* rowss_next, bool last, int lm, int lg) {
#pragma unroll
  for (int mi = 0; mi < MI; ++mi) {
    const int m = row0 + mi * 16 + lm;
    const float* hr = hrow_r(p, from_x == 1 ? 0 : 1, m);
    float* hw = hrow_w(p, m);
    u16* hbr = p.hb + (size_t)m * DM;
    float ss = 0.f;
#pragma unroll
    for (int ni = 0; ni < NI; ++ni) {
      const int n = n0 + ni * 16 + lg * 4;
      float4 h;
      if (from_x >= 2) {
        const u32x2 pk = *(const u32x2*)(hbr + n);
        h = make_float4(__uint_as_float(pk[0] << 16), __uint_as_float(pk[0] & 0xffff0000u), __uint_as_float(pk[1] << 16), __uint_as_float(pk[1] & 0xffff0000u));
      } else h = *(const float4*)(hr + n);
      h.x += acc[ni][mi][0]; h.y += acc[ni][mi][1]; h.z += acc[ni][mi][2]; h.w += acc[ni][mi][3];
      if (last) *(float4*)(hw + n) = h;
      if (!last) {
        u32x2 pk = {pack2bf(h.x, h.y), pack2bf(h.z, h.w)};
        *(u32x2*)(hbr + n) = pk;
        ss += h.x * h.x + h.y * h.y + h.z * h.z + h.w * h.w;
      }
    }
    if (!last) {
      ss += __shfl_xor(ss, 16);
      ss += __shfl_xor(ss, 32);
      if (lg == 0) atomicAdd(rowss_next + m, ss);
    }
  }
}

DI void phase_resid(const Params& p, int from_x, const u16* A, int K, const u16* W, float* rowss_next, bool last,
                    unsigned char* smem) {
  int tid_ = threadIdx.x; asm volatile("" : "+v"(tid_));
  const int tid = tid_, lane = tid & 63, wave = tid >> 6, wm = wave >> 1, wn = wave & 1;
  const int lm = lane & 15, lg = lane >> 4;
  constexpr int NT = 4, NTILES = 132 * NT;
  const int nfull = (NTILES / (int)gridDim.x) * (int)gridDim.x;
  for (int it = vblock(); it < nfull; it += gridDim.x) {
    const int g = it / (4 * NT), rem = it - g * (4 * NT), nt = rem >> 2, mt = g * 4 + (rem & 3);
    f32x4 acc[8][4];
    zero_acc<4, 8>(acc);
    gemm_kloop<4, 8>(A + (size_t)(mt * 256) * K, K, W + (size_t)(nt * 256) * K, K, K, acc, smem);
    resid_epilogue<4, 8>(p, from_x, acc, mt * 256 + wm * 64, nt * 256 + wn * 128, rowss_next, last, lm, lg);
  }
  for (int s = vblock(); s < 4 * (NTILES - nfull); s += gridDim.x) {
    const int it = nfull + (s >> 2), hm = s & 1, hn = (s >> 1) & 1;
    const int g = it / (4 * NT), rem = it - g * (4 * NT), nt = rem >> 2, mt = g * 4 + (rem & 3);
    f32x4 acc[4][2];
    zero_acc<2, 4>(acc);
    gemm_kloop<2, 4>(A + (size_t)(mt * 256 + hm * 128) * K, K, W + (size_t)(nt * 256 + hn * 128) * K, K, K, acc, smem);
    resid_epilogue<2, 4>(p, from_x, acc, mt * 256 + hm * 128 + wm * 32, nt * 256 + hn * 128 + wn * 64, rowss_next, last, lm, lg);
  }
}

template <int MI>
DI void merge_tile(const Params& p, int layer, int rowbase, int nt, unsigned char* smem) {
  int tid_ = threadIdx.x; asm volatile("" : "+v"(tid_));
  const int tid = tid_, lane = tid & 63, wave = tid >> 6, wm = wave >> 1, wn = wave & 1;
  const int lm = lane & 15, lg = lane >> 4;
  const u16* WL = p.wts + (size_t)layer * LAYER_W;
  const float* rowss = p.rowss + (size_t)(2 * layer) * R;
  const float* bg = p.b_gate + layer * 3 * DM;
  u32 mp[4][MI][2];
#pragma unroll
  for (int ni = 0; ni < 4; ++ni)
#pragma unroll
    for (int mi = 0; mi < MI; ++mi) { mp[ni][mi][0] = 0u; mp[ni][mi][1] = 0u; }
#pragma unroll 1
  for (int br = 0; br < 3; ++br) {
    const u16* Y = br == 0 ? p.ysb : (br == 1 ? p.ysp : p.ydf);
    const int Kb = br == 2 ? 512 : 256;
    const u16* Wb = WL + (br == 0 ? OFF_BRSB : (br == 1 ? OFF_BRSP : OFF_BRDF));
    f32x4 acc[4][MI];
    zero_acc<MI, 4>(acc);
    gemm_kloop<MI, 4>(Y + (size_t)rowbase * Kb, Kb, Wb + (size_t)(nt * 128) * Kb, Kb, Kb, acc, smem);
    u32 brp[4][MI][2];
#pragma unroll
    for (int ni = 0; ni < 4; ++ni)
#pragma unroll
      for (int mi = 0; mi < MI; ++mi) {
        brp[ni][mi][0] = pack2bf(acc[ni][mi][0], acc[ni][mi][1]);
        brp[ni][mi][1] = pack2bf(acc[ni][mi][2], acc[ni][mi][3]);
      }
    zero_acc<MI, 4>(acc);
    gemm_kloop<MI, 4>(p.hb + (size_t)rowbase * DM, DM, WL + OFF_WG + (size_t)(br * 1024 + nt * 128) * DM, DM, DM, acc, smem);
    int m0 = rowbase + wm * 16 * MI + lm, n0 = nt * 128 + wn * 64 + lg * 4;
    asm volatile("" : "+v"(m0), "+v"(n0));
#pragma unroll
    for (int mi = 0; mi < MI; ++mi) {
      const float rs = rsqrtf(rowss[m0 + mi * 16] * (1.f / DM) + EPS);
#pragma unroll
      for (int ni = 0; ni < 4; ++ni) {
        const float4 b4 = *(const float4*)(bg + br * DM + n0 + ni * 16);
        const float bb[4] = {b4.x, b4.y, b4.z, b4.w};
        float mv[4];
#pragma unroll
        for (int r = 0; r < 4; ++r) {
          const float gv = acc[ni][mi][r] * rs + bb[r];
          const float sg = 1.f / (1.f + __expf(-gv));
          const u32 w = brp[ni][mi][r >> 1], mw = mp[ni][mi][r >> 1];
          const float bv = __uint_as_float((r & 1) ? (w & 0xffff0000u) : (w << 16));
          const float mo = __uint_as_float((r & 1) ? (mw & 0xffff0000u) : (mw << 16));
          mv[r] = mo + sg * bv;
        }
        mp[ni][mi][0] = pack2bf(mv[0], mv[1]);
        mp[ni][mi][1] = pack2bf(mv[2], mv[3]);
      }
    }
  }
  int m0 = rowbase + wm * 16 * MI + lm, n0 = nt * 128 + wn * 64 + lg * 4;
  asm volatile("" : "+v"(m0), "+v"(n0));
#pragma unroll
  for (int mi = 0; mi < MI; ++mi)
#pragma unroll
    for (int ni = 0; ni < 4; ++ni) {
      u32x2 pk = {mp[ni][mi][0], mp[ni][mi][1]};
      *(u32x2*)(p.merged + (size_t)(m0 + mi * 16) * DM + n0 + ni * 16) = pk;
    }
}

DI void phase_merge(const Params& p, int layer, unsigned char* smem) {
  constexpr int NT = 8, NTILES = 132 * NT;
  const int nfull = (NTILES / (int)gridDim.x) * (int)gridDim.x;
  for (int it = vblock(); it < nfull; it += gridDim.x) {
    const int g = it / (4 * NT), rem = it - g * (4 * NT), nt = rem >> 2, mt = g * 4 + (rem & 3);
    merge_tile<4>(p, layer, mt * 256, nt, smem);
  }
  for (int s = vblock(); s < 2 * (NTILES - nfull); s += gridDim.x) {
    const int it = nfull + (s >> 1), hf = s & 1;
    const int g = it / (4 * NT), rem = it - g * (4 * NT), nt = rem >> 2, mt = g * 4 + (rem & 3);
    merge_tile<2>(p, layer, mt * 256 + hf * 128, nt, smem);
  }
}

DI void phase_ffnup(const Params& p, int layer, unsigned char* smem) {
  int tid_ = threadIdx.x; asm volatile("" : "+v"(tid_));
  const int tid = tid_, lane = tid & 63, wave = tid >> 6, wm = wave >> 1, wn = wave & 1;
  const int lr = tid >> 3, lc = tid & 7, lm = lane & 15, lg = lane >> 4;
  const u16* W = p.wts + (size_t)layer * LAYER_W + OFF_UP;
  const float* rowss = p.rowss + (size_t)(2 * layer + 1) * R;
  const float* cw = p.conv_w + layer * 3 * DFF;
  const float* cb = p.conv_b + layer * DFF;
  constexpr int NT = 22, MT = 136, NTILES = MT * NT;
  float* G = (float*)smem;
  for (int it = vblock(); it < NTILES; it += gridDim.x) {
    const int g = it / (4 * NT), rem = it - g * (4 * NT), nt = rem >> 2, mt = g * 4 + (rem & 3);
    const int b = mt / 17, ti = mt - b * 17, tbase = 254 * ti - 2;
    f32x4 acc[8][4];
    zero_acc<4, 8>(acc);
    gemm_kloop<4, 8>(p.hb + ((ptrdiff_t)(b * TP + tbase)) * DM, DM, W + (size_t)(nt * 256) * DM, DM, DM, acc, smem);
    int r0 = wm * 64 + lm, gc0 = 64 * wn + 4 * lg;
    asm volatile("" : "+v"(r0), "+v"(gc0));
    int tt[4];
#pragma unroll
    for (int mi = 0; mi < 4; ++mi) {
      const int r = r0 + mi * 16;
      tt[mi] = tbase + r;
      float rs = (tt[mi] >= 0 && tt[mi] < TP) ? rsqrtf(rowss[b * TP + tt[mi]] * (1.f / DM) + EPS) : 0.f;
#pragma unroll
      for (int ni = 0; ni < 8; ++ni) acc[ni][mi] *= rs;
#pragma unroll
      for (int n2 = 0; n2 < 4; ++n2) {
        float4 g4 = make_float4(acc[2 * n2][mi][0], acc[2 * n2][mi][1], acc[2 * n2][mi][2], acc[2 * n2][mi][3]);
        *(float4*)(G + r * 132 + gc0 + 16 * n2) = g4;
      }
    }
    __syncthreads();
#pragma unroll
    for (int n2 = 0; n2 < 4; ++n2) {
      const int gc = gc0 + 16 * n2;
      const int ff = 128 * nt + gc;
      const float4 w0 = *(const float4*)(cw + ff), w1 = *(const float4*)(cw + DFF + ff), w2 = *(const float4*)(cw + 2 * DFF + ff);
      const float4 c4 = *(const float4*)(cb + ff);
#pragma unroll
      for (int mi = 0; mi < 4; ++mi) {
        const int r = r0 + mi * 16;
        if (r >= 2 && tt[mi] < TP) {
          const float4 g1 = *(const float4*)(G + (r - 1) * 132 + gc);
          const float4 g2 = *(const float4*)(G + (r - 2) * 132 + gc);
          float cv[4];
          cv[0] = c4.x + w0.x * g2.x + w1.x * g1.x + w2.x * acc[2 * n2][mi][0];
          cv[1] = c4.y + w0.y * g2.y + w1.y * g1.y + w2.y * acc[2 * n2][mi][1];
          cv[2] = c4.z + w0.z * g2.z + w1.z * g1.z + w2.z * acc[2 * n2][mi][2];
          cv[3] = c4.w + w0.w * g2.w + w1.w * g1.w + w2.w * acc[2 * n2][mi][3];
          float a[4];
#pragma unroll
          for (int e = 0; e < 4; ++e) a[e] = cv[e] / (1.f + __expf(-cv[e])) * acc[2 * n2 + 1][mi][e];
          u32x2 pk = {pack2bf(a[0], a[1]), pack2bf(a[2], a[3])};
          *(u32x2*)(p.act + (size_t)(b * TP + tt[mi]) * DFF + ff) = pk;
        }
      }
    }
    __syncthreads();
  }
}

DI int swap23(int k) { return (k & ~12) | ((k & 4) << 1) | ((k & 8) >> 1); }

DI void build_lut(const Params& p, int bias_head, unsigned char* smem, int tid) {
  float* lut = (float*)(smem + LUT_OFF);
  const int d = tid;
  if (d <= 128) {
    int bucket;
    if (d < 16) bucket = d;
    else {
      float nf = (float)d;
      int large = 16 + (int)(logf(nf / 16.f) / 2.0794415416798357f * 16.f);
      bucket = large < 31 ? large : 31;
    }
    lut[d] = p.rel_bias[bucket * 8 + bias_head] * LOG2E;
  }
}

template <int NCH>
DI void ld_tile_g(u32x4 (&r)[NCH], const u16* base, size_t rstride, int k0, bool is_vt, int tid) {
#pragma unroll
  for (int i = 0; i < NCH; ++i) {
    int id = tid + 256 * i, row = id >> 3, c = id & 7;
    const u16* s = is_vt ? base + (size_t)row * rstride + k0 + c * 8 : base + (size_t)(k0 + row) * rstride + c * 8;
    r[i] = *(const u32x4*)s;
  }
}
template <int NCH>
DI void st_tile_s(const u32x4 (&r)[NCH], unsigned char* dst, bool permute, int tid) {
#pragma unroll
  for (int i = 0; i < NCH; ++i) {
    int id = tid + 256 * i, row = id >> 3, c = id & 7;
    int rr = permute ? swap23(row) : row;
    *(u32x4*)(dst + rr * 144 + c * 16) = r[i];
  }
}

DI bf16x8 pack8(const f32x16& v, int s2) {
  u32x4 pk;
  if (s2 == 0) pk = u32x4{pack2bf(v[0], v[1]), pack2bf(v[2], v[3]), pack2bf(v[4], v[5]), pack2bf(v[6], v[7])};
  else pk = u32x4{pack2bf(v[8], v[9]), pack2bf(v[10], v[11]), pack2bf(v[12], v[13]), pack2bf(v[14], v[15])};
  return __builtin_bit_cast(bf16x8, pk);
}
DI f32x16 zero16() {
  f32x16 z;
#pragma unroll
  for (int i = 0; i < 16; ++i) z[i] = 0.f;
  return z;
}

DI void diff_map(const unsigned char* sk, const bf16x8 (&qf)[4], const unsigned char* sv, const float* lut, bool far,
                 bool diag, int ks0, int tq, int h, int lq, f32x16 (&O)[4], float& m, float& l) {
  const float csc = 0.125f * LOG2E;
  f32x16 S = zero16();
#pragma unroll
  for (int s = 0; s < 4; ++s) {
    bf16x8 kf = *(const bf16x8*)(sk + lq * 144 + (16 * s + 8 * h) * 2);
    S = mfma32(kf, qf[s], S);
  }
  if (far) {
    const float cbias = lut[128];
    float mx = fmaxf(fmaxf(S[0], S[1]), S[2]);
#pragma unroll
    for (int i = 3; i < 15; i += 2) mx = fmaxf(fmaxf(mx, S[i]), S[i + 1]);
    mx = fmaxf(mx, S[15]);
    mx = fmaxf(mx, __shfl_xor(mx, 32));
    const float mn = fmaxf(m, mx * csc + cbias);
    if (__any(mn > m)) {
      const float a = __builtin_amdgcn_exp2f(m - mn);
      l *= a; m = mn;
#pragma unroll
      for (int d = 0; d < 4; ++d) O[d] *= a;
    }
    const float off = cbias - m;
#pragma unroll
    for (int i = 0; i < 16; ++i) { float pv = __builtin_amdgcn_exp2f(S[i] * csc + off); l += pv; S[i] = pv; }
  } else {
    float mx = -1e30f;
#pragma unroll
    for (int i = 0; i < 16; ++i) {
      const int key = ks0 + 16 * (i >> 3) + 8 * h + (i & 7);
      int d = tq - key;
      const bool msk = diag && d < 0;
      d = d < 0 ? 0 : (d > 128 ? 128 : d);
      float x = S[i] * csc + lut[d];
      if (msk) x = -1e30f;
      S[i] = x;
      mx = fmaxf(mx, x);
    }
    mx = fmaxf(mx, __shfl_xor(mx, 32));
    const float mn = fmaxf(m, mx);
    if (__any(mn > m)) {
      const float a = __builtin_amdgcn_exp2f(m - mn);
      l *= a; m = mn;
#pragma unroll
      for (int d = 0; d < 4; ++d) O[d] *= a;
    }
#pragma unroll
    for (int i = 0; i < 16; ++i) { float pv = __builtin_amdgcn_exp2f(S[i] - m); l += pv; S[i] = pv; }
  }
  const bf16x8 p0 = pack8(S, 0), p1 = pack8(S, 1);
#pragma unroll
  for (int d = 0; d < 4; ++d) {
    bf16x8 v0 = *(const bf16x8*)(sv + (d * 32 + lq) * 144 + 16 * h);
    bf16x8 v1 = *(const bf16x8*)(sv + (d * 32 + lq) * 144 + 32 + 16 * h);
    O[d] = mfma32(v0, p0, O[d]);
    O[d] = mfma32(v1, p1, O[d]);
  }
}

DI void diff_map_far2(const unsigned char* sk, const bf16x8 (&qf)[4], const unsigned char* sv, float cbias, int h, int lq,
                      f32x16 (&O)[4], float& m, float& l) {
  const float csc = 0.125f * LOG2E;
  f32x16 S0 = zero16(), S1 = zero16();
#pragma unroll
  for (int s = 0; s < 4; ++s) {
    bf16x8 k0 = *(const bf16x8*)(sk + lq * 144 + (16 * s + 8 * h) * 2);
    bf16x8 k1 = *(const bf16x8*)(sk + (32 + lq) * 144 + (16 * s + 8 * h) * 2);
    S0 = mfma32(k0, qf[s], S0);
    S1 = mfma32(k1, qf[s], S1);
  }
  float mx = fmaxf(fmaxf(S0[0], S0[1]), S0[2]);
#pragma unroll
  for (int i = 3; i < 15; i += 2) mx = fmaxf(fmaxf(mx, S0[i]), S0[i + 1]);
  mx = fmaxf(mx, S0[15]);
#pragma unroll
  for (int i = 0; i < 16; i += 2) mx = fmaxf(fmaxf(mx, S1[i]), S1[i + 1]);
  mx = fmaxf(mx, __shfl_xor(mx, 32));
  const float mn = fmaxf(m, mx * csc + cbias);
  if (__any(mn > m)) {
    const float a = __builtin_amdgcn_exp2f(m - mn);
    l *= a; m = mn;
#pragma unroll
    for (int d = 0; d < 4; ++d) O[d] *= a;
  }
  const float off = cbias - m;
  float la = 0.f, lb = 0.f;
#pragma unroll
  for (int i = 0; i < 16; ++i) {
    float pa = __builtin_amdgcn_exp2f(S0[i] * csc + off), pb = __builtin_amdgcn_exp2f(S1[i] * csc + off);
    la += pa; lb += pb; S0[i] = pa; S1[i] = pb;
  }
  l += la + lb;
  const bf16x8 p0 = pack8(S0, 0), p1 = pack8(S0, 1), p2 = pack8(S1, 0), p3 = pack8(S1, 1);
#pragma unroll
  for (int d = 0; d < 4; ++d) {
    const unsigned char* vr = sv + (d * 32 + lq) * 144 + 16 * h;
    bf16x8 v0 = *(const bf16x8*)(vr), v1 = *(const bf16x8*)(vr + 32), v2 = *(const bf16x8*)(vr + 64), v3 = *(const bf16x8*)(vr + 96);
    O[d] = mfma32(v0, p0, O[d]);
    O[d] = mfma32(v1, p1, O[d]);
    O[d] = mfma32(v2, p2, O[d]);
    O[d] = mfma32(v3, p3, O[d]);
  }
}

DI void diff_job8(const Params& p, int layer, int b, int head, int qb, unsigned char* smem) {
  int tid_ = threadIdx.x; asm volatile("" : "+v"(tid_));
  const int tid = tid_, lane = tid & 63, wave = tid >> 6, h = lane >> 5, lq = lane & 31;
  const int map = wave >> 2, qg = wave & 3;
  const int t0 = qb * 128, tw0 = t0 + 32 * qg, tq = tw0 + lq;
  const float* lut = (const float*)(smem + LUT_OFF);
  build_lut(p, 4 + head, smem, tid);
  bf16x8 qf[4];
  {
    const u16* qr = p.qdf + (size_t)(b * TP + tq) * 512 + head * 128 + 64 * map + 8 * h;
#pragma unroll
    for (int s = 0; s < 4; ++s) qf[s] = *(const bf16x8*)(qr + 16 * s);
  }
  f32x16 O[4];
#pragma unroll
  for (int i = 0; i < 4; ++i) O[i] = zero16();
  float m = -1e30f, l = 0.f;
  const u16* K1 = p.kdf + (size_t)b * TP * 512 + head * 128;
  const u16* VT = p.vtdf + (size_t)(b * 512 + head * 128) * TP;
  const int ntile = 2 * (qb + 1);
  const int krow = tid >> 3, kc = tid & 7, krs = swap23(krow);
  u32x4 rk1, rk2, rv[2];
  auto gl = [&](int k0) {
    const u16* s = K1 + (size_t)(k0 + krow) * 512 + kc * 8;
    rk1 = *(const u32x4*)s; rk2 = *(const u32x4*)(s + 64);
#pragma unroll
    for (int i = 0; i < 2; ++i) rv[i] = *(const u32x4*)(VT + (size_t)(krow + 64 * i) * TP + k0 + kc * 8);
  };
  auto sl = [&](unsigned char* d) {
    *(u32x4*)(d + krs * 144 + kc * 16) = rk1;
    *(u32x4*)(d + 9216 + krs * 144 + kc * 16) = rk2;
#pragma unroll
    for (int i = 0; i < 2; ++i) *(u32x4*)(d + 18432 + (krow + 64 * i) * 144 + kc * 16) = rv[i];
  };
  gl(0); sl(smem);
  if (ntile > 1) gl(64);
  __syncthreads();
  const float cbias = lut[128];
  for (int j = 0; j < ntile; ++j) {
    __syncthreads();
    if (j + 1 < ntile) { sl(smem + ((j + 1) & 1) * 36864); if (j + 2 < ntile) gl((j + 2) * 64); }
    const unsigned char* sb = smem + (j & 1) * 36864;
    const unsigned char* sk = sb + 9216 * map;
    const int k0 = j * 64;
    if (tw0 - (k0 + 63) >= 113) {
      diff_map_far2(sk, qf, sb + 18432, cbias, h, lq, O, m, l);
    } else {
#pragma unroll 1
      for (int sub = 0; sub < 2; ++sub) {
        const int ks0 = k0 + sub * 32;
        if (ks0 > tw0 + 31) break;
        const bool far = (tw0 - (ks0 + 31)) >= 113;
        const bool diag = (ks0 + 31) > tw0;
        diff_map(sk + sub * 32 * 144, qf, sb + 18432 + sub * 64, lut, far, diag, ks0, tq, h, lq, O, m, l);
      }
    }
  }
  __syncthreads();
  float lam;
  const float lam_init = 0.8f - 0.6f * expf(-0.3f * (float)layer);
  {
    float a = p.lq1[layer * 64 + lane] * p.lk1[layer * 64 + lane];
    float c = p.lq2[layer * 64 + lane] * p.lk2[layer * 64 + lane];
    a = wave_sum(a); c = wave_sum(c);
    lam = expf(a) - expf(c) + lam_init;
  }
  l += __shfl_xor(l, 32);
  const float il = (map ? lam : 1.f) / l;
  float* X = (float*)smem + (size_t)(qg * 32 + lq) * 132;
  if (map == 1) {
#pragma unroll
    for (int d = 0; d < 4; ++d)
#pragma unroll
      for (int g = 0; g < 4; ++g) {
        float4 v = make_float4(O[d][4 * g] * il, O[d][4 * g + 1] * il, O[d][4 * g + 2] * il, O[d][4 * g + 3] * il);
        *(float4*)(X + 32 * d + 8 * g + 4 * h) = v;
      }
  }
  __syncthreads();
  if (map == 0) {
    float ss = 0.f;
#pragma unroll
    for (int d = 0; d < 4; ++d)
#pragma unroll
      for (int g = 0; g < 4; ++g) {
        const float4 v = *(const float4*)(X + 32 * d + 8 * g + 4 * h);
        float y0 = O[d][4 * g] * il - v.x, y1 = O[d][4 * g + 1] * il - v.y, y2 = O[d][4 * g + 2] * il - v.z, y3 = O[d][4 * g + 3] * il - v.w;
        O[d][4 * g] = y0; O[d][4 * g + 1] = y1; O[d][4 * g + 2] = y2; O[d][4 * g + 3] = y3;
        ss += y0 * y0 + y1 * y1 + y2 * y2 + y3 * y3;
      }
    ss += __shfl_xor(ss, 32);
    const float sc = rsqrtf(ss * (1.f / 128.f) + EPS) * (1.f - lam_init);
    const float* sg = p.subln + layer * 128;
    u16* yr = p.ydf + (size_t)(b * TP + tq) * 512 + head * 128;
#pragma unroll
    for (int d = 0; d < 4; ++d)
#pragma unroll
      for (int g = 0; g < 4; ++g) {
        const int dv = 32 * d + 8 * g + 4 * h;
        const float4 g4 = *(const float4*)(sg + dv);
        u32x2 pk = {pack2bf(O[d][4 * g] * sc * g4.x, O[d][4 * g + 1] * sc * g4.y),
                    pack2bf(O[d][4 * g + 2] * sc * g4.z, O[d][4 * g + 3] * sc * g4.w)};
        *(u32x2*)(yr + dv) = pk;
      }
  }
  __syncthreads();
}

DI void sparse_job(const Params& p, int layer, int b, int head, int qb, unsigned char* smem) {
  int tid_ = threadIdx.x & 255; asm volatile("" : "+v"(tid_));
  const int tid = tid_, lane = tid & 63, wave = tid >> 6, h = lane >> 5, lq = lane & 31;
  const int t0 = qb * 128, tw0 = t0 + 32 * wave, tq = tw0 + lq;
  const float* lut = (const float*)(smem + LUT_OFF);
  build_lut(p, head, smem, tid);
  bf16x8 qf[4];
  {
    const u16* qr = p.qsp + (size_t)(b * TP + tq) * 256 + head * 64 + 8 * h;
#pragma unroll
    for (int s = 0; s < 4; ++s) qf[s] = *(const bf16x8*)(qr + 16 * s);
  }
  f32x16 O[2] = {zero16(), zero16()};
  float m = -1e30f, l = 0.f;
  const u16* Kp = p.ksp + (size_t)b * TP * 256 + head * 64;
  const u16* VT = p.vtsp + (size_t)(b * 256 + head * 64) * TP;
  const u32* mrow = p.mask + (size_t)(b * TP + tq) * MW;
  const int ntile = 2 * (qb + 1);
  const float csc = 0.125f * LOG2E;
  u32x4 rk[2], rv[2];
  ld_tile_g<2>(rk, Kp, 256, 0, false, tid); ld_tile_g<2>(rv, VT, TP, 0, true, tid);
  u32x2 mnext = *(const u32x2*)(mrow);
  st_tile_s<2>(rk, smem, true, tid); st_tile_s<2>(rv, smem + 9216, false, tid);
  if (ntile > 1) { ld_tile_g<2>(rk, Kp, 256, 64, false, tid); ld_tile_g<2>(rv, VT, TP, 64, true, tid); }
  for (int j = 0; j < ntile; ++j) {
    const bool more = j + 1 < ntile;
    const u32x2 mcur = mnext;
    __syncthreads();
    if (more) {
      unsigned char* d = smem + ((j + 1) & 1) * 18432; st_tile_s<2>(rk, d, true, tid); st_tile_s<2>(rv, d + 9216, false, tid);
      mnext = *(const u32x2*)(mrow + 2 * (j + 1));
      if (j + 2 < ntile) { const int k0 = (j + 2) * 64; ld_tile_g<2>(rk, Kp, 256, k0, false, tid); ld_tile_g<2>(rv, VT, TP, k0, true, tid); }
    }
    const unsigned char* sb = smem + (j & 1) * 18432;
    if (tw0 - (j * 64 + 63) >= 113) {
      const float cbias = lut[128];
      f32x16 S0 = zero16(), S1 = zero16();
#pragma unroll
      for (int s = 0; s < 4; ++s) {
        bf16x8 k0 = *(const bf16x8*)(sb + lq * 144 + (16 * s + 8 * h) * 2);
        bf16x8 k1 = *(const bf16x8*)(sb + (32 + lq) * 144 + (16 * s + 8 * h) * 2);
        S0 = mfma32(k0, qf[s], S0);
        S1 = mfma32(k1, qf[s], S1);
      }
      const u32 sa = ((mcur[0] >> (8 * h)) & 0xffu) | (((mcur[0] >> (16 + 8 * h)) & 0xffu) << 8);
      const u32 sb2 = ((mcur[1] >> (8 * h)) & 0xffu) | (((mcur[1] >> (16 + 8 * h)) & 0xffu) << 8);
      float mx = -1e30f;
#pragma unroll
      for (int i = 0; i < 16; ++i) {
        mx = fmaxf(mx, (sa & (1u << i)) ? S0[i] : -1e30f);
        mx = fmaxf(mx, (sb2 & (1u << i)) ? S1[i] : -1e30f);
      }
      mx = fmaxf(mx, __shfl_xor(mx, 32));
      const float mn = mx > -1e29f ? fmaxf(m, mx * csc + cbias) : m;
      if (__any(mn > m)) {
        const float a = __builtin_amdgcn_exp2f(m - mn);
        l *= a; O[0] *= a; O[1] *= a;
        m = mn;
      }
      const float off = cbias - m;
      float la = 0.f, lb = 0.f;
#pragma unroll
      for (int i = 0; i < 16; ++i) {
        const float pa = (sa & (1u << i)) ? __builtin_amdgcn_exp2f(S0[i] * csc + off) : 0.f;
        const float pb = (sb2 & (1u << i)) ? __builtin_amdgcn_exp2f(S1[i] * csc + off) : 0.f;
        la += pa; lb += pb; S0[i] = pa; S1[i] = pb;
      }
      l += la + lb;
      const bf16x8 p0 = pack8(S0, 0), p1 = pack8(S0, 1), p2 = pack8(S1, 0), p3 = pack8(S1, 1);
#pragma unroll
      for (int d = 0; d < 2; ++d) {
        const unsigned char* vr = sb + 9216 + (d * 32 + lq) * 144 + 16 * h;
        bf16x8 v0 = *(const bf16x8*)(vr), v1 = *(const bf16x8*)(vr + 32), v2 = *(const bf16x8*)(vr + 64), v3 = *(const bf16x8*)(vr + 96);
        O[d] = mfma32(v0, p0, O[d]);
        O[d] = mfma32(v1, p1, O[d]);
        O[d] = mfma32(v2, p2, O[d]);
        O[d] = mfma32(v3, p3, O[d]);
      }
    } else
#pragma unroll 1
    for (int sub = 0; sub < 2; ++sub) {
      const int ks0 = j * 64 + sub * 32;
      if (ks0 > tw0 + 31) break;
      const u32 mw = sub ? mcur[1] : mcur[0];
      if (!__any(mw != 0u)) continue;
      f32x16 S = zero16();
#pragma unroll
      for (int s = 0; s < 4; ++s) {
        bf16x8 k1 = *(const bf16x8*)(sb + (sub * 32 + lq) * 144 + (16 * s + 8 * h) * 2);
        S = mfma32(k1, qf[s], S);
      }
      const bool far = (tw0 - (ks0 + 31)) >= 113;
      const float cbias = lut[128];
      const u32 sel16 = ((mw >> (8 * h)) & 0xffu) | (((mw >> (16 + 8 * h)) & 0xffu) << 8);
      if (far) {
        float mx = -1e30f;
#pragma unroll
        for (int i = 0; i < 16; ++i) mx = fmaxf(mx, (sel16 & (1u << i)) ? S[i] : -1e30f);
        mx = fmaxf(mx, __shfl_xor(mx, 32));
        const float mn = mx > -1e29f ? fmaxf(m, mx * csc + cbias) : m;
        if (__any(mn > m)) {
          const float a = __builtin_amdgcn_exp2f(m - mn);
          l *= a; O[0] *= a; O[1] *= a;
          m = mn;
        }
        const float off = cbias - m;
#pragma unroll
        for (int i = 0; i < 16; ++i) {
          float pv = (sel16 & (1u << i)) ? __builtin_amdgcn_exp2f(S[i] * csc + off) : 0.f;
          l += pv;
          S[i] = pv;
        }
      } else {
        float mx = -1e30f;
#pragma unroll
        for (int i = 0; i < 16; ++i) {
          const int ko = 16 * (i >> 3) + 8 * h + (i & 7);
          int d = tq - (ks0 + ko); d = d < 0 ? 0 : (d > 128 ? 128 : d);
          float x = S[i] * csc + lut[d];
          if (!(sel16 & (1u << i))) x = -1e30f;
          S[i] = x;
          mx = fmaxf(mx, x);
        }
        mx = fmaxf(mx, __shfl_xor(mx, 32));
        const float mn = fmaxf(m, mx);
        if (__any(mn > m)) {
          const float a = __builtin_amdgcn_exp2f(m - mn);
          l *= a; O[0] *= a; O[1] *= a;
          m = mn;
        }
#pragma unroll
        for (int i = 0; i < 16; ++i) {
          float pv = S[i] > -1e29f ? __builtin_amdgcn_exp2f(S[i] - m) : 0.f;
          l += pv;
          S[i] = pv;
        }
      }
      bf16x8 pa0 = pack8(S, 0), pa1 = pack8(S, 1);
#pragma unroll
      for (int d = 0; d < 2; ++d) {
        bf16x8 v0 = *(const bf16x8*)(sb + 9216 + (d * 32 + lq) * 144 + (sub * 32 + 8 * h) * 2);
        bf16x8 v1 = *(const bf16x8*)(sb + 9216 + (d * 32 + lq) * 144 + (sub * 32 + 16 + 8 * h) * 2);
        O[d] = mfma32(v0, pa0, O[d]);
        O[d] = mfma32(v1, pa1, O[d]);
      }
    }
  }
  __syncthreads();
  l += __shfl_xor(l, 32);
  const float il = 1.f / l;
  u16* yr = p.ysp + (size_t)(b * TP + tq) * 256 + head * 64;
#pragma unroll
  for (int d = 0; d < 2; ++d)
#pragma unroll
    for (int g = 0; g < 4; ++g) {
      u32x2 pk = {pack2bf(O[d][4 * g] * il, O[d][4 * g + 1] * il), pack2bf(O[d][4 * g + 2] * il, O[d][4 * g + 3] * il)};
      *(u32x2*)(yr + 32 * d + 8 * g + 4 * h) = pk;
    }
  __syncthreads();
}

DI void sb_job(const Params& p, int b, int head, int qb, unsigned char* smem) {
  int tid_ = threadIdx.x & 255; asm volatile("" : "+v"(tid_));
  const int tid = tid_, lane = tid & 63, wave = tid >> 6, h = lane >> 5, lq = lane & 31;
  const int t0 = qb * 128, tw0 = t0 + 32 * wave, tq = tw0 + lq;
  bf16x8 qf[4];
  {
    const u16* qr = p.qsb + (size_t)(b * TP + tq) * 256 + head * 64 + 8 * h;
#pragma unroll
    for (int s = 0; s < 4; ++s) qf[s] = *(const bf16x8*)(qr + 16 * s);
  }
  f32x16 O[2] = {zero16(), zero16()};
  float carry = 0.f;
  const u16* Kp = p.ksb + (size_t)b * TP * 256 + head * 64;
  const u16* VT = p.vtsb + (size_t)(b * 256 + head * 64) * TP;
  const int ntile = 2 * (qb + 1);
  u32x4 rk[2], rv[2];
  ld_tile_g<2>(rk, Kp, 256, (ntile - 1) * 64, false, tid); ld_tile_g<2>(rv, VT, TP, (ntile - 1) * 64, true, tid);
  st_tile_s<2>(rk, smem, true, tid); st_tile_s<2>(rv, smem + 9216, false, tid);
  __syncthreads();
  for (int jj = 0; jj < ntile; ++jj) {
    const int j = ntile - 1 - jj;
    const bool more = jj + 1 < ntile;
    if (more) { const int k0 = (j - 1) * 64; ld_tile_g<2>(rk, Kp, 256, k0, false, tid); ld_tile_g<2>(rv, VT, TP, k0, true, tid); }
    __builtin_amdgcn_sched_barrier(0);
    const unsigned char* sb = smem + (jj & 1) * 18432;
    const bool wdone = !__any(carry >= -104.f);
    if (!wdone) {
#pragma unroll 1
      for (int sub = 1; sub >= 0; --sub) {
        const int ks0 = j * 64 + sub * 32;
        if (ks0 > tw0) continue;
        f32x16 S = zero16();
#pragma unroll
        for (int s = 0; s < 4; ++s) {
          bf16x8 k1 = *(const bf16x8*)(sb + (sub * 32 + lq) * 144 + (16 * s + 8 * h) * 2);
          S = mfma32(k1, qf[s], S);
        }
        const bool diag = (ks0 + 31) >= tw0;
        float lsm[16];
        float sA = 0.f, sB = 0.f;
#pragma unroll
        for (int i = 0; i < 16; ++i) {
          const int key = ks0 + 16 * (i >> 3) + 8 * h + (i & 7);
          const float z = S[i] * 0.125f;
          const float sp = fmaxf(z, 0.f) + __logf(1.f + __expf(-fabsf(z)));
          const bool valid = !diag || key < tq;
          lsm[i] = valid ? -sp : 0.f;
          S[i] = valid ? z - sp : -1e30f;
          if (i < 8) sA += lsm[i]; else sB += lsm[i];
        }
        const float oA = __shfl_xor(sA, 32), oB = __shfl_xor(sB, 32);
        const float aboveB = h == 0 ? oB : 0.f;
        const float aboveA = h == 0 ? (oA + sB + oB) : (oB + sB);
        float run = carry + aboveB;
#pragma unroll
        for (int i = 15; i >= 8; --i) { float lw = S[i] + run; run += lsm[i]; S[i] = lw > -1e29f ? __expf(lw) : 0.f; }
        run = carry + aboveA;
#pragma unroll
        for (int i = 7; i >= 0; --i) { float lw = S[i] + run; run += lsm[i]; S[i] = lw > -1e29f ? __expf(lw) : 0.f; }
        carry += sA + sB + oA + oB;
        bf16x8 pa0 = pack8(S, 0), pa1 = pack8(S, 1);
#pragma unroll
        for (int d = 0; d < 2; ++d) {
          bf16x8 v0 = *(const bf16x8*)(sb + 9216 + (d * 32 + lq) * 144 + (sub * 32 + 8 * h) * 2);
          bf16x8 v1 = *(const bf16x8*)(sb + 9216 + (d * 32 + lq) * 144 + (sub * 32 + 16 + 8 * h) * 2);
          O[d] = mfma32(v0, pa0, O[d]);
          O[d] = mfma32(v1, pa1, O[d]);
        }
      }
    }
    if (more) { unsigned char* d = smem + ((jj + 1) & 1) * 18432; st_tile_s<2>(rk, d, true, tid); st_tile_s<2>(rv, d + 9216, false, tid); }
    const int alldone = __syncthreads_and((int)(!__any(carry >= -104.f)));
    if (alldone) break;
  }
  u16* yr = p.ysb + (size_t)(b * TP + tq) * 256 + head * 64;
#pragma unroll
  for (int d = 0; d < 2; ++d)
#pragma unroll
    for (int g = 0; g < 4; ++g) {
      u32x2 pk = {pack2bf(O[d][4 * g], O[d][4 * g + 1]), pack2bf(O[d][4 * g + 2], O[d][4 * g + 3])};
      *(u32x2*)(yr + 32 * d + 8 * g + 4 * h) = pk;
    }
  __syncthreads();
}

DI void idx_scan(const u32* hq, int need, u32* outbin, u32* outneed, int q, int lane) {
  u32 c = 0;
#pragma unroll
  for (int w = 0; w < 8; ++w) { u32 v = hq[8 * lane + w]; c += (v & 0xffffu) + (v >> 16); }
  u32 incl = c;
#pragma unroll
  for (int o = 1; o < 64; o <<= 1) { u32 v = __shfl_down(incl, o); if (lane + o < 64) incl += v; }
  const u32 above = incl - c;
  if ((int)above < need && need <= (int)incl) {
    u32 cum = above;
    for (int bin = 16 * lane + 15; bin >= 16 * lane; --bin) {
      u32 cnt = (hq[bin >> 1] >> ((bin & 1) * 16)) & 0xffffu;
      if ((int)(cum + cnt) >= need) { outbin[q] = (u32)bin; outneed[q] = (u32)need - cum; break; }
      cum += cnt;
    }
  }
}

template <int PASS, bool DIAG>
DI void idx_tile(const bf16x8 kf, const bf16x8 (&qf)[8], const float (&wq)[8], int kt, int lm, int lg, int tq, bool selall, u32 bA, u32 pfx,
                 u32* hist, u32* maskw, u32* cand, u32* ccnt) {
  const f32x4 z4 = {0.f, 0.f, 0.f, 0.f};
  f32x4 sc = z4;
#pragma unroll
  for (int j = 0; j < 8; ++j) {
    f32x4 d = mfma16(kf, qf[j], z4);
#pragma unroll
    for (int r = 0; r < 4; ++r) sc[r] += wq[j] * fmaxf(d[r], 0.f);
  }
  u32 selbits = 0u;
#pragma unroll
  for (int r = 0; r < 4; ++r) {
    const int key = kt * 16 + lg * 4 + r;
    const bool valid = !DIAG || key <= tq;
    const u32 bits = __float_as_uint(sc[r]);
    const u32 u = bits ^ ((u32)((int)bits >> 31) | 0x80000000u);
    if (PASS == 0) {
      if (valid) { const u32 bin = u >> 22; atomicAdd(&hist[lm * 512 + (bin >> 1)], 1u << ((bin & 1) * 16)); }
    } else if (PASS == 1) {
      if (valid && (u >> 22) == bA) { const u32 bin = (u >> 12) & 1023u; atomicAdd(&hist[lm * 512 + (bin >> 1)], 1u << ((bin & 1) * 16)); }
    } else {
      const u32 pp = u >> 12;
      if (valid && (selall || pp > pfx)) selbits |= 1u << r;
      if (valid && !selall && pp == pfx) {
        const u32 ix = atomicAdd(&ccnt[lm], 1u);
        if (ix < 64u) { cand[(lm * 64 + ix) * 2] = u; cand[(lm * 64 + ix) * 2 + 1] = (u32)key; }
      }
    }
  }
  if (PASS == 2 && selbits) {
    const int kb = kt * 16 + lg * 4;
    atomicOr(&maskw[lm * MW + (kb >> 5)], selbits << (kb & 31));
  }
}
template <int PASS>
DI void idx_pass(const u16* kp, const bf16x8 (&qf)[8], const float (&wq)[8], int wave, int ntile, int lm, int lg, int tq, bool selall,
                 u32 bA, u32 pfx, u32* hist, u32* maskw, u32* cand, u32* ccnt) {
  auto ldk = [&](int t) { return *(const bf16x8*)(kp + (size_t)(t < ntile ? t : 0) * 512); };
  int kt = wave;
  bf16x8 ka = ldk(kt), kb = ldk(kt + 4);
  for (; kt + 4 < ntile - 1; kt += 8) {
    const bf16x8 kc = ldk(kt + 8), kd = ldk(kt + 12);
    idx_tile<PASS, false>(ka, qf, wq, kt, lm, lg, tq, selall, bA, pfx, hist, maskw, cand, ccnt);
    idx_tile<PASS, false>(kb, qf, wq, kt + 4, lm, lg, tq, selall, bA, pfx, hist, maskw, cand, ccnt);
    ka = kc; kb = kd;
  }
  if (kt < ntile - 1) { idx_tile<PASS, false>(ka, qf, wq, kt, lm, lg, tq, selall, bA, pfx, hist, maskw, cand, ccnt); kt += 4; ka = kb; }
  if (kt == ntile - 1) idx_tile<PASS, true>(ka, qf, wq, kt, lm, lg, tq, selall, bA, pfx, hist, maskw, cand, ccnt);
}

DI void idx_job(const Params& p, int b, int qg, unsigned char* smem) {
  int tid_ = threadIdx.x & 255; asm volatile("" : "+v"(tid_));
  const int tid = tid_, lane = tid & 63, wave = tid >> 6, lm = lane & 15, lg = lane >> 4;
  u32* hist = (u32*)smem;
  u32* maskw = (u32*)(smem + 32768);
  u32* cand = (u32*)(smem + 41216);
  u32* ccnt = (u32*)(smem + 49408);
  u32* binA = ccnt + 16; u32* needB = ccnt + 32; u32* binB = ccnt + 48; u32* needC = ccnt + 64;
  const int t0 = qg * 16, ntile = qg + 1, tq = t0 + lm;
  const bool selall = tq + 1 <= 256;
  bf16x8 qf[8];
  float wq[8];
  {
    const u16* qr = p.qix + (size_t)(b * TP + tq) * 256 + lg * 8;
    const float* wr = p.wix + (size_t)(b * TP + tq) * 8;
#pragma unroll
    for (int j = 0; j < 8; ++j) { qf[j] = *(const bf16x8*)(qr + j * 32); wq[j] = wr[j]; }
  }
  for (int i = tid; i < 8192 + 2112; i += 256) hist[i] = 0u;
  if (tid < 80) ccnt[tid] = 0u;
  __syncthreads();
  const u16* kbase = p.kix + (size_t)b * TP * 32;
  const f32x4 z4 = {0.f, 0.f, 0.f, 0.f};
  const u16* kp = kbase + (size_t)lm * 32 + lg * 8;
  idx_pass<0>(kp, qf, wq, wave, ntile, lm, lg, tq, selall, 0u, 0u, hist, maskw, cand, ccnt);
  __syncthreads();
  for (int qq = 0; qq < 4; ++qq) idx_scan(hist + (wave * 4 + qq) * 512, 256, binA, needB, wave * 4 + qq, lane);
  __syncthreads();
  for (int i = tid; i < 8192; i += 256) hist[i] = 0u;
  __syncthreads();
  idx_pass<1>(kp, qf, wq, wave, ntile, lm, lg, tq, selall, binA[lm], 0u, hist, maskw, cand, ccnt);
  __syncthreads();
  for (int qq = 0; qq < 4; ++qq) idx_scan(hist + (wave * 4 + qq) * 512, (int)needB[wave * 4 + qq], binB, needC, wave * 4 + qq, lane);
  __syncthreads();
  idx_pass<2>(kp, qf, wq, wave, ntile, lm, lg, tq, selall, binA[lm], (binA[lm] << 10) | binB[lm], hist, maskw, cand, ccnt);
  __syncthreads();
  {
    const int q = tid >> 4, i0 = tid & 15;
    u32 cnt = ccnt[q]; if (cnt > 64u) cnt = 64u;
    const u32 need = needC[q];
    for (u32 c = i0; c < cnt; c += 16) {
      const u32 u = cand[(q * 64 + c) * 2], key = cand[(q * 64 + c) * 2 + 1];
      u32 rank = 0;
      for (u32 e = 0; e < cnt; ++e) {
        const u32 u2 = cand[(q * 64 + e) * 2], k2 = cand[(q * 64 + e) * 2 + 1];
        rank += (u2 > u || (u2 == u && k2 < key)) ? 1u : 0u;
      }
      if (rank < need) atomicOr(&maskw[q * MW + (key >> 5)], 1u << (key & 31));
    }
  }
  __syncthreads();
  for (int i = tid; i < 16 * MW; i += 256) p.mask[(size_t)(b * TP + t0) * MW + i] = maskw[i];
  __syncthreads();
}

DI int next_job(u32* ctr, unsigned char* smem) {
  int* sj = (int*)(smem + SJOB_OFF);
  __syncthreads();
  if (threadIdx.x == 0) *sj = (int)atomicAdd(ctr, 1u);
  __syncthreads();
  return *sj;
}

DI void phase_attn(const Params& p, int layer, int phase, unsigned char* smem) {
  u32* ctr = p.ctr + phase;
  for (;;) {
    const int jp = next_job(ctr, smem);
    if (jp >= 2640) break;
    if (jp < 1056) { const int qb = 32 - jp / 32, r = jp & 31; diff_job8(p, layer, r >> 2, r & 3, qb, smem); continue; }
    int half = threadIdx.x >> 8; asm volatile("" : "+v"(half));
    unsigned char* sm = smem + half * HALF_BYTES;
    const int job = 2 * (jp - 1056) + half;
    if (job < 2112) { idx_job(p, job & 7, 263 - (job >> 3), sm); }
    else { const int i = job - 2112; const int qb = 32 - i / 32, r = i & 31; sb_job(p, r >> 2, r & 3, qb, sm); }
  }
}
DI void phase_sparse(const Params& p, int layer, int phase, unsigned char* smem) {
  u32* ctr = p.ctr + phase;
  for (;;) {
    const int jp = next_job(ctr, smem);
    if (jp >= 528) break;
    int half = threadIdx.x >> 8; asm volatile("" : "+v"(half));
    unsigned char* sm = smem + half * HALF_BYTES;
    const int job = 2 * jp + half;
    const int qb = 32 - job / 32, r = job & 31;
    sparse_job(p, layer, r >> 2, r & 3, qb, sm);
  }
}

DI void run_phase(const Params& p, int ph, unsigned char* smem, int rep = 0) {
  if (ph == 0) { phase_prep(p, smem); return; }
  const int layer = (ph - 1) / 7, s = (ph - 1) % 7;
  const u16* WL = p.wts + (size_t)layer * LAYER_W;
  switch (s) {
    case 0: phase_g1(p, layer, smem); break;
    case 1: phase_attn(p, layer, ph + 16 * rep, smem); break;
    case 2: phase_sparse(p, layer, ph + 16 * rep, smem); break;
    case 3: phase_merge(p, layer, smem); break;
    case 4: phase_resid(p, layer == 0 ? 1 : 3, p.merged, DM, WL + OFF_OUT, p.rowss + (size_t)(2 * layer + 1) * R, false, smem); break;
    case 5: phase_ffnup(p, layer, smem); break;
    default: phase_resid(p, 2, p.act, DFF, WL + OFF_DOWN, p.rowss + (size_t)(2 * layer + 2) * R, layer == 1, smem); break;
  }
}


#define XB_TMO      128
#define XB_XCNT(j)  (256  + 64 * (j))
#define XB_XSUB(j)  (1280 + 64 * (j))
#define XB_XGEN(j)  (2304 + 64 * (j))
#define XB_TOP      3328
#define XB_TOPGEN   3392
#define XCD_BAR_WORDS 3456
#define XB_SPIN_CAP (1u << 20)
#define LAS __attribute__((address_space(3)))
DI unsigned xb_ld(unsigned* p) { return __hip_atomic_load(p, __ATOMIC_RELAXED, __HIP_MEMORY_SCOPE_AGENT); }
DI unsigned xb_add(unsigned* p, unsigned v) { return __hip_atomic_fetch_add(p, v, __ATOMIC_RELAXED, __HIP_MEMORY_SCOPE_AGENT); }
DI unsigned xb_xcc_id() { return (unsigned)__builtin_amdgcn_s_getreg((3 << 11) | 20) & 0xFu; }
#define XB_SPIN(cond, bar) do { unsigned _sp = 0; while (cond) { __builtin_amdgcn_s_sleep(1); \
    if ((++_sp & 255u) == 0u) { if (xb_ld(&(bar)[XB_TMO])) break; if (_sp > XB_SPIN_CAP) { atomicAdd(&(bar)[XB_TMO], 1u); break; } } } } while (0)
struct XcdBarrier { unsigned* bar; unsigned x; volatile LAS unsigned* st; };
DI XcdBarrier xcd_barrier_post(unsigned* bar, volatile LAS unsigned* st) {
  XcdBarrier b; b.bar = bar; b.x = xb_xcc_id(); b.st = st;
  if (threadIdx.x == 0) (void)xb_add(&bar[XB_XCNT(b.x)], 1u);
  return b;
}
DI void xcd_barrier_complete(unsigned* bar, unsigned x, unsigned& nloc, unsigned& nx) {
  const unsigned G = gridDim.x * gridDim.y * gridDim.z;
  unsigned sum, cnt, mine, sp = 0u;
  for (;;) {
    sum = 0u; cnt = 0u; mine = 0u;
#pragma unroll
    for (unsigned j = 0; j < 16; ++j) { const unsigned c = xb_ld(&bar[XB_XCNT(j)]); sum += c; cnt += (c > 0u) ? 1u : 0u; mine = (j == x) ? c : mine; }
    if (sum == G) break;
    __builtin_amdgcn_s_sleep(1);
    if ((++sp & 255u) == 0u) { if (xb_ld(&bar[XB_TMO])) break; if (sp > XB_SPIN_CAP) { atomicAdd(&bar[XB_TMO], 1u); break; } }
  }
  nloc = mine > 0u ? mine : 1u; nx = cnt > 0u ? cnt : 1u;
}
DI void xcd_barrier(const XcdBarrier& b) {
  asm volatile("s_waitcnt vmcnt(0)" ::: "memory");
  __syncthreads();
  if (threadIdx.x == 0) {
    unsigned* bar = b.bar;
    __builtin_amdgcn_s_waitcnt(0);
    unsigned nloc = b.st[0], nx = b.st[1];
    if (nloc == 0u) { xcd_barrier_complete(bar, b.x, nloc, nx); b.st[0] = nloc; b.st[1] = nx; }
    const unsigned old = xb_add(&bar[XB_XSUB(b.x)], 1u);
    const unsigned gen = old / nloc;
    if (old + 1u == (gen + 1u) * nloc) {
      __builtin_amdgcn_fence(__ATOMIC_RELEASE, "agent");
      asm volatile("s_waitcnt vmcnt(0)" ::: "memory");
      const unsigned og = xb_add(&bar[XB_TOP], 1u);
      const unsigned tg = og / nx;
      if (og + 1u == (tg + 1u) * nx) xb_add(&bar[XB_TOPGEN], 1u);
      else XB_SPIN(xb_ld(&bar[XB_TOPGEN]) == tg, bar);
      __builtin_amdgcn_fence(__ATOMIC_ACQUIRE, "agent");
      xb_add(&bar[XB_XGEN(b.x)], 1u);
      asm volatile("s_waitcnt vmcnt(0)" ::: "memory");
    } else {
      XB_SPIN(xb_ld(&bar[XB_XGEN(b.x)]) == gen, bar);
      __builtin_amdgcn_fence(__ATOMIC_ACQUIRE, "agent");
      asm volatile("s_waitcnt vmcnt(0)" ::: "memory");
    }
  }
  __syncthreads();
}

constexpr int NPHASE = 15;

__global__ void __launch_bounds__(512) mega(Params p, int ph_lo, int ph_hi) {
  __shared__ __attribute__((aligned(16))) unsigned char smem[SMEM_BYTES];
  volatile LAS unsigned* xst = (volatile LAS unsigned*)(smem + (SMEM_BYTES - 16));
  if (threadIdx.x == 0) { xst[0] = 0u; xst[1] = 0u; }
  __syncthreads();
  const XcdBarrier xb = xcd_barrier_post(p.bar, xst);
  for (int ph = ph_lo; ph < ph_hi; ++ph) {
    run_phase(p, ph, smem);
#ifdef PROBE_MASK
    if (ph > 0 && ((PROBE_MASK >> ((ph - 1) % 7)) & 1)) { cg::this_grid().sync(); run_phase(p, ph, smem, 1); }
#endif
    if (ph + 1 < ph_hi) { if (ph_hi > 1000) cg::this_grid().sync(); else xcd_barrier(xb); }
  }
}

extern "C" void kernel_launch(void* const* d_in, const int* in_sizes, int n_in, void* d_out, int out_size, void* d_ws,
                              size_t ws_size, hipStream_t stream) {
  Params p{};
  const float* const* in = (const float* const*)d_in;
  p.x = in[0]; p.meta = in[1]; p.rel_bias = in[2]; p.attn_norm = in[3]; p.w_in = in[4]; p.b_gate = in[5];
  p.qn_sp = in[6]; p.kn_sp = in[7]; p.qn_df = in[8]; p.kn_df = in[9]; p.lq1 = in[10]; p.lk1 = in[11]; p.lq2 = in[12];
  p.lk2 = in[13]; p.subln = in[14]; p.w_br_sb = in[15]; p.w_br_sp = in[16]; p.w_br_df = in[17]; p.w_out = in[18];
  p.ffn_norm = in[19]; p.w_up = in[20]; p.conv_w = in[21]; p.conv_b = in[22]; p.w_down = in[23];
  p.out = (float*)d_out;
  unsigned char* w = (unsigned char*)d_ws;
  size_t off = 0;
  auto take = [&](size_t bytes) { unsigned char* r = w + off; off += (bytes + 255) & ~(size_t)255; return r; };
  p.ctr = (u32*)take(256);
  p.bar = (u32*)take((size_t)XCD_BAR_WORDS * 4);
  p.hb = (u16*)take((size_t)(R + 512) * DM * 2) + (size_t)256 * DM;
  p.rowss = (float*)take((size_t)4 * R * 4);
  p.side = (float*)take((size_t)NB * 128 * DM * 4);
  p.wts = (u16*)take((size_t)2 * LAYER_W * 2);
  p.mask = (u32*)take((size_t)R * MW * 4);
  unsigned char* region = w + off;
  p.qsb = (u16*)take((size_t)R * 256 * 2); p.ksb = (u16*)take((size_t)R * 256 * 2);
  p.qsp = (u16*)take((size_t)R * 256 * 2); p.ksp = (u16*)take((size_t)R * 256 * 2);
  p.qdf = (u16*)take((size_t)R * 512 * 2); p.kdf = (u16*)take((size_t)R * 512 * 2);
  p.vtsb = (u16*)take((size_t)R * 256 * 2); p.vtsp = (u16*)take((size_t)R * 256 * 2); p.vtdf = (u16*)take((size_t)R * 512 * 2);
  p.qix = (u16*)take((size_t)R * 256 * 2); p.kix = (u16*)take((size_t)R * 32 * 2); p.wix = (float*)take((size_t)R * 8 * 4);
  p.ysb = (u16*)take((size_t)R * 256 * 2); p.ysp = (u16*)take((size_t)R * 256 * 2); p.ydf = (u16*)take((size_t)R * 512 * 2);
  p.merged = (u16*)region;
  p.act = (u16*)region;
  if (off > ws_size) { fprintf(stderr, "workspace too small: need %zu have %zu\n", off, ws_size); return; }
#if FUSED
  static int grid_blocks = 0;
  if (!grid_blocks) {
    int dev = 0, cus = 0, per_cu = 0;
    hipGetDevice(&dev);
    hipDeviceGetAttribute(&cus, hipDeviceAttributeMultiprocessorCount, dev);
    hipOccupancyMaxActiveBlocksPerMultiprocessor(&per_cu, mega, 512, 0);
    if (per_cu > 1) per_cu = 1;
    grid_blocks = cus * per_cu;
  }
  int lo = 0, hi = NPHASE;
  (void)hipMemsetAsync(p.bar, 0, (size_t)XCD_BAR_WORDS * 4, stream);
  void* args[] = {&p, &lo, &hi};
  hipError_t e = hipLaunchCooperativeKernel((void*)mega, dim3(grid_blocks), dim3(512), args, 0, stream);
  if (e != hipSuccess) fprintf(stderr, "cooperative launch failed: %s (grid %d)\n", hipGetErrorString(e), grid_blocks);
#else
  for (int ph = 0; ph < NPHASE; ++ph) mega<<<256, 512, 0, stream>>>(p, ph, ph + 1);
#endif
}
```

```cpp
#include <hip/hip_runtime.h>
#include <hip/hip_cooperative_groups.h>
#include <cstdio>
namespace cg = cooperative_groups;

#ifndef FUSED
#define FUSED 1
#endif

#define DI __device__ __forceinline__
typedef unsigned short u16;
typedef unsigned int u32;
using bf16x8 = __attribute__((ext_vector_type(8))) short;
using f32x4 = __attribute__((ext_vector_type(4))) float;
using f32x16 = __attribute__((ext_vector_type(16))) float;
using u32x4 = __attribute__((ext_vector_type(4))) unsigned;
using u32x2 = __attribute__((ext_vector_type(2))) unsigned;
typedef __bf16 bf2_t __attribute__((ext_vector_type(2)));
typedef float f2_t __attribute__((ext_vector_type(2)));

constexpr int NB = 8, SEQ = 4096, DM = 1024, TP = 4224, TREAL = 4112, NMETA = 16, R = NB * TP;
constexpr int DFF = 2816, DIN = 6440, MW = 132;
constexpr float EPS = 1e-6f;
constexpr float LOG2E = 1.4426950408889634f;
constexpr int HALF_BYTES = 75776;
constexpr int SMEM_BYTES = 2 * HALF_BYTES;
constexpr int LUT_OFF = 73728;
constexpr int SJOB_OFF = 75000;

constexpr int NWIN = 3584;
constexpr size_t OFF_WIN = 0, OFF_WG = OFF_WIN + (size_t)NWIN * 1024, OFF_BRSB = OFF_WG + (size_t)3072 * 1024, OFF_BRSP = OFF_BRSB + 262144,
                 OFF_BRDF = OFF_BRSP + 262144, OFF_OUT = OFF_BRDF + 524288, OFF_UP = OFF_OUT + 1048576, OFF_DOWN = OFF_UP + (size_t)5632 * 1024,
                 LAYER_W = OFF_DOWN + (size_t)1024 * 2816;

struct Params {
  const float *x, *meta, *rel_bias, *attn_norm, *w_in, *b_gate, *qn_sp, *kn_sp, *qn_df, *kn_df, *lq1, *lk1, *lq2, *lk2,
      *subln, *w_br_sb, *w_br_sp, *w_br_df, *w_out, *ffn_norm, *w_up, *conv_w, *conv_b, *w_down;
  float* out;
  u16* hb; float* rowss; float* side; u16* wts;
  u16 *qsb, *ksb, *qsp, *ksp, *qdf, *kdf, *vtsb, *vtsp, *vtdf, *qix, *kix; float* wix;
  u16 *ysb, *ysp, *ydf; u32* mask; u16* merged; u16* act; u32* ctr; u32* bar;
};

DI u32 pack2bf(float a, float b) {
  f2_t v = {a, b};
  bf2_t r = __builtin_convertvector(v, bf2_t);
  return __builtin_bit_cast(u32, r);
}
DI u16 f2bf(float a) { return (u16)(pack2bf(a, 0.f) & 0xffffu); }
DI float wave_sum(float v) {
#pragma unroll
  for (int o = 32; o; o >>= 1) v += __shfl_xor(v, o);
  return v;
}
DI f32x4 mfma16(bf16x8 a, bf16x8 b, f32x4 c) { return __builtin_amdgcn_mfma_f32_16x16x32_bf16(a, b, c, 0, 0, 0); }
DI f32x16 mfma32(bf16x8 a, bf16x8 b, f32x16 c) { return __builtin_amdgcn_mfma_f32_32x32x16_bf16(a, b, c, 0, 0, 0); }

DI int vblock() {
  int g = gridDim.x, b = blockIdx.x;
  if ((g & 7) == 0) return (b & 7) * (g >> 3) + (b >> 3);
  return b;
}

DI float* hrow_w(const Params& p, int gr) {
  int b = gr / TP, t = gr - b * TP;
  if (t >= NMETA && t < TREAL) return p.out + ((size_t)(b * SEQ + t - NMETA)) * DM;
  int s = t < NMETA ? t : t - TREAL + NMETA;
  return p.side + ((size_t)(b * 128 + s)) * DM;
}
DI const float* hrow_r(const Params& p, int layer, int gr) {
  int b = gr / TP, t = gr - b * TP;
  if (t >= NMETA && t < TREAL) {
    size_t o = ((size_t)(b * SEQ + t - NMETA)) * DM;
    return layer == 0 ? p.x + o : p.out + o;
  }
  int s = t < NMETA ? t : t - TREAL + NMETA;
  return p.side + ((size_t)(b * 128 + s)) * DM;
}

DI int wt_srccol(int kind, int n) {
  if (kind == 0) {
    if (n < 1536) return n;
    if (n < 3072) return 1832 + n - 1536;
    if (n < 3328) return 1536 + n - 3072;
    if (n < 3360) return 1792 + n - 3328;
    if (n < 3368) return 1824 + n - 3360;
    return -1;
  }
  if (kind == 1) return 3368 + n;
  if (kind == 6) {
    int j = n >> 8, w = n & 255, wn = w >> 7, ni = (w & 127) >> 4, c = w & 15;
    int ff = 128 * j + 64 * wn + 16 * (ni >> 1) + c;
    return (ni & 1) ? DFF + ff : ff;
  }
  return n;
}

DI void phase_prep(const Params& p, unsigned char* smem) {
  int tid_ = threadIdx.x; asm volatile("" : "+v"(tid_));
  const int tid = tid_, wave = tid >> 6, lane = tid & 63;
  for (int gr = blockIdx.x * 8 + wave; gr < R; gr += gridDim.x * 8) {
    int b = gr / TP, t = gr - b * TP;
    const float* src = nullptr;
    if (t < NMETA) src = p.meta + (size_t)t * DM;
    else if (t < TREAL) src = p.x + ((size_t)(b * SEQ + t - NMETA)) * DM;
    float4 v[4];
    float ss = 0.f;
#pragma unroll
    for (int i = 0; i < 4; ++i) {
      v[i] = src ? ((const float4*)src)[lane + 64 * i] : make_float4(0.f, 0.f, 0.f, 0.f);
      ss += v[i].x * v[i].x + v[i].y * v[i].y + v[i].z * v[i].z + v[i].w * v[i].w;
    }
    ss = wave_sum(ss);
#pragma unroll
    for (int i = 0; i < 4; ++i) {
      u32x2 pk = {pack2bf(v[i].x, v[i].y), pack2bf(v[i].z, v[i].w)};
      *(u32x2*)(p.hb + (size_t)gr * DM + (lane + 64 * i) * 4) = pk;
    }
    if (lane == 0) { p.rowss[gr] = ss; p.rowss[R + gr] = 0.f; p.rowss[2 * R + gr] = 0.f; p.rowss[3 * R + gr] = 0.f; }
    if (t < NMETA || t >= TREAL) {
      int s = t < NMETA ? t : t - TREAL + NMETA;
      float* d = p.side + ((size_t)(b * 128 + s)) * DM;
#pragma unroll
      for (int i = 0; i < 4; ++i) ((float4*)d)[lane + 64 * i] = v[i];
    }
  }
  if (blockIdx.x == 0 && tid < 64) p.ctr[tid] = 0;
  for (int i = blockIdx.x * 512 + tid; i < 2 * 256 * DM / 8; i += gridDim.x * 512) {
    const int hf = i / (256 * DM / 8), o = i - hf * (256 * DM / 8);
    u16* d = hf ? p.hb + (size_t)R * DM : p.hb - (size_t)256 * DM;
    *(u32x4*)(d + (size_t)o * 8) = u32x4{0u, 0u, 0u, 0u};
  }
  const int half = tid >> 8, t2 = tid & 255;
  float* tl = (float*)(smem + half * HALF_BYTES);
  constexpr int NK[8] = {NWIN, 3072, 1024, 1024, 1024, 1024, 5632, 1024};
  constexpr int KK[8] = {1024, 1024, 256, 256, 512, 1024, 1024, 2816};
  int total = 0;
  int cum[9];
  cum[0] = 0;
#pragma unroll
  for (int k = 0; k < 8; ++k) { total += (NK[k] / 64) * (KK[k] / 64); cum[k + 1] = total; }
  for (int jp = blockIdx.x; 2 * jp < 2 * total; jp += gridDim.x) {
    const int job = 2 * jp + half;
    const bool act = job < 2 * total;
    int layer = job >= total ? 1 : 0;
    int j = job - layer * total;
    int kind = 0;
#pragma unroll
    for (int k = 1; k < 8; ++k) if (j >= cum[k]) kind = k;
    int jj = j;
    int K = 1024, ld = 1024;
    const float* src = p.w_in; const float* gain = nullptr; u16* dst = p.wts + (size_t)layer * LAYER_W;
    switch (kind) {
      case 0: jj -= cum[0]; K = 1024; ld = DIN; src = p.w_in + (size_t)layer * DM * DIN; gain = p.attn_norm + layer * DM; dst += OFF_WIN; break;
      case 1: jj -= cum[1]; K = 1024; ld = DIN; src = p.w_in + (size_t)layer * DM * DIN; gain = p.attn_norm + layer * DM; dst += OFF_WG; break;
      case 2: jj -= cum[2]; K = 256; ld = 1024; src = p.w_br_sb + (size_t)layer * 256 * 1024; dst += OFF_BRSB; break;
      case 3: jj -= cum[3]; K = 256; ld = 1024; src = p.w_br_sp + (size_t)layer * 256 * 1024; dst += OFF_BRSP; break;
      case 4: jj -= cum[4]; K = 512; ld = 1024; src = p.w_br_df + (size_t)layer * 512 * 1024; dst += OFF_BRDF; break;
      case 5: jj -= cum[5]; K = 1024; ld = 1024; src = p.w_out + (size_t)layer * 1024 * 1024; dst += OFF_OUT; break;
      case 6: jj -= cum[6]; K = 1024; ld = 2 * DFF; src = p.w_up + (size_t)layer * DM * 2 * DFF; gain = p.ffn_norm + layer * DM; dst += OFF_UP; break;
      default: jj -= cum[7]; K = DFF; ld = 1024; src = p.w_down + (size_t)layer * DFF * 1024; dst += OFF_DOWN; break;
    }
    int nkt = K / 64;
    int n0 = (jj / nkt) * 64, k0 = (jj % nkt) * 64;
    if (act) {
      const int nn = t2 & 63, kq = t2 >> 6;
      const int col = wt_srccol(kind, n0 + nn);
      const float* sp = src + (size_t)(k0 + kq) * ld + (col >= 0 ? col : 0);
      float v[16];
#pragma unroll
      for (int i = 0; i < 16; ++i) v[i] = sp[(size_t)(4 * i) * ld];
#pragma unroll
      for (int i = 0; i < 16; ++i) {
        float x = col >= 0 ? v[i] : 0.f;
        if (gain) x *= gain[k0 + kq + 4 * i];
        tl[nn * 65 + kq + 4 * i] = x;
      }
    }
    __syncthreads();
    if (act) {
#pragma unroll
      for (int i = 0; i < 2; ++i) {
        int idx = t2 + 256 * i, nn = idx >> 3, c = idx & 7;
        const float* s = tl + nn * 65 + c * 8;
        u32x4 pk = {pack2bf(s[0], s[1]), pack2bf(s[2], s[3]), pack2bf(s[4], s[5]), pack2bf(s[6], s[7])};
        *(u32x4*)(dst + (size_t)(n0 + nn) * K + k0 + c * 8) = pk;
      }
    }
    __syncthreads();
  }
}

template <int MI, int NI>
DI void gemm_kloop(const u16* Au, int lda, const u16* Bu, int ldb, int K, f32x4 (&acc)[NI][MI], unsigned char* smem) {
  int tid_ = threadIdx.x; asm volatile("" : "+v"(tid_));
  const int tid = tid_, lane = tid & 63, wave = tid >> 6, wm = wave >> 1, wn = wave & 1;
  const int lr = tid >> 3, lc = tid & 7;
  const int voa = lr * lda + lc * 8, vob = lr * ldb + lc * 8;
  constexpr int NB2 = NI / 2;
  u32x4 ra[MI], rb[NB2];
  const int nk = K >> 6;
  const int fsw = (lane & 15) >> 1;
  const int fro0 = (lane & 15) * 128 + (((lane >> 4) ^ fsw) << 4);
  const int fro1 = (lane & 15) * 128 + ((((lane >> 4) + 4) ^ fsw) << 4);
  const int wof = lr * 128 + ((lc ^ ((lr >> 1) & 7)) << 4);
#define GLOAD(K0)                                                                                        \
  {                                                                                                      \
    _Pragma("unroll") for (int q = 0; q < MI; ++q) ra[q] = *(const u32x4*)((Au + (size_t)(q * 64) * lda + (K0)) + voa); \
    _Pragma("unroll") for (int q = 0; q < NB2; ++q) rb[q] = *(const u32x4*)((Bu + (size_t)(q * 64) * ldb + (K0)) + vob); \
  }
#define SWRITE(BUF)                                                                                      \
  {                                                                                                      \
    unsigned char* d_ = smem + (BUF) * 65536 + wof;                                                      \
    _Pragma("unroll") for (int q = 0; q < MI; ++q) *(u32x4*)(d_ + q * 8192) = ra[q];                     \
    _Pragma("unroll") for (int q = 0; q < NB2; ++q) *(u32x4*)(d_ + 32768 + q * 8192) = rb[q];            \
  }
  GLOAD(0);
  SWRITE(0);
  if (nk > 1) GLOAD(64);
  for (int kt = 0; kt < nk; ++kt) {
    __syncthreads();
    if (kt + 1 < nk) {
      SWRITE((kt + 1) & 1);
      if (kt + 2 < nk) GLOAD((kt + 2) << 6);
    }
    {
      const unsigned char* sa = smem + (kt & 1) * 65536;
      const unsigned char* sb = sa + 32768;
#pragma unroll
      for (int ks = 0; ks < 2; ++ks) {
        const int fo = ks ? fro1 : fro0;
        bf16x8 af[MI];
#pragma unroll
        for (int i = 0; i < MI; ++i) af[i] = *(const bf16x8*)(sa + (wm * 16 * MI + i * 16) * 128 + fo);
#pragma unroll
        for (int nh = 0; nh < NI; nh += 4) {
          bf16x8 wf[4];
#pragma unroll
          for (int i = 0; i < 4; ++i) wf[i] = *(const bf16x8*)(sb + (wn * 16 * NI + (nh + i) * 16) * 128 + fo);
#pragma unroll
          for (int ni = 0; ni < 4; ++ni)
#pragma unroll
            for (int mi = 0; mi < MI; ++mi) acc[nh + ni][mi] = mfma16(wf[ni], af[mi], acc[nh + ni][mi]);
        }
      }
    }
  }
  __syncthreads();
#undef GLOAD
#undef SWRITE
}

template <int MI, int NI>
DI void zero_acc(f32x4 (&acc)[NI][MI]) {
#pragma unroll
  for (int i = 0; i < NI; ++i)
#pragma unroll
    for (int j = 0; j < MI; ++j) acc[i][j] = f32x4{0.f, 0.f, 0.f, 0.f};
}

DI void phase_g1(const Params& p, int layer, unsigned char* smem) {
  int tid_ = threadIdx.x; asm volatile("" : "+v"(tid_));
  const int tid = tid_, lane = tid & 63, wave = tid >> 6, wm = wave >> 1, wn = wave & 1;
  const int lr = tid >> 3, lc = tid & 7, lm = lane & 15, lg = lane >> 4;
  const u16* W = p.wts + (size_t)layer * LAYER_W + OFF_WIN;
  const float* rowss = p.rowss + (size_t)(2 * layer) * R;
  constexpr int NT = 13, NTILES = 132 * NT;
  for (int it = vblock(); it < NTILES; it += gridDim.x) {
    const int g = it / (4 * NT), rem = it - g * (4 * NT), nt = rem >> 2, mt = g * 4 + (rem & 3);
    f32x4 acc[8][4];
    zero_acc<4, 8>(acc);
    gemm_kloop<4, 8>(p.hb + (size_t)(mt * 256) * DM, DM, W + (size_t)(nt * 256) * DM, DM, DM, acc, smem);
    int mrow[4];
#pragma unroll
    for (int mi = 0; mi < 4; ++mi) {
      mrow[mi] = mt * 256 + wm * 64 + mi * 16 + lm;
      float rs = rsqrtf(rowss[mrow[mi]] * (1.f / DM) + EPS);
#pragma unroll
      for (int ni = 0; ni < 8; ++ni) acc[ni][mi] *= rs;
    }
    int kind;
    u16* dst = nullptr; int ld = 256, col0 = 0, vrows = 256; const float* gn = nullptr;
    if (nt == 0) { kind = 0; dst = p.qsb; }
    else if (nt == 1) { kind = 0; dst = p.ksb; }
    else if (nt == 2) { kind = 2; dst = p.vtsb; vrows = 256; }
    else if (nt == 3) { kind = 1; dst = p.qsp; gn = p.qn_sp + layer * 64; }
    else if (nt == 4) { kind = 1; dst = p.ksp; gn = p.kn_sp + layer * 64; }
    else if (nt == 5) { kind = 2; dst = p.vtsp; vrows = 256; }
    else if (nt < 8) { kind = 1; dst = p.qdf; ld = 512; col0 = (nt - 6) * 256; gn = p.qn_df + layer * 64; }
    else if (nt < 10) { kind = 1; dst = p.kdf; ld = 512; col0 = (nt - 8) * 256; gn = p.kn_df + layer * 64; }
    else if (nt < 12) { kind = 2; dst = p.vtdf; col0 = (nt - 10) * 256; vrows = 512; }
    else { kind = 0; dst = p.qix; }
    if (kind == 1) {
#pragma unroll
      for (int mi = 0; mi < 4; ++mi)
#pragma unroll
        for (int hh = 0; hh < 2; ++hh) {
          float ss = 0.f;
#pragma unroll
          for (int n4 = 0; n4 < 4; ++n4)
#pragma unroll
            for (int r = 0; r < 4; ++r) ss += acc[hh * 4 + n4][mi][r] * acc[hh * 4 + n4][mi][r];
          ss += __shfl_xor(ss, 16);
          ss += __shfl_xor(ss, 32);
          float sc = rsqrtf(ss * (1.f / 64.f) + EPS);
#pragma unroll
          for (int n4 = 0; n4 < 4; ++n4)
#pragma unroll
            for (int r = 0; r < 4; ++r) acc[hh * 4 + n4][mi][r] *= sc * gn[n4 * 16 + lg * 4 + r];
        }
    }
    if (kind == 0 || kind == 1) {
#pragma unroll
      for (int mi = 0; mi < 4; ++mi)
#pragma unroll
        for (int ni = 0; ni < 8; ++ni) {
          u32x2 pk = {pack2bf(acc[ni][mi][0], acc[ni][mi][1]), pack2bf(acc[ni][mi][2], acc[ni][mi][3])};
          *(u32x2*)(dst + (size_t)mrow[mi] * ld + col0 + wn * 128 + ni * 16 + lg * 4) = pk;
        }
    } else if (kind == 2) {
#pragma unroll
      for (int mi = 0; mi < 4; ++mi) {
        int b = mrow[mi] / TP, t = mrow[mi] - b * TP;
#pragma unroll
        for (int ni = 0; ni < 8; ++ni)
#pragma unroll
          for (int r = 0; r < 4; ++r) {
            int row = col0 + wn * 128 + ni * 16 + lg * 4 + r;
            dst[((size_t)(b * vrows + row)) * TP + t] = f2bf(acc[ni][mi][r]);
          }
      }
    }
  }
  {
    const int v = vblock(), first = NTILES % gridDim.x, nfree = gridDim.x - first;
    if (v >= first) {
      for (int s = v - first; s < 132; s += nfree) {
        const int mt = s;
        f32x4 acc[4][4];
        zero_acc<4, 4>(acc);
        gemm_kloop<4, 4>(p.hb + (size_t)(mt * 256) * DM, DM, W + (size_t)(13 * 256) * DM, DM, DM, acc, smem);
        if (wn == 0) {
#pragma unroll
          for (int mi = 0; mi < 4; ++mi) {
            const int m = mt * 256 + wm * 64 + mi * 16 + lm;
            const float rs = rsqrtf(rowss[m] * (1.f / DM) + EPS);
#pragma unroll
            for (int ni = 0; ni < 2; ++ni) {
              u32x2 pk = {pack2bf(acc[ni][mi][0] * rs, acc[ni][mi][1] * rs), pack2bf(acc[ni][mi][2] * rs, acc[ni][mi][3] * rs)};
              *(u32x2*)(p.kix + (size_t)m * 32 + ni * 16 + lg * 4) = pk;
            }
            if (lg < 2) {
              float4 w4 = make_float4(acc[2][mi][0] * rs, acc[2][mi][1] * rs, acc[2][mi][2] * rs, acc[2][mi][3] * rs);
              *(float4*)(p.wix + (size_t)m * 8 + lg * 4) = w4;
            }
          }
        }
      }
    }
  }
}

template <int MI, int NI>
DI void resid_epilogue(const Params& p, int from_x, const f32x4 (&acc)[NI][MI], int row0, int n0, float* rowss_next, bool last, int lm, int lg) {
#pragma unroll
  for (int mi = 0; mi < MI; ++mi) {
    const int m = row0 + mi * 16 + lm;
    const float* hr = hrow_r(p, from_x == 1 ? 0 : 1, m);
    float* hw = hrow_w(p, m);
    u16* hbr = p.hb + (size_t)m * DM;
    float ss = 0.f;
#pragma unroll
    for (int ni = 0; ni < NI; ++ni) {
      const int n = n0 + ni * 16 + lg * 4;
      float4 h;
      if (from_x >= 2) {
        const u32x2 pk = *(const u32x2*)(hbr + n);
        h = make_float4(__uint_as_float(pk[0] << 16), __uint_as_float(pk[0] & 0xffff0000u), __uint_as_float(pk[1] << 16), __uint_as_float(pk[1] & 0xffff0000u));
      } else h = *(const float4*)(hr + n);
      h.x += acc[ni][mi][0]; h.y += acc[ni][mi][1]; h.z += acc[ni][mi][2]; h.w += acc[ni][mi][3];
      if (last) *(float4*)(hw + n) = h;
      if (!last) {
        u32x2 pk = {pack2bf(h.x, h.y), pack2bf(h.z, h.w)};
        *(u32x2*)(hbr + n) = pk;
        ss += h.x * h.x + h.y * h.y + h.z * h.z + h.w * h.w;
      }
    }
    if (!last) {
      ss += __shfl_xor(ss, 16);
      ss += __shfl_xor(ss, 32);
      if (lg == 0) atomicAdd(rowss_next + m, ss);
    }
  }
}

DI void phase_resid(const Params& p, int from_x, const u16* A, int K, const u16* W, float* rowss_next, bool last,
                    unsigned char* smem) {
  int tid_ = threadIdx.x; asm volatile("" : "+v"(tid_));
  const int tid = tid_, lane = tid & 63, wave = tid >> 6, wm = wave >> 1, wn = wave & 1;
  const int lm = lane & 15, lg = lane >> 4;
  constexpr int NT = 4, NTILES = 132 * NT;
  const int nfull = (NTILES / (int)gridDim.x) * (int)gridDim.x;
  for (int it = vblock(); it < nfull; it += gridDim.x) {
    const int g = it / (4 * NT), rem = it - g * (4 * NT), nt = rem >> 2, mt = g * 4 + (rem & 3);
    f32x4 acc[8][4];
    zero_acc<4, 8>(acc);
    gemm_kloop<4, 8>(A + (size_t)(mt * 256) * K, K, W + (size_t)(nt * 256) * K, K, K, acc, smem);
    resid_epilogue<4, 8>(p, from_x, acc, mt * 256 + wm * 64, nt * 256 + wn * 128, rowss_next, last, lm, lg);
  }
  for (int s = vblock(); s < 4 * (NTILES - nfull); s += gridDim.x) {
    const int it = nfull + (s >> 2), hm = s & 1, hn = (s >> 1) & 1;
    const int g = it / (4 * NT), rem = it - g * (4 * NT), nt = rem >> 2, mt = g * 4 + (rem & 3);
    f32x4 acc[4][2];
    zero_acc<2, 4>(acc);
    gemm_kloop<2, 4>(A + (size_t)(mt * 256 + hm * 128) * K, K, W + (size_t)(nt * 256 + hn * 128) * K, K, K, acc, smem);
    resid_epilogue<2, 4>(p, from_x, acc, mt * 256 + hm * 128 + wm * 32, nt * 256 + hn * 128 + wn * 64, rowss_next, last, lm, lg);
  }
}

template <int MI>
DI void merge_tile(const Params& p, int layer, int rowbase, int nt, unsigned char* smem) {
  int tid_ = threadIdx.x; asm volatile("" : "+v"(tid_));
  const int tid = tid_, lane = tid & 63, wave = tid >> 6, wm = wave >> 1, wn = wave & 1;
  const int lm = lane & 15, lg = lane >> 4;
  const u16* WL = p.wts + (size_t)layer * LAYER_W;
  const float* rowss = p.rowss + (size_t)(2 * layer) * R;
  const float* bg = p.b_gate + layer * 3 * DM;
  u32 mp[4][MI][2];
#pragma unroll
  for (int ni = 0; ni < 4; ++ni)
#pragma unroll
    for (int mi = 0; mi < MI; ++mi) { mp[ni][mi][0] = 0u; mp[ni][mi][1] = 0u; }
#pragma unroll 1
  for (int br = 0; br < 3; ++br) {
    const u16* Y = br == 0 ? p.ysb : (br == 1 ? p.ysp : p.ydf);
    const int Kb = br == 2 ? 512 : 256;
    const u16* Wb = WL + (br == 0 ? OFF_BRSB : (br == 1 ? OFF_BRSP : OFF_BRDF));
    f32x4 acc[4][MI];
    zero_acc<MI, 4>(acc);
    gemm_kloop<MI, 4>(Y + (size_t)rowbase * Kb, Kb, Wb + (size_t)(nt * 128) * Kb, Kb, Kb, acc, smem);
    u32 brp[4][MI][2];
#pragma unroll
    for (int ni = 0; ni < 4; ++ni)
#pragma unroll
      for (int mi = 0; mi < MI; ++mi) {
        brp[ni][mi][0] = pack2bf(acc[ni][mi][0], acc[ni][mi][1]);
        brp[ni][mi][1] = pack2bf(acc[ni][mi][2], acc[ni][mi][3]);
      }
    zero_acc<MI, 4>(acc);
    gemm_kloop<MI, 4>(p.hb + (size_t)rowbase * DM, DM, WL + OFF_WG + (size_t)(br * 1024 + nt * 128) * DM, DM, DM, acc, smem);
    int m0 = rowbase + wm * 16 * MI + lm, n0 = nt * 128 + wn * 64 + lg * 4;
    asm volatile("" : "+v"(m0), "+v"(n0));
#pragma unroll
    for (int mi = 0; mi < MI; ++mi) {
      const float rs = rsqrtf(rowss[m0 + mi * 16] * (1.f / DM) + EPS);
#pragma unroll
      for (int ni = 0; ni < 4; ++ni) {
        const float4 b4 = *(const float4*)(bg + br * DM + n0 + ni * 16);
        const float bb[4] = {b4.x, b4.y, b4.z, b4.w};
        float mv[4];
#pragma unroll
        for (int r = 0; r < 4; ++r) {
          const float gv = acc[ni][mi][r] * rs + bb[r];
          const float sg = 1.f / (1.f + __expf(-gv));
          const u32 w = brp[ni][mi][r >> 1], mw = mp[ni][mi][r >> 1];
          const float bv = __uint_as_float((r & 1) ? (w & 0xffff0000u) : (w << 16));
          const float mo = __uint_as_float((r & 1) ? (mw & 0xffff0000u) : (mw << 16));
          mv[r] = mo + sg * bv;
        }
        mp[ni][mi][0] = pack2bf(mv[0], mv[1]);
        mp[ni][mi][1] = pack2bf(mv[2], mv[3]);
      }
    }
  }
  int m0 = rowbase + wm * 16 * MI + lm, n0 = nt * 128 + wn * 64 + lg * 4;
  asm volatile("" : "+v"(m0), "+v"(n0));
#pragma unroll
  for (int mi = 0; mi < MI; ++mi)
#pragma unroll
    for (int ni = 0; ni < 4; ++ni) {
      u32x2 pk = {mp[ni][mi][0], mp[ni][mi][1]};
      *(u32x2*)(p.merged + (size_t)(m0 + mi * 16) * DM + n0 + ni * 16) = pk;
    }
}

DI void phase_merge(const Params& p, int layer, unsigned char* smem) {
  constexpr int NT = 8, NTILES = 132 * NT;
  const int nfull = (NTILES / (int)gridDim.x) * (int)gridDim.x;
  for (int it = vblock(); it < nfull; it += gridDim.x) {
    const int g = it / (4 * NT), rem = it - g * (4 * NT), nt = rem >> 2, mt = g * 4 + (rem & 3);
    merge_tile<4>(p, layer, mt * 256, nt, smem);
  }
  for (int s = vblock(); s < 2 * (NTILES - nfull); s += gridDim.x) {
    const int it = nfull + (s >> 1), hf = s & 1;
    const int g = it / (4 * NT), rem = it - g * (4 * NT), nt = rem >> 2, mt = g * 4 + (rem & 3);
    merge_tile<2>(p, layer, mt * 256 + hf * 128, nt, smem);
  }
}

DI void phase_ffnup(const Params& p, int layer, unsigned char* smem) {
  int tid_ = threadIdx.x; asm volatile("" : "+v"(tid_));
  const int tid = tid_, lane = tid & 63, wave = tid >> 6, wm = wave >> 1, wn = wave & 1;
  const int lr = tid >> 3, lc = tid & 7, lm = lane & 15, lg = lane >> 4;
  const u16* W = p.wts + (size_t)layer * LAYER_W + OFF_UP;
  const float* rowss = p.rowss + (size_t)(2 * layer + 1) * R;
  const float* cw = p.conv_w + layer * 3 * DFF;
  const float* cb = p.conv_b + layer * DFF;
  constexpr int NT = 22, MT = 136, NTILES = MT * NT;
  float* G = (float*)smem;
  for (int it = vblock(); it < NTILES; it += gridDim.x) {
    const int g = it / (4 * NT), rem = it - g * (4 * NT), nt = rem >> 2, mt = g * 4 + (rem & 3);
    const int b = mt / 17, ti = mt - b * 17, tbase = 254 * ti - 2;
    f32x4 acc[8][4];
    zero_acc<4, 8>(acc);
    gemm_kloop<4, 8>(p.hb + ((ptrdiff_t)(b * TP + tbase)) * DM, DM, W + (size_t)(nt * 256) * DM, DM, DM, acc, smem);
    int r0 = wm * 64 + lm, gc0 = 64 * wn + 4 * lg;
    asm volatile("" : "+v"(r0), "+v"(gc0));
    int tt[4];
#pragma unroll
    for (int mi = 0; mi < 4; ++mi) {
      const int r = r0 + mi * 16;
      tt[mi] = tbase + r;
      float rs = (tt[mi] >= 0 && tt[mi] < TP) ? rsqrtf(rowss[b * TP + tt[mi]] * (1.f / DM) + EPS) : 0.f;
#pragma unroll
      for (int ni = 0; ni < 8; ++ni) acc[ni][mi] *= rs;
#pragma unroll
      for (int n2 = 0; n2 < 4; ++n2) {
        float4 g4 = make_float4(acc[2 * n2][mi][0], acc[2 * n2][mi][1], acc[2 * n2][mi][2], acc[2 * n2][mi][3]);
        *(float4*)(G + r * 132 + gc0 + 16 * n2) = g4;
      }
    }
    __syncthreads();
#pragma unroll
    for (int n2 = 0; n2 < 4; ++n2) {
      const int gc = gc0 + 16 * n2;
      const int ff = 128 * nt + gc;
      const float4 w0 = *(const float4*)(cw + ff), w1 = *(const float4*)(cw + DFF + ff), w2 = *(const float4*)(cw + 2 * DFF + ff);
      const float4 c4 = *(const float4*)(cb + ff);
#pragma unroll
      for (int mi = 0; mi < 4; ++mi) {
        const int r = r0 + mi * 16;
        if (r >= 2 && tt[mi] < TP) {
          const float4 g1 = *(const float4*)(G + (r - 1) * 132 + gc);
          const float4 g2 = *(const float4*)(G + (r - 2) * 132 + gc);
          float cv[4];
          cv[0] = c4.x + w0.x * g2.x + w1.x * g1.x + w2.x * acc[2 * n2][mi][0];
          cv[1] = c4.y + w0.y * g2.y + w1.y * g1.y + w2.y * acc[2 * n2][mi][1];
          cv[2] = c4.z + w0.z * g2.z + w1.z * g1.z + w2.z * acc[2 * n2][mi][2];
          cv[3] = c4.w + w0.w * g2.w + w1.w * g1.w + w2.w * acc[2 * n2][mi][3];
          float a[4];
#pragma unroll
          for (int e = 0; e < 4; ++e) a[e] = cv[e] / (1.f + __expf(-cv[e])) * acc[2 * n2 + 1][mi][e];
          u32x2 pk = {pack2bf(a[0], a[1]), pack2bf(a[2], a[3])};
          *(u32x2*)(p.act + (size_t)(b * TP + tt[mi]) * DFF + ff) = pk;
        }
      }
    }
    __syncthreads();
  }
}

DI int swap23(int k) { return (k & ~12) | ((k & 4) << 1) | ((k & 8) >> 1); }

DI void build_lut(const Params& p, int bias_head, unsigned char* smem, int tid) {
  float* lut = (float*)(smem + LUT_OFF);
  const int d = tid;
  if (d <= 128) {
    int bucket;
    if (d < 16) bucket = d;
    else {
      float nf = (float)d;
      int large = 16 + (int)(logf(nf / 16.f) / 2.0794415416798357f * 16.f);
      bucket = large < 31 ? large : 31;
    }
    lut[d] = p.rel_bias[bucket * 8 + bias_head] * LOG2E;
  }
}

template <int NCH>
DI void ld_tile_g(u32x4 (&r)[NCH], const u16* base, size_t rstride, int k0, bool is_vt, int tid) {
#pragma unroll
  for (int i = 0; i < NCH; ++i) {
    int id = tid + 256 * i, row = id >> 3, c = id & 7;
    const u16* s = is_vt ? base + (size_t)row * rstride + k0 + c * 8 : base + (size_t)(k0 + row) * rstride + c * 8;
    r[i] = *(const u32x4*)s;
  }
}
template <int NCH>
DI void st_tile_s(const u32x4 (&r)[NCH], unsigned char* dst, bool permute, int tid) {
#pragma unroll
  for (int i = 0; i < NCH; ++i) {
    int id = tid + 256 * i, row = id >> 3, c = id & 7;
    int rr = permute ? swap23(row) : row;
    *(u32x4*)(dst + rr * 144 + c * 16) = r[i];
  }
}

DI bf16x8 pack8(const f32x16& v, int s2) {
  u32x4 pk;
  if (s2 == 0) pk = u32x4{pack2bf(v[0], v[1]), pack2bf(v[2], v[3]), pack2bf(v[4], v[5]), pack2bf(v[6], v[7])};
  else pk = u32x4{pack2bf(v[8], v[9]), pack2bf(v[10], v[11]), pack2bf(v[12], v[13]), pack2bf(v[14], v[15])};
  return __builtin_bit_cast(bf16x8, pk);
}
DI f32x16 zero16() {
  f32x16 z;
#pragma unroll
  for (int i = 0; i < 16; ++i) z[i] = 0.f;
  return z;
}

DI void diff_map(const unsigned char* sk, const bf16x8 (&qf)[4], const unsigned char* sv, const float* lut, bool far,
                 bool diag, int ks0, int tq, int h, int lq, f32x16 (&O)[4], float& m, float& l) {
  const float csc = 0.125f * LOG2E;
  f32x16 S = zero16();
#pragma unroll
  for (int s = 0; s < 4; ++s) {
    bf16x8 kf = *(const bf16x8*)(sk + lq * 144 + (16 * s + 8 * h) * 2);
    S = mfma32(kf, qf[s], S);
  }
  if (far) {
    const float cbias = lut[128];
    float mx = fmaxf(fmaxf(S[0], S[1]), S[2]);
#pragma unroll
    for (int i = 3; i < 15; i += 2) mx = fmaxf(fmaxf(mx, S[i]), S[i + 1]);
    mx = fmaxf(mx, S[15]);
    mx = fmaxf(mx, __shfl_xor(mx, 32));
    const float mn = fmaxf(m, mx * csc + cbias);
    if (__any(mn > m)) {
      const float a = __builtin_amdgcn_exp2f(m - mn);
      l *= a; m = mn;
#pragma unroll
      for (int d = 0; d < 4; ++d) O[d] *= a;
    }
    const float off = cbias - m;
#pragma unroll
    for (int i = 0; i < 16; ++i) { float pv = __builtin_amdgcn_exp2f(S[i] * csc + off); l += pv; S[i] = pv; }
  } else {
    float mx = -1e30f;
#pragma unroll
    for (int i = 0; i < 16; ++i) {
      const int key = ks0 + 16 * (i >> 3) + 8 * h + (i & 7);
      int d = tq - key;
      const bool msk = diag && d < 0;
      d = d < 0 ? 0 : (d > 128 ? 128 : d);
      float x = S[i] * csc + lut[d];
      if (msk) x = -1e30f;
      S[i] = x;
      mx = fmaxf(mx, x);
    }
    mx = fmaxf(mx, __shfl_xor(mx, 32));
    const float mn = fmaxf(m, mx);
    if (__any(mn > m)) {
      const float a = __builtin_amdgcn_exp2f(m - mn);
      l *= a; m = mn;
#pragma unroll
      for (int d = 0; d < 4; ++d) O[d] *= a;
    }
#pragma unroll
    for (int i = 0; i < 16; ++i) { float pv = __builtin_amdgcn_exp2f(S[i] - m); l += pv; S[i] = pv; }
  }
  const bf16x8 p0 = pack8(S, 0), p1 = pack8(S, 1);
#pragma unroll
  for (int d = 0; d < 4; ++d) {
    bf16x8 v0 = *(const bf16x8*)(sv + (d * 32 + lq) * 144 + 16 * h);
    bf16x8 v1 = *(const bf16x8*)(sv + (d * 32 + lq) * 144 + 32 + 16 * h);
    O[d] = mfma32(v0, p0, O[d]);
    O[d] = mfma32(v1, p1, O[d]);
  }
}

DI void diff_map_far2(const unsigned char* sk, const bf16x8 (&qf)[4], const unsigned char* sv, float cbias, int h, int lq,
                      f32x16 (&O)[4], float& m, float& l) {
  const float csc = 0.125f * LOG2E;
  f32x16 S0 = zero16(), S1 = zero16();
#pragma unroll
  for (int s = 0; s < 4; ++s) {
    bf16x8 k0 = *(const bf16x8*)(sk + lq * 144 + (16 * s + 8 * h) * 2);
    bf16x8 k1 = *(const bf16x8*)(sk + (32 + lq) * 144 + (16 * s + 8 * h) * 2);
    S0 = mfma32(k0, qf[s], S0);
    S1 = mfma32(k1, qf[s], S1);
  }
  float mx = fmaxf(fmaxf(S0[0], S0[1]), S0[2]);
#pragma unroll
  for (int i = 3; i < 15; i += 2) mx = fmaxf(fmaxf(mx, S0[i]), S0[i + 1]);
  mx = fmaxf(mx, S0[15]);
#pragma unroll
  for (int i = 0; i < 16; i += 2) mx = fmaxf(fmaxf(mx, S1[i]), S1[i + 1]);
  mx = fmaxf(mx, __shfl_xor(mx, 32));
  const float mn = fmaxf(m, mx * csc + cbias);
  if (__any(mn > m + 8.f)) {
    const float a = __builtin_amdgcn_exp2f(m - mn);
    l *= a; m = mn;
#pragma unroll
    for (int d = 0; d < 4; ++d) O[d] *= a;
  }
  const float off = cbias - m;
  float la = 0.f, lb = 0.f;
#pragma unroll
  for (int i = 0; i < 16; ++i) {
    float pa = __builtin_amdgcn_exp2f(S0[i] * csc + off), pb = __builtin_amdgcn_exp2f(S1[i] * csc + off);
    la += pa; lb += pb; S0[i] = pa; S1[i] = pb;
  }
  l += la + lb;
  const bf16x8 p0 = pack8(S0, 0), p1 = pack8(S0, 1), p2 = pack8(S1, 0), p3 = pack8(S1, 1);
#pragma unroll
  for (int d = 0; d < 4; ++d) {
    const unsigned char* vr = sv + (d * 32 + lq) * 144 + 16 * h;
    bf16x8 v0 = *(const bf16x8*)(vr), v1 = *(const bf16x8*)(vr + 32), v2 = *(const bf16x8*)(vr + 64), v3 = *(const bf16x8*)(vr + 96);
    O[d] = mfma32(v0, p0, O[d]);
    O[d] = mfma32(v1, p1, O[d]);
    O[d] = mfma32(v2, p2, O[d]);
    O[d] = mfma32(v3, p3, O[d]);
  }
}

DI void diff_job8(const Params& p, int layer, int b, int head, int qb, unsigned char* smem) {
  int tid_ = threadIdx.x; asm volatile("" : "+v"(tid_));
  const int tid = tid_, lane = tid & 63, wave = tid >> 6, h = lane >> 5, lq = lane & 31;
  const int map = wave >> 2, qg = wave & 3;
  const int t0 = qb * 128, tw0 = t0 + 32 * qg, tq = tw0 + lq;
  const float* lut = (const float*)(smem + LUT_OFF);
  build_lut(p, 4 + head, smem, tid);
  bf16x8 qf[4];
  {
    const u16* qr = p.qdf + (size_t)(b * TP + tq) * 512 + head * 128 + 64 * map + 8 * h;
#pragma unroll
    for (int s = 0; s < 4; ++s) qf[s] = *(const bf16x8*)(qr + 16 * s);
  }
  f32x16 O[4];
#pragma unroll
  for (int i = 0; i < 4; ++i) O[i] = zero16();
  float m = -1e30f, l = 0.f;
  const u16* K1 = p.kdf + (size_t)b * TP * 512 + head * 128;
  const u16* VT = p.vtdf + (size_t)(b * 512 + head * 128) * TP;
  const int ntile = 2 * (qb + 1);
  const int krow = tid >> 3, kc = tid & 7, krs = swap23(krow);
  u32x4 rk1, rk2, rv[2];
  auto gl = [&](int k0) {
    const u16* s = K1 + (size_t)(k0 + krow) * 512 + kc * 8;
    rk1 = *(const u32x4*)s; rk2 = *(const u32x4*)(s + 64);
#pragma unroll
    for (int i = 0; i < 2; ++i) rv[i] = *(const u32x4*)(VT + (size_t)(krow + 64 * i) * TP + k0 + kc * 8);
  };
  auto sl = [&](unsigned char* d) {
    *(u32x4*)(d + krs * 144 + kc * 16) = rk1;
    *(u32x4*)(d + 9216 + krs * 144 + kc * 16) = rk2;
#pragma unroll
    for (int i = 0; i < 2; ++i) *(u32x4*)(d + 18432 + (krow + 64 * i) * 144 + kc * 16) = rv[i];
  };
  gl(0); sl(smem);
  if (ntile > 1) gl(64);
  __syncthreads();
  const float cbias = lut[128];
  for (int j = 0; j < ntile; ++j) {
    __syncthreads();
    if (j + 1 < ntile) { sl(smem + ((j + 1) & 1) * 36864); if (j + 2 < ntile) gl((j + 2) * 64); }
    const unsigned char* sb = smem + (j & 1) * 36864;
    const unsigned char* sk = sb + 9216 * map;
    const int k0 = j * 64;
    if (tw0 - (k0 + 63) >= 113) {
      diff_map_far2(sk, qf, sb + 18432, cbias, h, lq, O, m, l);
    } else {
#pragma unroll 1
      for (int sub = 0; sub < 2; ++sub) {
        const int ks0 = k0 + sub * 32;
        if (ks0 > tw0 + 31) break;
        const bool far = (tw0 - (ks0 + 31)) >= 113;
        const bool diag = (ks0 + 31) > tw0;
        diff_map(sk + sub * 32 * 144, qf, sb + 18432 + sub * 64, lut, far, diag, ks0, tq, h, lq, O, m, l);
      }
    }
  }
  __syncthreads();
  float lam;
  const float lam_init = 0.8f - 0.6f * expf(-0.3f * (float)layer);
  {
    float a = p.lq1[layer * 64 + lane] * p.lk1[layer * 64 + lane];
    float c = p.lq2[layer * 64 + lane] * p.lk2[layer * 64 + lane];
    a = wave_sum(a); c = wave_sum(c);
    lam = expf(a) - expf(c) + lam_init;
  }
  l += __shfl_xor(l, 32);
  const float il = (map ? lam : 1.f) / l;
  float* X = (float*)smem + (size_t)(qg * 32 + lq) * 132;
  if (map == 1) {
#pragma unroll
    for (int d = 0; d < 4; ++d)
#pragma unroll
      for (int g = 0; g < 4; ++g) {
        float4 v = make_float4(O[d][4 * g] * il, O[d][4 * g + 1] * il, O[d][4 * g + 2] * il, O[d][4 * g + 3] * il);
        *(float4*)(X + 32 * d + 8 * g + 4 * h) = v;
      }
  }
  __syncthreads();
  if (map == 0) {
    float ss = 0.f;
#pragma unroll
    for (int d = 0; d < 4; ++d)
#pragma unroll
      for (int g = 0; g < 4; ++g) {
        const float4 v = *(const float4*)(X + 32 * d + 8 * g + 4 * h);
        float y0 = O[d][4 * g] * il - v.x, y1 = O[d][4 * g + 1] * il - v.y, y2 = O[d][4 * g + 2] * il - v.z, y3 = O[d][4 * g + 3] * il - v.w;
        O[d][4 * g] = y0; O[d][4 * g + 1] = y1; O[d][4 * g + 2] = y2; O[d][4 * g + 3] = y3;
        ss += y0 * y0 + y1 * y1 + y2 * y2 + y3 * y3;
      }
    ss += __shfl_xor(ss, 32);
    const float sc = rsqrtf(ss * (1.f / 128.f) + EPS) * (1.f - lam_init);
    const float* sg = p.subln + layer * 128;
    u16* yr = p.ydf + (size_t)(b * TP + tq) * 512 + head * 128;
#pragma unroll
    for (int d = 0; d < 4; ++d)
#pragma unroll
      for (int g = 0; g < 4; ++g) {
        const int dv = 32 * d + 8 * g + 4 * h;
        const float4 g4 = *(const float4*)(sg + dv);
        u32x2 pk = {pack2bf(O[d][4 * g] * sc * g4.x, O[d][4 * g + 1] * sc * g4.y),
                    pack2bf(O[d][4 * g + 2] * sc * g4.z, O[d][4 * g + 3] * sc * g4.w)};
        *(u32x2*)(yr + dv) = pk;
      }
  }
  __syncthreads();
}

DI void sparse_job(const Params& p, int layer, int b, int head, int qb, unsigned char* smem) {
  int tid_ = threadIdx.x & 255; asm volatile("" : "+v"(tid_));
  const int tid = tid_, lane = tid & 63, wave = tid >> 6, h = lane >> 5, lq = lane & 31;
  const int t0 = qb * 128, tw0 = t0 + 32 * wave, tq = tw0 + lq;
  const float* lut = (const float*)(smem + LUT_OFF);
  build_lut(p, head, smem, tid);
  bf16x8 qf[4];
  {
    const u16* qr = p.qsp + (size_t)(b * TP + tq) * 256 + head * 64 + 8 * h;
#pragma unroll
    for (int s = 0; s < 4; ++s) qf[s] = *(const bf16x8*)(qr + 16 * s);
  }
  f32x16 O[2] = {zero16(), zero16()};
  float m = -1e30f, l = 0.f;
  const u16* Kp = p.ksp + (size_t)b * TP * 256 + head * 64;
  const u16* VT = p.vtsp + (size_t)(b * 256 + head * 64) * TP;
  const u32* mrow = p.mask + (size_t)(b * TP + tq) * MW;
  const int ntile = 2 * (qb + 1);
  const float csc = 0.125f * LOG2E;
  u32x4 rk[2], rv[2];
  ld_tile_g<2>(rk, Kp, 256, 0, false, tid); ld_tile_g<2>(rv, VT, TP, 0, true, tid);
  u32x2 mnext = *(const u32x2*)(mrow);
  st_tile_s<2>(rk, smem, true, tid); st_tile_s<2>(rv, smem + 9216, false, tid);
  if (ntile > 1) { ld_tile_g<2>(rk, Kp, 256, 64, false, tid); ld_tile_g<2>(rv, VT, TP, 64, true, tid); }
  for (int j = 0; j < ntile; ++j) {
    const bool more = j + 1 < ntile;
    const u32x2 mcur = mnext;
    __syncthreads();
    if (more) {
      unsigned char* d = smem + ((j + 1) & 1) * 18432; st_tile_s<2>(rk, d, true, tid); st_tile_s<2>(rv, d + 9216, false, tid);
      mnext = *(const u32x2*)(mrow + 2 * (j + 1));
      if (j + 2 < ntile) { const int k0 = (j + 2) * 64; ld_tile_g<2>(rk, Kp, 256, k0, false, tid); ld_tile_g<2>(rv, VT, TP, k0, true, tid); }
    }
    const unsigned char* sb = smem + (j & 1) * 18432;
    if (tw0 - (j * 64 + 63) >= 113) {
      const float cbias = lut[128];
      f32x16 S0 = zero16(), S1 = zero16();
#pragma unroll
      for (int s = 0; s < 4; ++s) {
        bf16x8 k0 = *(const bf16x8*)(sb + lq * 144 + (16 * s + 8 * h) * 2);
        bf16x8 k1 = *(const bf16x8*)(sb + (32 + lq) * 144 + (16 * s + 8 * h) * 2);
        S0 = mfma32(k0, qf[s], S0);
        S1 = mfma32(k1, qf[s], S1);
      }
      const u32 sa = ((mcur[0] >> (8 * h)) & 0xffu) | (((mcur[0] >> (16 + 8 * h)) & 0xffu) << 8);
      const u32 sb2 = ((mcur[1] >> (8 * h)) & 0xffu) | (((mcur[1] >> (16 + 8 * h)) & 0xffu) << 8);
      float mx = -1e30f;
#pragma unroll
      for (int i = 0; i < 16; ++i) {
        mx = fmaxf(mx, (sa & (1u << i)) ? S0[i] : -1e30f);
        mx = fmaxf(mx, (sb2 & (1u << i)) ? S1[i] : -1e30f);
      }
      mx = fmaxf(mx, __shfl_xor(mx, 32));
      const float mn = mx > -1e29f ? fmaxf(m, mx * csc + cbias) : m;
      if (__any(mn > m + 8.f)) {
        const float a = __builtin_amdgcn_exp2f(m - mn);
        l *= a; O[0] *= a; O[1] *= a;
        m = mn;
      }
      const float off = cbias - m;
      float la = 0.f, lb = 0.f;
#pragma unroll
      for (int i = 0; i < 16; ++i) {
        const float pa = (sa & (1u << i)) ? __builtin_amdgcn_exp2f(S0[i] * csc + off) : 0.f;
        const float pb = (sb2 & (1u << i)) ? __builtin_amdgcn_exp2f(S1[i] * csc + off) : 0.f;
        la += pa; lb += pb; S0[i] = pa; S1[i] = pb;
      }
      l += la + lb;
      const bf16x8 p0 = pack8(S0, 0), p1 = pack8(S0, 1), p2 = pack8(S1, 0), p3 = pack8(S1, 1);
#pragma unroll
      for (int d = 0; d < 2; ++d) {
        const unsigned char* vr = sb + 9216 + (d * 32 + lq) * 144 + 16 * h;
        bf16x8 v0 = *(const bf16x8*)(vr), v1 = *(const bf16x8*)(vr + 32), v2 = *(const bf16x8*)(vr + 64), v3 = *(const bf16x8*)(vr + 96);
        O[d] = mfma32(v0, p0, O[d]);
        O[d] = mfma32(v1, p1, O[d]);
        O[d] = mfma32(v2, p2, O[d]);
        O[d] = mfma32(v3, p3, O[d]);
      }
    } else
#pragma unroll 1
    for (int sub = 0; sub < 2; ++sub) {
      const int ks0 = j * 64 + sub * 32;
      if (ks0 > tw0 + 31) break;
      const u32 mw = sub ? mcur[1] : mcur[0];
      if (!__any(mw != 0u)) continue;
      f32x16 S = zero16();
#pragma unroll
      for (int s = 0; s < 4; ++s) {
        bf16x8 k1 = *(const bf16x8*)(sb + (sub * 32 + lq) * 144 + (16 * s + 8 * h) * 2);
        S = mfma32(k1, qf[s], S);
      }
      const bool far = (tw0 - (ks0 + 31)) >= 113;
      const float cbias = lut[128];
      const u32 sel16 = ((mw >> (8 * h)) & 0xffu) | (((mw >> (16 + 8 * h)) & 0xffu) << 8);
      if (far) {
        float mx = -1e30f;
#pragma unroll
        for (int i = 0; i < 16; ++i) mx = fmaxf(mx, (sel16 & (1u << i)) ? S[i] : -1e30f);
        mx = fmaxf(mx, __shfl_xor(mx, 32));
        const float mn = mx > -1e29f ? fmaxf(m, mx * csc + cbias) : m;
        if (__any(mn > m)) {
          const float a = __builtin_amdgcn_exp2f(m - mn);
          l *= a; O[0] *= a; O[1] *= a;
          m = mn;
        }
        const float off = cbias - m;
#pragma unroll
        for (int i = 0; i < 16; ++i) {
          float pv = (sel16 & (1u << i)) ? __builtin_amdgcn_exp2f(S[i] * csc + off) : 0.f;
          l += pv;
          S[i] = pv;
        }
      } else {
        float mx = -1e30f;
#pragma unroll
        for (int i = 0; i < 16; ++i) {
          const int ko = 16 * (i >> 3) + 8 * h + (i & 7);
          int d = tq - (ks0 + ko); d = d < 0 ? 0 : (d > 128 ? 128 : d);
          float x = S[i] * csc + lut[d];
          if (!(sel16 & (1u << i))) x = -1e30f;
          S[i] = x;
          mx = fmaxf(mx, x);
        }
        mx = fmaxf(mx, __shfl_xor(mx, 32));
        const float mn = fmaxf(m, mx);
        if (__any(mn > m)) {
          const float a = __builtin_amdgcn_exp2f(m - mn);
          l *= a; O[0] *= a; O[1] *= a;
          m = mn;
        }
#pragma unroll
        for (int i = 0; i < 16; ++i) {
          float pv = S[i] > -1e29f ? __builtin_amdgcn_exp2f(S[i] - m) : 0.f;
          l += pv;
          S[i] = pv;
        }
      }
      bf16x8 pa0 = pack8(S, 0), pa1 = pack8(S, 1);
#pragma unroll
      for (int d = 0; d < 2; ++d) {
        bf16x8 v0 = *(const bf16x8*)(sb + 9216 + (d * 32 + lq) * 144 + (sub * 32 + 8 * h) * 2);
        bf16x8 v1 = *(const bf16x8*)(sb + 9216 + (d * 32 + lq) * 144 + (sub * 32 + 16 + 8 * h) * 2);
        O[d] = mfma32(v0, pa0, O[d]);
        O[d] = mfma32(v1, pa1, O[d]);
      }
    }
  }
  __syncthreads();
  l += __shfl_xor(l, 32);
  const float il = 1.f / l;
  u16* yr = p.ysp + (size_t)(b * TP + tq) * 256 + head * 64;
#pragma unroll
  for (int d = 0; d < 2; ++d)
#pragma unroll
    for (int g = 0; g < 4; ++g) {
      u32x2 pk = {pack2bf(O[d][4 * g] * il, O[d][4 * g + 1] * il), pack2bf(O[d][4 * g + 2] * il, O[d][4 * g + 3] * il)};
      *(u32x2*)(yr + 32 * d + 8 * g + 4 * h) = pk;
    }
  __syncthreads();
}

DI void sb_job(const Params& p, int b, int head, int qb, unsigned char* smem) {
  int tid_ = threadIdx.x & 255; asm volatile("" : "+v"(tid_));
  const int tid = tid_, lane = tid & 63, wave = tid >> 6, h = lane >> 5, lq = lane & 31;
  const int t0 = qb * 128, tw0 = t0 + 32 * wave, tq = tw0 + lq;
  bf16x8 qf[4];
  {
    const u16* qr = p.qsb + (size_t)(b * TP + tq) * 256 + head * 64 + 8 * h;
#pragma unroll
    for (int s = 0; s < 4; ++s) qf[s] = *(const bf16x8*)(qr + 16 * s);
  }
  f32x16 O[2] = {zero16(), zero16()};
  float carry = 0.f;
  const u16* Kp = p.ksb + (size_t)b * TP * 256 + head * 64;
  const u16* VT = p.vtsb + (size_t)(b * 256 + head * 64) * TP;
  const int ntile = 2 * (qb + 1);
  u32x4 rk[2], rv[2];
  ld_tile_g<2>(rk, Kp, 256, (ntile - 1) * 64, false, tid); ld_tile_g<2>(rv, VT, TP, (ntile - 1) * 64, true, tid);
  st_tile_s<2>(rk, smem, true, tid); st_tile_s<2>(rv, smem + 9216, false, tid);
  __syncthreads();
  for (int jj = 0; jj < ntile; ++jj) {
    const int j = ntile - 1 - jj;
    const bool more = jj + 1 < ntile;
    if (more) { const int k0 = (j - 1) * 64; ld_tile_g<2>(rk, Kp, 256, k0, false, tid); ld_tile_g<2>(rv, VT, TP, k0, true, tid); }
    __builtin_amdgcn_sched_barrier(0);
    const unsigned char* sb = smem + (jj & 1) * 18432;
    const bool wdone = !__any(carry >= -104.f);
    if (!wdone) {
#pragma unroll 1
      for (int sub = 1; sub >= 0; --sub) {
        const int ks0 = j * 64 + sub * 32;
        if (ks0 > tw0) continue;
        f32x16 S = zero16();
#pragma unroll
        for (int s = 0; s < 4; ++s) {
          bf16x8 k1 = *(const bf16x8*)(sb + (sub * 32 + lq) * 144 + (16 * s + 8 * h) * 2);
          S = mfma32(k1, qf[s], S);
        }
        const bool diag = (ks0 + 31) >= tw0;
        float lsm[16];
        float sA = 0.f, sB = 0.f;
#pragma unroll
        for (int i = 0; i < 16; ++i) {
          const int key = ks0 + 16 * (i >> 3) + 8 * h + (i & 7);
          const float z = S[i] * 0.125f;
          const float sp = fmaxf(z, 0.f) + __logf(1.f + __expf(-fabsf(z)));
          const bool valid = !diag || key < tq;
          lsm[i] = valid ? -sp : 0.f;
          S[i] = valid ? z - sp : -1e30f;
          if (i < 8) sA += lsm[i]; else sB += lsm[i];
        }
        const float oA = __shfl_xor(sA, 32), oB = __shfl_xor(sB, 32);
        const float aboveB = h == 0 ? oB : 0.f;
        const float aboveA = h == 0 ? (oA + sB + oB) : (oB + sB);
        float run = carry + aboveB;
#pragma unroll
        for (int i = 15; i >= 8; --i) { float lw = S[i] + run; run += lsm[i]; S[i] = lw > -1e29f ? __expf(lw) : 0.f; }
        run = carry + aboveA;
#pragma unroll
        for (int i = 7; i >= 0; --i) { float lw = S[i] + run; run += lsm[i]; S[i] = lw > -1e29f ? __expf(lw) : 0.f; }
        carry += sA + sB + oA + oB;
        bf16x8 pa0 = pack8(S, 0), pa1 = pack8(S, 1);
#pragma unroll
        for (int d = 0; d < 2; ++d) {
          bf16x8 v0 = *(const bf16x8*)(sb + 9216 + (d * 32 + lq) * 144 + (sub * 32 + 8 * h) * 2);
          bf16x8 v1 = *(const bf16x8*)(sb + 9216 + (d * 32 + lq) * 144 + (sub * 32 + 16 + 8 * h) * 2);
          O[d] = mfma32(v0, pa0, O[d]);
          O[d] = mfma32(v1, pa1, O[d]);
        }
      }
    }
    if (more) { unsigned char* d = smem + ((jj + 1) & 1) * 18432; st_tile_s<2>(rk, d, true, tid); st_tile_s<2>(rv, d + 9216, false, tid); }
    const int alldone = __syncthreads_and((int)(!__any(carry >= -104.f)));
    if (alldone) break;
  }
  u16* yr = p.ysb + (size_t)(b * TP + tq) * 256 + head * 64;
#pragma unroll
  for (int d = 0; d < 2; ++d)
#pragma unroll
    for (int g = 0; g < 4; ++g) {
      u32x2 pk = {pack2bf(O[d][4 * g], O[d][4 * g + 1]), pack2bf(O[d][4 * g + 2], O[d][4 * g + 3])};
      *(u32x2*)(yr + 32 * d + 8 * g + 4 * h) = pk;
    }
  __syncthreads();
}

DI void idx_scan(const u32* hq, int need, u32* outbin, u32* outneed, int q, int lane) {
  u32 c = 0;
#pragma unroll
  for (int w = 0; w < 8; ++w) { u32 v = hq[8 * lane + w]; c += (v & 0xffffu) + (v >> 16); }
  u32 incl = c;
#pragma unroll
  for (int o = 1; o < 64; o <<= 1) { u32 v = __shfl_down(incl, o); if (lane + o < 64) incl += v; }
  const u32 above = incl - c;
  if ((int)above < need && need <= (int)incl) {
    u32 cum = above;
    for (int bin = 16 * lane + 15; bin >= 16 * lane; --bin) {
      u32 cnt = (hq[bin >> 1] >> ((bin & 1) * 16)) & 0xffffu;
      if ((int)(cum + cnt) >= need) { outbin[q] = (u32)bin; outneed[q] = (u32)need - cum; break; }
      cum += cnt;
    }
  }
}

template <int PASS, bool DIAG>
DI void idx_tile(const bf16x8 kf, const bf16x8 (&qf)[8], const float (&wq)[8], int kt, int lm, int lg, int tq, bool selall, u32 bA, u32 pfx,
                 u32* hist, u32* maskw, u32* cand, u32* ccnt) {
  const f32x4 z4 = {0.f, 0.f, 0.f, 0.f};
  f32x4 sc = z4;
#pragma unroll
  for (int j = 0; j < 8; ++j) {
    f32x4 d = mfma16(kf, qf[j], z4);
#pragma unroll
    for (int r = 0; r < 4; ++r) sc[r] += wq[j] * fmaxf(d[r], 0.f);
  }
  u32 selbits = 0u;
#pragma unroll
  for (int r = 0; r < 4; ++r) {
    const int key = kt * 16 + lg * 4 + r;
    const bool valid = !DIAG || key <= tq;
    const u32 bits = __float_as_uint(sc[r]);
    const u32 u = bits ^ ((u32)((int)bits >> 31) | 0x80000000u);
    if (PASS == 0) {
      if (valid) { const u32 bin = u >> 22; atomicAdd(&hist[lm * 512 + (bin >> 1)], 1u << ((bin & 1) * 16)); }
    } else if (PASS == 1) {
      if (valid && (u >> 22) == bA) { const u32 bin = (u >> 12) & 1023u; atomicAdd(&hist[lm * 512 + (bin >> 1)], 1u << ((bin & 1) * 16)); }
    } else {
      const u32 pp = u >> 12;
      if (valid && (selall || pp > pfx)) selbits |= 1u << r;
      if (valid && !selall && pp == pfx) {
        const u32 ix = atomicAdd(&ccnt[lm], 1u);
        if (ix < 64u) { cand[(lm * 64 + ix) * 2] = u; cand[(lm * 64 + ix) * 2 + 1] = (u32)key; }
      }
    }
  }
  if (PASS == 2 && selbits) {
    const int kb = kt * 16 + lg * 4;
    atomicOr(&maskw[lm * MW + (kb >> 5)], selbits << (kb & 31));
  }
}
template <int PASS>
DI void idx_pass(const u16* kp, const bf16x8 (&qf)[8], const float (&wq)[8], int wave, int ntile, int lm, int lg, int tq, bool selall,
                 u32 bA, u32 pfx, u32* hist, u32* maskw, u32* cand, u32* ccnt) {
  auto ldk = [&](int t) { return *(const bf16x8*)(kp + (size_t)(t < ntile ? t : 0) * 512); };
  int kt = wave;
  bf16x8 ka = ldk(kt), kb = ldk(kt + 4);
  for (; kt + 4 < ntile - 1; kt += 8) {
    const bf16x8 kc = ldk(kt + 8), kd = ldk(kt + 12);
    idx_tile<PASS, false>(ka, qf, wq, kt, lm, lg, tq, selall, bA, pfx, hist, maskw, cand, ccnt);
    idx_tile<PASS, false>(kb, qf, wq, kt + 4, lm, lg, tq, selall, bA, pfx, hist, maskw, cand, ccnt);
    ka = kc; kb = kd;
  }
  if (kt < ntile - 1) { idx_tile<PASS, false>(ka, qf, wq, kt, lm, lg, tq, selall, bA, pfx, hist, maskw, cand, ccnt); kt += 4; ka = kb; }
  if (kt == ntile - 1) idx_tile<PASS, true>(ka, qf, wq, kt, lm, lg, tq, selall, bA, pfx, hist, maskw, cand, ccnt);
}

DI void idx_job(const Params& p, int b, int qg, unsigned char* smem) {
  int tid_ = threadIdx.x & 255; asm volatile("" : "+v"(tid_));
  const int tid = tid_, lane = tid & 63, wave = tid >> 6, lm = lane & 15, lg = lane >> 4;
  u32* hist = (u32*)smem;
  u32* maskw = (u32*)(smem + 32768);
  u32* cand = (u32*)(smem + 41216);
  u32* ccnt = (u32*)(smem + 49408);
  u32* binA = ccnt + 16; u32* needB = ccnt + 32; u32* binB = ccnt + 48; u32* needC = ccnt + 64;
  const int t0 = qg * 16, ntile = qg + 1, tq = t0 + lm;
  const bool selall = tq + 1 <= 256;
  bf16x8 qf[8];
  float wq[8];
  {
    const u16* qr = p.qix + (size_t)(b * TP + tq) * 256 + lg * 8;
    const float* wr = p.wix + (size_t)(b * TP + tq) * 8;
#pragma unroll
    for (int j = 0; j < 8; ++j) { qf[j] = *(const bf16x8*)(qr + j * 32); wq[j] = wr[j]; }
  }
  for (int i = tid; i < 8192 + 2112; i += 256) hist[i] = 0u;
  if (tid < 80) ccnt[tid] = 0u;
  __syncthreads();
  const u16* kbase = p.kix + (size_t)b * TP * 32;
  const f32x4 z4 = {0.f, 0.f, 0.f, 0.f};
  const u16* kp = kbase + (size_t)lm * 32 + lg * 8;
  idx_pass<0>(kp, qf, wq, wave, ntile, lm, lg, tq, selall, 0u, 0u, hist, maskw, cand, ccnt);
  __syncthreads();
  for (int qq = 0; qq < 4; ++qq) idx_scan(hist + (wave * 4 + qq) * 512, 256, binA, needB, wave * 4 + qq, lane);
  __syncthreads();
  for (int i = tid; i < 8192; i += 256) hist[i] = 0u;
  __syncthreads();
  idx_pass<1>(kp, qf, wq, wave, ntile, lm, lg, tq, selall, binA[lm], 0u, hist, maskw, cand, ccnt);
  __syncthreads();
  for (int qq = 0; qq < 4; ++qq) idx_scan(hist + (wave * 4 + qq) * 512, (int)needB[wave * 4 + qq], binB, needC, wave * 4 + qq, lane);
  __syncthreads();
  idx_pass<2>(kp, qf, wq, wave, ntile, lm, lg, tq, selall, binA[lm], (binA[lm] << 10) | binB[lm], hist, maskw, cand, ccnt);
  __syncthreads();
  {
    const int q = tid >> 4, i0 = tid & 15;
    u32 cnt = ccnt[q]; if (cnt > 64u) cnt = 64u;
    const u32 need = needC[q];
    for (u32 c = i0; c < cnt; c += 16) {
      const u32 u = cand[(q * 64 + c) * 2], key = cand[(q * 64 + c) * 2 + 1];
      u32 rank = 0;
      for (u32 e = 0; e < cnt; ++e) {
        const u32 u2 = cand[(q * 64 + e) * 2], k2 = cand[(q * 64 + e) * 2 + 1];
        rank += (u2 > u || (u2 == u && k2 < key)) ? 1u : 0u;
      }
      if (rank < need) atomicOr(&maskw[q * MW + (key >> 5)], 1u << (key & 31));
    }
  }
  __syncthreads();
  for (int i = tid; i < 16 * MW; i += 256) p.mask[(size_t)(b * TP + t0) * MW + i] = maskw[i];
  __syncthreads();
}

DI int next_job(u32* ctr, unsigned char* smem) {
  int* sj = (int*)(smem + SJOB_OFF);
  __syncthreads();
  if (threadIdx.x == 0) *sj = (int)atomicAdd(ctr, 1u);
  __syncthreads();
  return *sj;
}

DI void phase_attn(const Params& p, int layer, int phase, unsigned char* smem) {
  u32* ctr = p.ctr + phase;
  for (;;) {
    const int jp = next_job(ctr, smem);
    if (jp >= 2640) break;
    if (jp < 1056) { const int qb = 32 - jp / 32, r = jp & 31; diff_job8(p, layer, r >> 2, r & 3, qb, smem); continue; }
    int half = threadIdx.x >> 8; asm volatile("" : "+v"(half));
    unsigned char* sm = smem + half * HALF_BYTES;
    const int job = 2 * (jp - 1056) + half;
    if (job < 2112) { idx_job(p, job & 7, 263 - (job >> 3), sm); }
    else { const int i = job - 2112; const int qb = 32 - i / 32, r = i & 31; sb_job(p, r >> 2, r & 3, qb, sm); }
  }
}
DI void phase_sparse(const Params& p, int layer, int phase, unsigned char* smem) {
  u32* ctr = p.ctr + phase;
  for (;;) {
    const int jp = next_job(ctr, smem);
    if (jp >= 528) break;
    int half = threadIdx.x >> 8; asm volatile("" : "+v"(half));
    unsigned char* sm = smem + half * HALF_BYTES;
    const int job = 2 * jp + half;
    const int qb = 32 - job / 32, r = job & 31;
    sparse_job(p, layer, r >> 2, r & 3, qb, sm);
  }
}

DI void run_phase(const Params& p, int ph, unsigned char* smem, int rep = 0) {
  if (ph == 0) { phase_prep(p, smem); return; }
  const int layer = (ph - 1) / 7, s = (ph - 1) % 7;
  const u16* WL = p.wts + (size_t)layer * LAYER_W;
  switch (s) {
    case 0: phase_g1(p, layer, smem); break;
    case 1: phase_attn(p, layer, ph + 16 * rep, smem); break;
    case 2: phase_sparse(p, layer, ph + 16 * rep, smem); break;
    case 3: phase_merge(p, layer, smem); break;
    case 4: phase_resid(p, layer == 0 ? 1 : 3, p.merged, DM, WL + OFF_OUT, p.rowss + (size_t)(2 * layer + 1) * R, false, smem); break;
    case 5: phase_ffnup(p, layer, smem); break;
    default: phase_resid(p, 2, p.act, DFF, WL + OFF_DOWN, p.rowss + (size_t)(2 * layer + 2) * R, layer == 1, smem); break;
  }
}


#define XB_TMO      128
#define XB_XCNT(j)  (256  + 64 * (j))
#define XB_XSUB(j)  (1280 + 64 * (j))
#define XB_XGEN(j)  (2304 + 64 * (j))
#define XB_TOP      3328
#define XB_TOPGEN   3392
#define XCD_BAR_WORDS 3456
#define XB_SPIN_CAP (1u << 20)
#define LAS __attribute__((address_space(3)))
DI unsigned xb_ld(unsigned* p) { return __hip_atomic_load(p, __ATOMIC_RELAXED, __HIP_MEMORY_SCOPE_AGENT); }
DI unsigned xb_add(unsigned* p, unsigned v) { return __hip_atomic_fetch_add(p, v, __ATOMIC_RELAXED, __HIP_MEMORY_SCOPE_AGENT); }
DI unsigned xb_xcc_id() { return (unsigned)__builtin_amdgcn_s_getreg((3 << 11) | 20) & 0xFu; }
#define XB_SPIN(cond, bar) do { unsigned _sp = 0; while (cond) { __builtin_amdgcn_s_sleep(1); \
    if ((++_sp & 255u) == 0u) { if (xb_ld(&(bar)[XB_TMO])) break; if (_sp > XB_SPIN_CAP) { atomicAdd(&(bar)[XB_TMO], 1u); break; } } } } while (0)
struct XcdBarrier { unsigned* bar; unsigned x; volatile LAS unsigned* st; };
DI XcdBarrier xcd_barrier_post(unsigned* bar, volatile LAS unsigned* st) {
  XcdBarrier b; b.bar = bar; b.x = xb_xcc_id(); b.st = st;
  if (threadIdx.x == 0) (void)xb_add(&bar[XB_XCNT(b.x)], 1u);
  return b;
}
DI void xcd_barrier_complete(unsigned* bar, unsigned x, unsigned& nloc, unsigned& nx) {
  const unsigned G = gridDim.x * gridDim.y * gridDim.z;
  unsigned sum, cnt, mine, sp = 0u;
  for (;;) {
    sum = 0u; cnt = 0u; mine = 0u;
#pragma unroll
    for (unsigned j = 0; j < 16; ++j) { const unsigned c = xb_ld(&bar[XB_XCNT(j)]); sum += c; cnt += (c > 0u) ? 1u : 0u; mine = (j == x) ? c : mine; }
    if (sum == G) break;
    __builtin_amdgcn_s_sleep(1);
    if ((++sp & 255u) == 0u) { if (xb_ld(&bar[XB_TMO])) break; if (sp > XB_SPIN_CAP) { atomicAdd(&bar[XB_TMO], 1u); break; } }
  }
  nloc = mine > 0u ? mine : 1u; nx = cnt > 0u ? cnt : 1u;
}
DI void xcd_barrier(const XcdBarrier& b) {
  asm volatile("s_waitcnt vmcnt(0)" ::: "memory");
  __syncthreads();
  if (threadIdx.x == 0) {
    unsigned* bar = b.bar;
    __builtin_amdgcn_s_waitcnt(0);
    unsigned nloc = b.st[0], nx = b.st[1];
    if (nloc == 0u) { xcd_barrier_complete(bar, b.x, nloc, nx); b.st[0] = nloc; b.st[1] = nx; }
    const unsigned old = xb_add(&bar[XB_XSUB(b.x)], 1u);
    const unsigned gen = old / nloc;
    if (old + 1u == (gen + 1u) * nloc) {
      __builtin_amdgcn_fence(__ATOMIC_RELEASE, "agent");
      asm volatile("s_waitcnt vmcnt(0)" ::: "memory");
      const unsigned og = xb_add(&bar[XB_TOP], 1u);
      const unsigned tg = og / nx;
      if (og + 1u == (tg + 1u) * nx) xb_add(&bar[XB_TOPGEN], 1u);
      else XB_SPIN(xb_ld(&bar[XB_TOPGEN]) == tg, bar);
      __builtin_amdgcn_fence(__ATOMIC_ACQUIRE, "agent");
      xb_add(&bar[XB_XGEN(b.x)], 1u);
      asm volatile("s_waitcnt vmcnt(0)" ::: "memory");
    } else {
      XB_SPIN(xb_ld(&bar[XB_XGEN(b.x)]) == gen, bar);
      __builtin_amdgcn_fence(__ATOMIC_ACQUIRE, "agent");
      asm volatile("s_waitcnt vmcnt(0)" ::: "memory");
    }
  }
  __syncthreads();
}

constexpr int NPHASE = 15;

__global__ void __launch_bounds__(512) mega(Params p, int ph_lo, int ph_hi) {
  __shared__ __attribute__((aligned(16))) unsigned char smem[SMEM_BYTES];
  volatile LAS unsigned* xst = (volatile LAS unsigned*)(smem + (SMEM_BYTES - 16));
  if (threadIdx.x == 0) { xst[0] = 0u; xst[1] = 0u; }
  __syncthreads();
  const XcdBarrier xb = xcd_barrier_post(p.bar, xst);
  for (int ph = ph_lo; ph < ph_hi; ++ph) {
    run_phase(p, ph, smem);
#ifdef PROBE_MASK
    if (ph > 0 && ((PROBE_MASK >> ((ph - 1) % 7)) & 1)) { cg::this_grid().sync(); run_phase(p, ph, smem, 1); }
#endif
    if (ph + 1 < ph_hi) { if (ph_hi > 1000) cg::this_grid().sync(); else xcd_barrier(xb); }
  }
}

extern "C" void kernel_launch(void* const* d_in, const int* in_sizes, int n_in, void* d_out, int out_size, void* d_ws,
                              size_t ws_size, hipStream_t stream) {
  Params p{};
  const float* const* in = (const float* const*)d_in;
  p.x = in[0]; p.meta = in[1]; p.rel_bias = in[2]; p.attn_norm = in[3]; p.w_in = in[4]; p.b_gate = in[5];
  p.qn_sp = in[6]; p.kn_sp = in[7]; p.qn_df = in[8]; p.kn_df = in[9]; p.lq1 = in[10]; p.lk1 = in[11]; p.lq2 = in[12];
  p.lk2 = in[13]; p.subln = in[14]; p.w_br_sb = in[15]; p.w_br_sp = in[16]; p.w_br_df = in[17]; p.w_out = in[18];
  p.ffn_norm = in[19]; p.w_up = in[20]; p.conv_w = in[21]; p.conv_b = in[22]; p.w_down = in[23];
  p.out = (float*)d_out;
  unsigned char* w = (unsigned char*)d_ws;
  size_t off = 0;
  auto take = [&](size_t bytes) { unsigned char* r = w + off; off += (bytes + 255) & ~(size_t)255; return r; };
  p.ctr = (u32*)take(256);
  p.bar = (u32*)take((size_t)XCD_BAR_WORDS * 4);
  p.hb = (u16*)take((size_t)(R + 512) * DM * 2) + (size_t)256 * DM;
  p.rowss = (float*)take((size_t)4 * R * 4);
  p.side = (float*)take((size_t)NB * 128 * DM * 4);
  p.wts = (u16*)take((size_t)2 * LAYER_W * 2);
  p.mask = (u32*)take((size_t)R * MW * 4);
  unsigned char* region = w + off;
  p.qsb = (u16*)take((size_t)R * 256 * 2); p.ksb = (u16*)take((size_t)R * 256 * 2);
  p.qsp = (u16*)take((size_t)R * 256 * 2); p.ksp = (u16*)take((size_t)R * 256 * 2);
  p.qdf = (u16*)take((size_t)R * 512 * 2); p.kdf = (u16*)take((size_t)R * 512 * 2);
  p.vtsb = (u16*)take((size_t)R * 256 * 2); p.vtsp = (u16*)take((size_t)R * 256 * 2); p.vtdf = (u16*)take((size_t)R * 512 * 2);
  p.qix = (u16*)take((size_t)R * 256 * 2); p.kix = (u16*)take((size_t)R * 32 * 2); p.wix = (float*)take((size_t)R * 8 * 4);
  p.ysb = (u16*)take((size_t)R * 256 * 2); p.ysp = (u16*)take((size_t)R * 256 * 2); p.ydf = (u16*)take((size_t)R * 512 * 2);
  p.merged = (u16*)region;
  p.act = (u16*)region;
  if (off > ws_size) { fprintf(stderr, "workspace too small: need %zu have %zu\n", off, ws_size); return; }
#if FUSED
  static int grid_blocks = 0;
  if (!grid_blocks) {
    int dev = 0, cus = 0, per_cu = 0;
    hipGetDevice(&dev);
    hipDeviceGetAttribute(&cus, hipDeviceAttributeMultiprocessorCount, dev);
    hipOccupancyMaxActiveBlocksPerMultiprocessor(&per_cu, mega, 512, 0);
    if (per_cu > 1) per_cu = 1;
    grid_blocks = cus * per_cu;
  }
  int lo = 0, hi = NPHASE;
  (void)hipMemsetAsync(p.bar, 0, (size_t)XCD_BAR_WORDS * 4, stream);
  void* args[] = {&p, &lo, &hi};
  hipError_t e = hipLaunchCooperativeKernel((void*)mega, dim3(grid_blocks), dim3(512), args, 0, stream);
  if (e != hipSuccess) fprintf(stderr, "cooperative launch failed: %s (grid %d)\n", hipGetErrorString(e), grid_blocks);
#else
  for (int ph = 0; ph < NPHASE; ++ph) mega<<<256, 512, 0, stream>>>(p, ph, ph + 1);
#endif
}
```

```cpp
#include <hip/hip_runtime.h>
#include <hip/hip_cooperative_groups.h>
#include <cstdio>
namespace cg = cooperative_groups;

#ifndef FUSED
#define FUSED 1
#endif

#define DI __device__ __forceinline__
typedef unsigned short u16;
typedef unsigned int u32;
using bf16x8 = __attribute__((ext_vector_type(8))) short;
using f32x4 = __attribute__((ext_vector_type(4))) float;
using f32x16 = __attribute__((ext_vector_type(16))) float;
using u32x4 = __attribute__((ext_vector_type(4))) unsigned;
using u32x2 = __attribute__((ext_vector_type(2))) unsigned;
typedef __bf16 bf2_t __attribute__((ext_vector_type(2)));
typedef float f2_t __attribute__((ext_vector_type(2)));

constexpr int NB = 8, SEQ = 4096, DM = 1024, TP = 4224, TREAL = 4112, NMETA = 16, R = NB * TP;
constexpr int DFF = 2816, DIN = 6440, MW = 132;
constexpr float EPS = 1e-6f;
constexpr float LOG2E = 1.4426950408889634f;
constexpr int HALF_BYTES = 75776;
constexpr int SMEM_BYTES = 2 * HALF_BYTES;
constexpr int LUT_OFF = 73728;
constexpr int SJOB_OFF = 75000;

constexpr int NWIN = 3584;
constexpr size_t OFF_WIN = 0, OFF_WG = OFF_WIN + (size_t)NWIN * 1024, OFF_BRSB = OFF_WG + (size_t)3072 * 1024, OFF_BRSP = OFF_BRSB + 262144,
                 OFF_BRDF = OFF_BRSP + 262144, OFF_OUT = OFF_BRDF + 524288, OFF_UP = OFF_OUT + 1048576, OFF_DOWN = OFF_UP + (size_t)5632 * 1024,
                 LAYER_W = OFF_DOWN + (size_t)1024 * 2816;

struct Params {
  const float *x, *meta, *rel_bias, *attn_norm, *w_in, *b_gate, *qn_sp, *kn_sp, *qn_df, *kn_df, *lq1, *lk1, *lq2, *lk2,
      *subln, *w_br_sb, *w_br_sp, *w_br_df, *w_out, *ffn_norm, *w_up, *conv_w, *conv_b, *w_down;
  float* out;
  u16* hb; float* rowss; float* side; u16* wts;
  u16 *qsb, *ksb, *qsp, *ksp, *qdf, *kdf, *vtsb, *vtsp, *vtdf, *qix, *kix; float* wix;
  u16 *ysb, *ysp, *ydf; u32* mask; u16* merged; u16* act; u32* ctr; u32* bar;
};

DI u32 pack2bf(float a, float b) {
  f2_t v = {a, b};
  bf2_t r = __builtin_convertvector(v, bf2_t);
  return __builtin_bit_cast(u32, r);
}
DI u16 f2bf(float a) { return (u16)(pack2bf(a, 0.f) & 0xffffu); }
DI float wave_sum(float v) {
#pragma unroll
  for (int o = 32; o; o >>= 1) v += __shfl_xor(v, o);
  return v;
}
DI f32x4 mfma16(bf16x8 a, bf16x8 b, f32x4 c) { return __builtin_amdgcn_mfma_f32_16x16x32_bf16(a, b, c, 0, 0, 0); }
DI f32x16 mfma32(bf16x8 a, bf16x8 b, f32x16 c) { return __builtin_amdgcn_mfma_f32_32x32x16_bf16(a, b, c, 0, 0, 0); }

DI int vblock() {
  int g = gridDim.x, b = blockIdx.x;
  if ((g & 7) == 0) return (b & 7) * (g >> 3) + (b >> 3);
  return b;
}

DI float* hrow_w(const Params& p, int gr) {
  int b = gr / TP, t = gr - b * TP;
  if (t >= NMETA && t < TREAL) return p.out + ((size_t)(b * SEQ + t - NMETA)) * DM;
  int s = t < NMETA ? t : t - TREAL + NMETA;
  return p.side + ((size_t)(b * 128 + s)) * DM;
}
DI const float* hrow_r(const Params& p, int layer, int gr) {
  int b = gr / TP, t = gr - b * TP;
  if (t >= NMETA && t < TREAL) {
    size_t o = ((size_t)(b * SEQ + t - NMETA)) * DM;
    return layer == 0 ? p.x + o : p.out + o;
  }
  int s = t < NMETA ? t : t - TREAL + NMETA;
  return p.side + ((size_t)(b * 128 + s)) * DM;
}

DI int wt_srccol(int kind, int n) {
  if (kind == 0) {
    if (n < 1536) return n;
    if (n < 3072) return 1832 + n - 1536;
    if (n < 3328) return 1536 + n - 3072;
    if (n < 3360) return 1792 + n - 3328;
    if (n < 3368) return 1824 + n - 3360;
    return -1;
  }
  if (kind == 1) return 3368 + n;
  if (kind == 6) {
    int j = n >> 8, w = n & 255, wn = w >> 7, ni = (w & 127) >> 4, c = w & 15;
    int ff = 128 * j + 64 * wn + 16 * (ni >> 1) + c;
    return (ni & 1) ? DFF + ff : ff;
  }
  return n;
}

DI void phase_prep(const Params& p, unsigned char* smem) {
  int tid_ = threadIdx.x; asm volatile("" : "+v"(tid_));
  const int tid = tid_, wave = tid >> 6, lane = tid & 63;
  for (int gr = blockIdx.x * 8 + wave; gr < R; gr += gridDim.x * 8) {
    int b = gr / TP, t = gr - b * TP;
    const float* src = nullptr;
    if (t < NMETA) src = p.meta + (size_t)t * DM;
    else if (t < TREAL) src = p.x + ((size_t)(b * SEQ + t - NMETA)) * DM;
    float4 v[4];
    float ss = 0.f;
#pragma unroll
    for (int i = 0; i < 4; ++i) {
      v[i] = src ? ((const float4*)src)[lane + 64 * i] : make_float4(0.f, 0.f, 0.f, 0.f);
      ss += v[i].x * v[i].x + v[i].y * v[i].y + v[i].z * v[i].z + v[i].w * v[i].w;
    }
    ss = wave_sum(ss);
#pragma unroll
    for (int i = 0; i < 4; ++i) {
      u32x2 pk = {pack2bf(v[i].x, v[i].y), pack2bf(v[i].z, v[i].w)};
      *(u32x2*)(p.hb + (size_t)gr * DM + (lane + 64 * i) * 4) = pk;
    }
    if (lane == 0) { p.rowss[gr] = ss; p.rowss[R + gr] = 0.f; p.rowss[2 * R + gr] = 0.f; p.rowss[3 * R + gr] = 0.f; }
    if (t < NMETA || t >= TREAL) {
      int s = t < NMETA ? t : t - TREAL + NMETA;
      float* d = p.side + ((size_t)(b * 128 + s)) * DM;
#pragma unroll
      for (int i = 0; i < 4; ++i) ((float4*)d)[lane + 64 * i] = v[i];
    }
  }
  if (blockIdx.x == 0 && tid < 64) p.ctr[tid] = 0;
  for (int i = blockIdx.x * 512 + tid; i < 2 * 256 * DM / 8; i += gridDim.x * 512) {
    const int hf = i / (256 * DM / 8), o = i - hf * (256 * DM / 8);
    u16* d = hf ? p.hb + (size_t)R * DM : p.hb - (size_t)256 * DM;
    *(u32x4*)(d + (size_t)o * 8) = u32x4{0u, 0u, 0u, 0u};
  }
  const int half = tid >> 8, t2 = tid & 255;
  float* tl = (float*)(smem + half * HALF_BYTES);
  constexpr int NK[8] = {NWIN, 3072, 1024, 1024, 1024, 1024, 5632, 1024};
  constexpr int KK[8] = {1024, 1024, 256, 256, 512, 1024, 1024, 2816};
  int total = 0;
  int cum[9];
  cum[0] = 0;
#pragma unroll
  for (int k = 0; k < 8; ++k) { total += (NK[k] / 64) * (KK[k] / 64); cum[k + 1] = total; }
  for (int jp = blockIdx.x; 2 * jp < 2 * total; jp += gridDim.x) {
    const int job = 2 * jp + half;
    const bool act = job < 2 * total;
    int layer = job >= total ? 1 : 0;
    int j = job - layer * total;
    int kind = 0;
#pragma unroll
    for (int k = 1; k < 8; ++k) if (j >= cum[k]) kind = k;
    int jj = j;
    int K = 1024, ld = 1024;
    const float* src = p.w_in; const float* gain = nullptr; u16* dst = p.wts + (size_t)layer * LAYER_W;
    switch (kind) {
      case 0: jj -= cum[0]; K = 1024; ld = DIN; src = p.w_in + (size_t)layer * DM * DIN; gain = p.attn_norm + layer * DM; dst += OFF_WIN; break;
      case 1: jj -= cum[1]; K = 1024; ld = DIN; src = p.w_in + (size_t)layer * DM * DIN; gain = p.attn_norm + layer * DM; dst += OFF_WG; break;
      case 2: jj -= cum[2]; K = 256; ld = 1024; src = p.w_br_sb + (size_t)layer * 256 * 1024; dst += OFF_BRSB; break;
      case 3: jj -= cum[3]; K = 256; ld = 1024; src = p.w_br_sp + (size_t)layer * 256 * 1024; dst += OFF_BRSP; break;
      case 4: jj -= cum[4]; K = 512; ld = 1024; src = p.w_br_df + (size_t)layer * 512 * 1024; dst += OFF_BRDF; break;
      case 5: jj -= cum[5]; K = 1024; ld = 1024; src = p.w_out + (size_t)layer * 1024 * 1024; dst += OFF_OUT; break;
      case 6: jj -= cum[6]; K = 1024; ld = 2 * DFF; src = p.w_up + (size_t)layer * DM * 2 * DFF; gain = p.ffn_norm + layer * DM; dst += OFF_UP; break;
      default: jj -= cum[7]; K = DFF; ld = 1024; src = p.w_down + (size_t)layer * DFF * 1024; dst += OFF_DOWN; break;
    }
    int nkt = K / 64;
    int n0 = (jj / nkt) * 64, k0 = (jj % nkt) * 64;
    if (act) {
      const int nn = t2 & 63, kq = t2 >> 6;
      const int col = wt_srccol(kind, n0 + nn);
      const float* sp = src + (size_t)(k0 + kq) * ld + (col >= 0 ? col : 0);
      float v[16];
#pragma unroll
      for (int i = 0; i < 16; ++i) v[i] = sp[(size_t)(4 * i) * ld];
#pragma unroll
      for (int i = 0; i < 16; ++i) {
        float x = col >= 0 ? v[i] : 0.f;
        if (gain) x *= gain[k0 + kq + 4 * i];
        tl[nn * 65 + kq + 4 * i] = x;
      }
    }
    __syncthreads();
    if (act) {
#pragma unroll
      for (int i = 0; i < 2; ++i) {
        int idx = t2 + 256 * i, nn = idx >> 3, c = idx & 7;
        const float* s = tl + nn * 65 + c * 8;
        u32x4 pk = {pack2bf(s[0], s[1]), pack2bf(s[2], s[3]), pack2bf(s[4], s[5]), pack2bf(s[6], s[7])};
        *(u32x4*)(dst + (size_t)(n0 + nn) * K + k0 + c * 8) = pk;
      }
    }
    __syncthreads();
  }
}

template <int MI, int NI>
DI void gemm_kloop(const u16* Au, int lda, const u16* Bu, int ldb, int K, f32x4 (&acc)[NI][MI], unsigned char* smem) {
  int tid_ = threadIdx.x; asm volatile("" : "+v"(tid_));
  const int tid = tid_, lane = tid & 63, wave = tid >> 6, wm = wave >> 1, wn = wave & 1;
  const int lr = tid >> 3, lc = tid & 7;
  const int voa = lr * lda + lc * 8, vob = lr * ldb + lc * 8;
  constexpr int NB2 = NI / 2;
  u32x4 ra[MI], rb[NB2];
  const int nk = K >> 6;
  const int fsw = (lane & 15) >> 1;
  const int fro0 = (lane & 15) * 128 + (((lane >> 4) ^ fsw) << 4);
  const int fro1 = (lane & 15) * 128 + ((((lane >> 4) + 4) ^ fsw) << 4);
  const int wof = lr * 128 + ((lc ^ ((lr >> 1) & 7)) << 4);
#define GLOAD(K0)                                                                                        \
  {                                                                                                      \
    _Pragma("unroll") for (int q = 0; q < MI; ++q) ra[q] = *(const u32x4*)((Au + (size_t)(q * 64) * lda + (K0)) + voa); \
    _Pragma("unroll") for (int q = 0; q < NB2; ++q) rb[q] = *(const u32x4*)((Bu + (size_t)(q * 64) * ldb + (K0)) + vob); \
  }
#define SWRITE(BUF)                                                                                      \
  {                                                                                                      \
    unsigned char* d_ = smem + (BUF) * 65536 + wof;                                                      \
    _Pragma("unroll") for (int q = 0; q < MI; ++q) *(u32x4*)(d_ + q * 8192) = ra[q];                     \
    _Pragma("unroll") for (int q = 0; q < NB2; ++q) *(u32x4*)(d_ + 32768 + q * 8192) = rb[q];            \
  }
  GLOAD(0);
  SWRITE(0);
  if (nk > 1) GLOAD(64);
  for (int kt = 0; kt < nk; ++kt) {
    __syncthreads();
    if (kt + 1 < nk) {
      SWRITE((kt + 1) & 1);
      if (kt + 2 < nk) GLOAD((kt + 2) << 6);
    }
    {
      const unsigned char* sa = smem + (kt & 1) * 65536;
      const unsigned char* sb = sa + 32768;
#pragma unroll
      for (int ks = 0; ks < 2; ++ks) {
        const int fo = ks ? fro1 : fro0;
        bf16x8 af[MI];
#pragma unroll
        for (int i = 0; i < MI; ++i) af[i] = *(const bf16x8*)(sa + (wm * 16 * MI + i * 16) * 128 + fo);
#pragma unroll
        for (int nh = 0; nh < NI; nh += 4) {
          bf16x8 wf[4];
#pragma unroll
          for (int i = 0; i < 4; ++i) wf[i] = *(const bf16x8*)(sb + (wn * 16 * NI + (nh + i) * 16) * 128 + fo);
#pragma unroll
          for (int ni = 0; ni < 4; ++ni)
#pragma unroll
            for (int mi = 0; mi < MI; ++mi) acc[nh + ni][mi] = mfma16(wf[ni], af[mi], acc[nh + ni][mi]);
        }
      }
    }
  }
  __syncthreads();
#undef GLOAD
#undef SWRITE
}

template <int MI, int NI>
DI void zero_acc(f32x4 (&acc)[NI][MI]) {
#pragma unroll
  for (int i = 0; i < NI; ++i)
#pragma unroll
    for (int j = 0; j < MI; ++j) acc[i][j] = f32x4{0.f, 0.f, 0.f, 0.f};
}

DI void phase_g1(const Params& p, int layer, unsigned char* smem) {
  int tid_ = threadIdx.x; asm volatile("" : "+v"(tid_));
  const int tid = tid_, lane = tid & 63, wave = tid >> 6, wm = wave >> 1, wn = wave & 1;
  const int lr = tid >> 3, lc = tid & 7, lm = lane & 15, lg = lane >> 4;
  const u16* W = p.wts + (size_t)layer * LAYER_W + OFF_WIN;
  const float* rowss = p.rowss + (size_t)(2 * layer) * R;
  constexpr int NT = 13, NTILES = 132 * NT;
  for (int it = vblock(); it < NTILES; it += gridDim.x) {
    const int g = it / (4 * NT), rem = it - g * (4 * NT), nt = rem >> 2, mt = g * 4 + (rem & 3);
    f32x4 acc[8][4];
    zero_acc<4, 8>(acc);
    gemm_kloop<4, 8>(p.hb + (size_t)(mt * 256) * DM, DM, W + (size_t)(nt * 256) * DM, DM, DM, acc, smem);
    int mrow[4];
#pragma unroll
    for (int mi = 0; mi < 4; ++mi) {
      mrow[mi] = mt * 256 + wm * 64 + mi * 16 + lm;
      float rs = rsqrtf(rowss[mrow[mi]] * (1.f / DM) + EPS);
#pragma unroll
      for (int ni = 0; ni < 8; ++ni) acc[ni][mi] *= rs;
    }
    int kind;
    u16* dst = nullptr; int ld = 256, col0 = 0, vrows = 256; const float* gn = nullptr;
    if (nt == 0) { kind = 0; dst = p.qsb; }
    else if (nt == 1) { kind = 0; dst = p.ksb; }
    else if (nt == 2) { kind = 2; dst = p.vtsb; vrows = 256; }
    else if (nt == 3) { kind = 1; dst = p.qsp; gn = p.qn_sp + layer * 64; }
    else if (nt == 4) { kind = 1; dst = p.ksp; gn = p.kn_sp + layer * 64; }
    else if (nt == 5) { kind = 2; dst = p.vtsp; vrows = 256; }
    else if (nt < 8) { kind = 1; dst = p.qdf; ld = 512; col0 = (nt - 6) * 256; gn = p.qn_df + layer * 64; }
    else if (nt < 10) { kind = 1; dst = p.kdf; ld = 512; col0 = (nt - 8) * 256; gn = p.kn_df + layer * 64; }
    else if (nt < 12) { kind = 2; dst = p.vtdf; col0 = (nt - 10) * 256; vrows = 512; }
    else { kind = 0; dst = p.qix; }
    if (kind == 1) {
#pragma unroll
      for (int mi = 0; mi < 4; ++mi)
#pragma unroll
        for (int hh = 0; hh < 2; ++hh) {
          float ss = 0.f;
#pragma unroll
          for (int n4 = 0; n4 < 4; ++n4)
#pragma unroll
            for (int r = 0; r < 4; ++r) ss += acc[hh * 4 + n4][mi][r] * acc[hh * 4 + n4][mi][r];
          ss += __shfl_xor(ss, 16);
          ss += __shfl_xor(ss, 32);
          float sc = rsqrtf(ss * (1.f / 64.f) + EPS);
#pragma unroll
          for (int n4 = 0; n4 < 4; ++n4)
#pragma unroll
            for (int r = 0; r < 4; ++r) acc[hh * 4 + n4][mi][r] *= sc * gn[n4 * 16 + lg * 4 + r];
        }
    }
    if (kind == 0 || kind == 1) {
#pragma unroll
      for (int mi = 0; mi < 4; ++mi)
#pragma unroll
        for (int ni = 0; ni < 8; ++ni) {
          u32x2 pk = {pack2bf(acc[ni][mi][0], acc[ni][mi][1]), pack2bf(acc[ni][mi][2], acc[ni][mi][3])};
          *(u32x2*)(dst + (size_t)mrow[mi] * ld + col0 + wn * 128 + ni * 16 + lg * 4) = pk;
        }
    } else if (kind == 2) {
#pragma unroll
      for (int mi = 0; mi < 4; ++mi) {
        int b = mrow[mi] / TP, t = mrow[mi] - b * TP;
#pragma unroll
        for (int ni = 0; ni < 8; ++ni)
#pragma unroll
          for (int r = 0; r < 4; ++r) {
            int row = col0 + wn * 128 + ni * 16 + lg * 4 + r;
            dst[((size_t)(b * vrows + row)) * TP + t] = f2bf(acc[ni][mi][r]);
          }
      }
    }
  }
  {
    const int v = vblock(), first = NTILES % gridDim.x, nfree = gridDim.x - first;
    if (v >= first) {
      for (int s = v - first; s < 132; s += nfree) {
        const int mt = s;
        f32x4 acc[4][4];
        zero_acc<4, 4>(acc);
        gemm_kloop<4, 4>(p.hb + (size_t)(mt * 256) * DM, DM, W + (size_t)(13 * 256) * DM, DM, DM, acc, smem);
        if (wn == 0) {
#pragma unroll
          for (int mi = 0; mi < 4; ++mi) {
            const int m = mt * 256 + wm * 64 + mi * 16 + lm;
            const float rs = rsqrtf(rowss[m] * (1.f / DM) + EPS);
#pragma unroll
            for (int ni = 0; ni < 2; ++ni) {
              u32x2 pk = {pack2bf(acc[ni][mi][0] * rs, acc[ni][mi][1] * rs), pack2bf(acc[ni][mi][2] * rs, acc[ni][mi][3] * rs)};
              *(u32x2*)(p.kix + (size_t)m * 32 + ni * 16 + lg * 4) = pk;
            }
            if (lg < 2) {
              float4 w4 = make_float4(acc[2][mi][0] * rs, acc[2][mi][1] * rs, acc[2][mi][2] * rs, acc[2][mi][3] * rs);
              *(float4*)(p.wix + (size_t)m * 8 + lg * 4) = w4;
            }
          }
        }
      }
    }
  }
}

template <int MI, int NI>
DI void resid_epilogue(const Params& p, int from_x, const f32x4 (&acc)[NI][MI], int row0, int n0, float* rowss_next, bool last, int lm, int lg) {
#pragma unroll
  for (int mi = 0; mi < MI; ++mi) {
    const int m = row0 + mi * 16 + lm;
    const float* hr = hrow_r(p, from_x == 1 ? 0 : 1, m);
    float* hw = hrow_w(p, m);
    u16* hbr = p.hb + (size_t)m * DM;
    float ss = 0.f;
#pragma unroll
    for (int ni = 0; ni < NI; ++ni) {
      const int n = n0 + ni * 16 + lg * 4;
      float4 h;
      if (from_x >= 2) {
        const u32x2 pk = *(const u32x2*)(hbr + n);
        h = make_float4(__uint_as_float(pk[0] << 16), __uint_as_float(pk[0] & 0xffff0000u), __uint_as_float(pk[1] << 16), __uint_as_float(pk[1] & 0xffff0000u));
      } else h = *(const float4*)(hr + n);
      h.x += acc[ni][mi][0]; h.y += acc[ni][mi][1]; h.z += acc[ni][mi][2]; h.w += acc[ni][mi][3];
      if (last) *(float4*)(hw + n) = h;
      if (!last) {
        u32x2 pk = {pack2bf(h.x, h.y), pack2bf(h.z, h.w)};
        *(u32x2*)(hbr + n) = pk;
        ss += h.x * h.x + h.y * h.y + h.z * h.z + h.w * h.w;
      }
    }
    if (!last) {
      ss += __shfl_xor(ss, 16);
      ss += __shfl_xor(ss, 32);
      if (lg == 0) atomicAdd(rowss_next + m, ss);
    }
  }
}

DI void phase_resid(const Params& p, int from_x, const u16* A, int K, const u16* W, float* rowss_next, bool last,
                    unsigned char* smem) {
  int tid_ = threadIdx.x; asm volatile("" : "+v"(tid_));
  const int tid = tid_, lane = tid & 63, wave = tid >> 6, wm = wave >> 1, wn = wave & 1;
  const int lm = lane & 15, lg = lane >> 4;
  constexpr int NT = 4, NTILES = 132 * NT;
  const int nfull = (NTILES / (int)gridDim.x) * (int)gridDim.x;
  for (int it = vblock(); it < nfull; it += gridDim.x) {
    const int g = it / (4 * NT), rem = it - g * (4 * NT), nt = rem >> 2, mt = g * 4 + (rem & 3);
    f32x4 acc[8][4];
    zero_acc<4, 8>(acc);
    gemm_kloop<4, 8>(A + (size_t)(mt * 256) * K, K, W + (size_t)(nt * 256) * K, K, K, acc, smem);
    resid_epilogue<4, 8>(p, from_x, acc, mt * 256 + wm * 64, nt * 256 + wn * 128, rowss_next, last, lm, lg);
  }
  for (int s = vblock(); s < 4 * (NTILES - nfull); s += gridDim.x) {
    const int it = nfull + (s >> 2), hm = s & 1, hn = (s >> 1) & 1;
    const int g = it / (4 * NT), rem = it - g * (4 * NT), nt = rem >> 2, mt = g * 4 + (rem & 3);
    f32x4 acc[4][2];
    zero_acc<2, 4>(acc);
    gemm_kloop<2, 4>(A + (size_t)(mt * 256 + hm * 128) * K, K, W + (size_t)(nt * 256 + hn * 128) * K, K, K, acc, smem);
    resid_epilogue<2, 4>(p, from_x, acc, mt * 256 + hm * 128 + wm * 32, nt * 256 + hn * 128 + wn * 64, rowss_next, last, lm, lg);
  }
}

template <int MI>
DI void merge_tile(const Params& p, int layer, int rowbase, int nt, unsigned char* smem) {
  int tid_ = threadIdx.x; asm volatile("" : "+v"(tid_));
  const int tid = tid_, lane = tid & 63, wave = tid >> 6, wm = wave >> 1, wn = wave & 1;
  const int lm = lane & 15, lg = lane >> 4;
  const u16* WL = p.wts + (size_t)layer * LAYER_W;
  const float* rowss = p.rowss + (size_t)(2 * layer) * R;
  const float* bg = p.b_gate + layer * 3 * DM;
  u32 mp[4][MI][2];
#pragma unroll
  for (int ni = 0; ni < 4; ++ni)
#pragma unroll
    for (int mi = 0; mi < MI; ++mi) { mp[ni][mi][0] = 0u; mp[ni][mi][1] = 0u; }
#pragma unroll 1
  for (int br = 0; br < 3; ++br) {
    const u16* Y = br == 0 ? p.ysb : (br == 1 ? p.ysp : p.ydf);
    const int Kb = br == 2 ? 512 : 256;
    const u16* Wb = WL + (br == 0 ? OFF_BRSB : (br == 1 ? OFF_BRSP : OFF_BRDF));
    f32x4 acc[4][MI];
    zero_acc<MI, 4>(acc);
    gemm_kloop<MI, 4>(Y + (size_t)rowbase * Kb, Kb, Wb + (size_t)(nt * 128) * Kb, Kb, Kb, acc, smem);
    u32 brp[4][MI][2];
#pragma unroll
    for (int ni = 0; ni < 4; ++ni)
#pragma unroll
      for (int mi = 0; mi < MI; ++mi) {
        brp[ni][mi][0] = pack2bf(acc[ni][mi][0], acc[ni][mi][1]);
        brp[ni][mi][1] = pack2bf(acc[ni][mi][2], acc[ni][mi][3]);
      }
    zero_acc<MI, 4>(acc);
    gemm_kloop<MI, 4>(p.hb + (size_t)rowbase * DM, DM, WL + OFF_WG + (size_t)(br * 1024 + nt * 128) * DM, DM, DM, acc, smem);
    int m0 = rowbase + wm * 16 * MI + lm, n0 = nt * 128 + wn * 64 + lg * 4;
    asm volatile("" : "+v"(m0), "+v"(n0));
#pragma unroll
    for (int mi = 0; mi < MI; ++mi) {
      const float rs = rsqrtf(rowss[m0 + mi * 16] * (1.f / DM) + EPS);
#pragma unroll
      for (int ni = 0; ni < 4; ++ni) {
        const float4 b4 = *(const float4*)(bg + br * DM + n0 + ni * 16);
        const float bb[4] = {b4.x, b4.y, b4.z, b4.w};
        float mv[4];
#pragma unroll
        for (int r = 0; r < 4; ++r) {
          const float gv = acc[ni][mi][r] * rs + bb[r];
          const float sg = 1.f / (1.f + __expf(-gv));
          const u32 w = brp[ni][mi][r >> 1], mw = mp[ni][mi][r >> 1];
          const float bv = __uint_as_float((r & 1) ? (w & 0xffff0000u) : (w << 16));
          const float mo = __uint_as_float((r & 1) ? (mw & 0xffff0000u) : (mw << 16));
          mv[r] = mo + sg * bv;
        }
        mp[ni][mi][0] = pack2bf(mv[0], mv[1]);
        mp[ni][mi][1] = pack2bf(mv[2], mv[3]);
      }
    }
  }
  int m0 = rowbase + wm * 16 * MI + lm, n0 = nt * 128 + wn * 64 + lg * 4;
  asm volatile("" : "+v"(m0), "+v"(n0));
#pragma unroll
  for (int mi = 0; mi < MI; ++mi)
#pragma unroll
    for (int ni = 0; ni < 4; ++ni) {
      u32x2 pk = {mp[ni][mi][0], mp[ni][mi][1]};
      *(u32x2*)(p.merged + (size_t)(m0 + mi * 16) * DM + n0 + ni * 16) = pk;
    }
}

DI void phase_merge(const Params& p, int layer, unsigned char* smem) {
  constexpr int NT = 8, NTILES = 132 * NT;
  const int nfull = (NTILES / (int)gridDim.x) * (int)gridDim.x;
  for (int it = vblock(); it < nfull; it += gridDim.x) {
    const int g = it / (4 * NT), rem = it - g * (4 * NT), nt = rem >> 2, mt = g * 4 + (rem & 3);
    merge_tile<4>(p, layer, mt * 256, nt, smem);
  }
  for (int s = vblock(); s < 2 * (NTILES - nfull); s += gridDim.x) {
    const int it = nfull + (s >> 1), hf = s & 1;
    const int g = it / (4 * NT), rem = it - g * (4 * NT), nt = rem >> 2, mt = g * 4 + (rem & 3);
    merge_tile<2>(p, layer, mt * 256 + hf * 128, nt, smem);
  }
}

DI void phase_ffnup(const Params& p, int layer, unsigned char* smem) {
  int tid_ = threadIdx.x; asm volatile("" : "+v"(tid_));
  const int tid = tid_, lane = tid & 63, wave = tid >> 6, wm = wave >> 1, wn = wave & 1;
  const int lr = tid >> 3, lc = tid & 7, lm = lane & 15, lg = lane >> 4;
  const u16* W = p.wts + (size_t)layer * LAYER_W + OFF_UP;
  const float* rowss = p.rowss + (size_t)(2 * layer + 1) * R;
  const float* cw = p.conv_w + layer * 3 * DFF;
  const float* cb = p.conv_b + layer * DFF;
  constexpr int NT = 22, MT = 136, NTILES = MT * NT;
  float* G = (float*)smem;
  for (int it = vblock(); it < NTILES; it += gridDim.x) {
    const int g = it / (4 * NT), rem = it - g * (4 * NT), nt = rem >> 2, mt = g * 4 + (rem & 3);
    const int b = mt / 17, ti = mt - b * 17, tbase = 254 * ti - 2;
    f32x4 acc[8][4];
    zero_acc<4, 8>(acc);
    gemm_kloop<4, 8>(p.hb + ((ptrdiff_t)(b * TP + tbase)) * DM, DM, W + (size_t)(nt * 256) * DM, DM, DM, acc, smem);
    int r0 = wm * 64 + lm, gc0 = 64 * wn + 4 * lg;
    asm volatile("" : "+v"(r0), "+v"(gc0));
    int tt[4];
#pragma unroll
    for (int mi = 0; mi < 4; ++mi) {
      const int r = r0 + mi * 16;
      tt[mi] = tbase + r;
      float rs = (tt[mi] >= 0 && tt[mi] < TP) ? rsqrtf(rowss[b * TP + tt[mi]] * (1.f / DM) + EPS) : 0.f;
#pragma unroll
      for (int ni = 0; ni < 8; ++ni) acc[ni][mi] *= rs;
#pragma unroll
      for (int n2 = 0; n2 < 4; ++n2) {
        float4 g4 = make_float4(acc[2 * n2][mi][0], acc[2 * n2][mi][1], acc[2 * n2][mi][2], acc[2 * n2][mi][3]);
        *(float4*)(G + r * 132 + gc0 + 16 * n2) = g4;
      }
    }
    __syncthreads();
#pragma unroll
    for (int n2 = 0; n2 < 4; ++n2) {
      const int gc = gc0 + 16 * n2;
      const int ff = 128 * nt + gc;
      const float4 w0 = *(const float4*)(cw + ff), w1 = *(const float4*)(cw + DFF + ff), w2 = *(const float4*)(cw + 2 * DFF + ff);
      const float4 c4 = *(const float4*)(cb + ff);
#pragma unroll
      for (int mi = 0; mi < 4; ++mi) {
        const int r = r0 + mi * 16;
        if (r >= 2 && tt[mi] < TP) {
          const float4 g1 = *(const float4*)(G + (r - 1) * 132 + gc);
          const float4 g2 = *(const float4*)(G + (r - 2) * 132 + gc);
          float cv[4];
          cv[0] = c4.x + w0.x * g2.x + w1.x * g1.x + w2.x * acc[2 * n2][mi][0];
          cv[1] = c4.y + w0.y * g2.y + w1.y * g1.y + w2.y * acc[2 * n2][mi][1];
          cv[2] = c4.z + w0.z * g2.z + w1.z * g1.z + w2.z * acc[2 * n2][mi][2];
          cv[3] = c4.w + w0.w * g2.w + w1.w * g1.w + w2.w * acc[2 * n2][mi][3];
          float a[4];
#pragma unroll
          for (int e = 0; e < 4; ++e) a[e] = cv[e] / (1.f + __expf(-cv[e])) * acc[2 * n2 + 1][mi][e];
          u32x2 pk = {pack2bf(a[0], a[1]), pack2bf(a[2], a[3])};
          *(u32x2*)(p.act + (size_t)(b * TP + tt[mi]) * DFF + ff) = pk;
        }
      }
    }
    __syncthreads();
  }
}

DI int swap23(int k) { return (k & ~12) | ((k & 4) << 1) | ((k & 8) >> 1); }

DI void build_lut(const Params& p, int bias_head, unsigned char* smem, int tid) {
  float* lut = (float*)(smem + LUT_OFF);
  const int d = tid;
  if (d <= 128) {
    int bucket;
    if (d < 16) bucket = d;
    else {
      float nf = (float)d;
      int large = 16 + (int)(logf(nf / 16.f) / 2.0794415416798357f * 16.f);
      bucket = large < 31 ? large : 31;
    }
    lut[d] = p.rel_bias[bucket * 8 + bias_head] * LOG2E;
  }
}

template <int NCH>
DI void ld_tile_g(u32x4 (&r)[NCH], const u16* base, size_t rstride, int k0, bool is_vt, int tid) {
#pragma unroll
  for (int i = 0; i < NCH; ++i) {
    int id = tid + 256 * i, row = id >> 3, c = id & 7;
    const u16* s = is_vt ? base + (size_t)row * rstride + k0 + c * 8 : base + (size_t)(k0 + row) * rstride + c * 8;
    r[i] = *(const u32x4*)s;
  }
}
template <int NCH>
DI void st_tile_s(const u32x4 (&r)[NCH], unsigned char* dst, bool permute, int tid) {
#pragma unroll
  for (int i = 0; i < NCH; ++i) {
    int id = tid + 256 * i, row = id >> 3, c = id & 7;
    int rr = permute ? swap23(row) : row;
    *(u32x4*)(dst + rr * 144 + c * 16) = r[i];
  }
}

DI bf16x8 pack8(const f32x16& v, int s2) {
  u32x4 pk;
  if (s2 == 0) pk = u32x4{pack2bf(v[0], v[1]), pack2bf(v[2], v[3]), pack2bf(v[4], v[5]), pack2bf(v[6], v[7])};
  else pk = u32x4{pack2bf(v[8], v[9]), pack2bf(v[10], v[11]), pack2bf(v[12], v[13]), pack2bf(v[14], v[15])};
  return __builtin_bit_cast(bf16x8, pk);
}
DI f32x16 zero16() {
  f32x16 z;
#pragma unroll
  for (int i = 0; i < 16; ++i) z[i] = 0.f;
  return z;
}

DI void diff_map(const unsigned char* sk, const bf16x8 (&qf)[4], const unsigned char* sv, const float* lut, bool far,
                 bool diag, int ks0, int tq, int h, int lq, f32x16 (&O)[4], float& m, float& l) {
  const float csc = 0.125f * LOG2E;
  f32x16 S = zero16();
#pragma unroll
  for (int s = 0; s < 4; ++s) {
    bf16x8 kf = *(const bf16x8*)(sk + lq * 144 + (16 * s + 8 * h) * 2);
    S = mfma32(kf, qf[s], S);
  }
  if (far) {
    const float cbias = lut[128];
    float mx = fmaxf(fmaxf(S[0], S[1]), S[2]);
#pragma unroll
    for (int i = 3; i < 15; i += 2) mx = fmaxf(fmaxf(mx, S[i]), S[i + 1]);
    mx = fmaxf(mx, S[15]);
    mx = fmaxf(mx, __shfl_xor(mx, 32));
    const float mn = fmaxf(m, mx * csc + cbias);
    if (__any(mn > m + 8.f)) {
      const float a = __builtin_amdgcn_exp2f(m - mn);
      l *= a; m = mn;
#pragma unroll
      for (int d = 0; d < 4; ++d) O[d] *= a;
    }
    const float off = cbias - m;
#pragma unroll
    for (int i = 0; i < 16; ++i) { float pv = __builtin_amdgcn_exp2f(S[i] * csc + off); l += pv; S[i] = pv; }
  } else {
    float mx = -1e30f;
#pragma unroll
    for (int i = 0; i < 16; ++i) {
      const int key = ks0 + 16 * (i >> 3) + 8 * h + (i & 7);
      int d = tq - key;
      const bool msk = diag && d < 0;
      d = d < 0 ? 0 : (d > 128 ? 128 : d);
      float x = S[i] * csc + lut[d];
      if (msk) x = -1e30f;
      S[i] = x;
      mx = fmaxf(mx, x);
    }
    mx = fmaxf(mx, __shfl_xor(mx, 32));
    const float mn = fmaxf(m, mx);
    if (__any(mn > m + 8.f)) {
      const float a = __builtin_amdgcn_exp2f(m - mn);
      l *= a; m = mn;
#pragma unroll
      for (int d = 0; d < 4; ++d) O[d] *= a;
    }
#pragma unroll
    for (int i = 0; i < 16; ++i) { float pv = __builtin_amdgcn_exp2f(S[i] - m); l += pv; S[i] = pv; }
  }
  const bf16x8 p0 = pack8(S, 0), p1 = pack8(S, 1);
#pragma unroll
  for (int d = 0; d < 4; ++d) {
    bf16x8 v0 = *(const bf16x8*)(sv + (d * 32 + lq) * 144 + 16 * h);
    bf16x8 v1 = *(const bf16x8*)(sv + (d * 32 + lq) * 144 + 32 + 16 * h);
    O[d] = mfma32(v0, p0, O[d]);
    O[d] = mfma32(v1, p1, O[d]);
  }
}

DI void diff_map_far2(const unsigned char* sk, const bf16x8 (&qf)[4], const unsigned char* sv, float cbias, int h, int lq,
                      f32x16 (&O)[4], float& m, float& l) {
  const float csc = 0.125f * LOG2E;
  f32x16 S0 = zero16(), S1 = zero16();
#pragma unroll
  for (int s = 0; s < 4; ++s) {
    bf16x8 k0 = *(const bf16x8*)(sk + lq * 144 + (16 * s + 8 * h) * 2);
    bf16x8 k1 = *(const bf16x8*)(sk + (32 + lq) * 144 + (16 * s + 8 * h) * 2);
    S0 = mfma32(k0, qf[s], S0);
    S1 = mfma32(k1, qf[s], S1);
  }
  float mx = fmaxf(fmaxf(S0[0], S0[1]), S0[2]);
#pragma unroll
  for (int i = 3; i < 15; i += 2) mx = fmaxf(fmaxf(mx, S0[i]), S0[i + 1]);
  mx = fmaxf(mx, S0[15]);
#pragma unroll
  for (int i = 0; i < 16; i += 2) mx = fmaxf(fmaxf(mx, S1[i]), S1[i + 1]);
  mx = fmaxf(mx, __shfl_xor(mx, 32));
  const float mn = fmaxf(m, mx * csc + cbias);
  if (__any(mn > m + 8.f)) {
    const float a = __builtin_amdgcn_exp2f(m - mn);
    l *= a; m = mn;
#pragma unroll
    for (int d = 0; d < 4; ++d) O[d] *= a;
  }
  const float off = cbias - m;
  float la = 0.f, lb = 0.f;
#pragma unroll
  for (int i = 0; i < 16; ++i) {
    float pa = __builtin_amdgcn_exp2f(S0[i] * csc + off), pb = __builtin_amdgcn_exp2f(S1[i] * csc + off);
    la += pa; lb += pb; S0[i] = pa; S1[i] = pb;
  }
  l += la + lb;
  const bf16x8 p0 = pack8(S0, 0), p1 = pack8(S0, 1), p2 = pack8(S1, 0), p3 = pack8(S1, 1);
#pragma unroll
  for (int d = 0; d < 4; ++d) {
    const unsigned char* vr = sv + (d * 32 + lq) * 144 + 16 * h;
    bf16x8 v0 = *(const bf16x8*)(vr), v1 = *(const bf16x8*)(vr + 32), v2 = *(const bf16x8*)(vr + 64), v3 = *(const bf16x8*)(vr + 96);
    O[d] = mfma32(v0, p0, O[d]);
    O[d] = mfma32(v1, p1, O[d]);
    O[d] = mfma32(v2, p2, O[d]);
    O[d] = mfma32(v3, p3, O[d]);
  }
}

DI void diff_job8(const Params& p, int layer, int b, int head, int qb, unsigned char* smem) {
  int tid_ = threadIdx.x; asm volatile("" : "+v"(tid_));
  const int tid = tid_, lane = tid & 63, wave = tid >> 6, h = lane >> 5, lq = lane & 31;
  const int map = wave >> 2, qg = wave & 3;
  const int t0 = qb * 128, tw0 = t0 + 32 * qg, tq = tw0 + lq;
  const float* lut = (const float*)(smem + LUT_OFF);
  build_lut(p, 4 + head, smem, tid);
  bf16x8 qf[4];
  {
    const u16* qr = p.qdf + (size_t)(b * TP + tq) * 512 + head * 128 + 64 * map + 8 * h;
#pragma unroll
    for (int s = 0; s < 4; ++s) qf[s] = *(const bf16x8*)(qr + 16 * s);
  }
  f32x16 O[4];
#pragma unroll
  for (int i = 0; i < 4; ++i) O[i] = zero16();
  float m = -1e30f, l = 0.f;
  const u16* K1 = p.kdf + (size_t)b * TP * 512 + head * 128;
  const u16* VT = p.vtdf + (size_t)(b * 512 + head * 128) * TP;
  const int ntile = 2 * (qb + 1);
  const int krow = tid >> 3, kc = tid & 7, krs = swap23(krow);
  u32x4 rk1, rk2, rv[2];
  auto gl = [&](int k0) {
    const u16* s = K1 + (size_t)(k0 + krow) * 512 + kc * 8;
    rk1 = *(const u32x4*)s; rk2 = *(const u32x4*)(s + 64);
#pragma unroll
    for (int i = 0; i < 2; ++i) rv[i] = *(const u32x4*)(VT + (size_t)(krow + 64 * i) * TP + k0 + kc * 8);
  };
  auto sl = [&](unsigned char* d) {
    *(u32x4*)(d + krs * 144 + kc * 16) = rk1;
    *(u32x4*)(d + 9216 + krs * 144 + kc * 16) = rk2;
#pragma unroll
    for (int i = 0; i < 2; ++i) *(u32x4*)(d + 18432 + (krow + 64 * i) * 144 + kc * 16) = rv[i];
  };
  gl(0); sl(smem);
  if (ntile > 1) gl(64);
  __syncthreads();
  const float cbias = lut[128];
  for (int j = 0; j < ntile; ++j) {
    __syncthreads();
    if (j + 1 < ntile) { sl(smem + ((j + 1) & 1) * 36864); if (j + 2 < ntile) gl((j + 2) * 64); }
    const unsigned char* sb = smem + (j & 1) * 36864;
    const unsigned char* sk = sb + 9216 * map;
    const int k0 = j * 64;
    if (tw0 - (k0 + 63) >= 113) {
      diff_map_far2(sk, qf, sb + 18432, cbias, h, lq, O, m, l);
    } else {
#pragma unroll 1
      for (int sub = 0; sub < 2; ++sub) {
        const int ks0 = k0 + sub * 32;
        if (ks0 > tw0 + 31) break;
        const bool far = (tw0 - (ks0 + 31)) >= 113;
        const bool diag = (ks0 + 31) > tw0;
        diff_map(sk + sub * 32 * 144, qf, sb + 18432 + sub * 64, lut, far, diag, ks0, tq, h, lq, O, m, l);
      }
    }
  }
  __syncthreads();
  float lam;
  const float lam_init = 0.8f - 0.6f * expf(-0.3f * (float)layer);
  {
    float a = p.lq1[layer * 64 + lane] * p.lk1[layer * 64 + lane];
    float c = p.lq2[layer * 64 + lane] * p.lk2[layer * 64 + lane];
    a = wave_sum(a); c = wave_sum(c);
    lam = expf(a) - expf(c) + lam_init;
  }
  l += __shfl_xor(l, 32);
  const float il = (map ? lam : 1.f) / l;
  float* X = (float*)smem + (size_t)(qg * 32 + lq) * 132;
  if (map == 1) {
#pragma unroll
    for (int d = 0; d < 4; ++d)
#pragma unroll
      for (int g = 0; g < 4; ++g) {
        float4 v = make_float4(O[d][4 * g] * il, O[d][4 * g + 1] * il, O[d][4 * g + 2] * il, O[d][4 * g + 3] * il);
        *(float4*)(X + 32 * d + 8 * g + 4 * h) = v;
      }
  }
  __syncthreads();
  if (map == 0) {
    float ss = 0.f;
#pragma unroll
    for (int d = 0; d < 4; ++d)
#pragma unroll
      for (int g = 0; g < 4; ++g) {
        const float4 v = *(const float4*)(X + 32 * d + 8 * g + 4 * h);
        float y0 = O[d][4 * g] * il - v.x, y1 = O[d][4 * g + 1] * il - v.y, y2 = O[d][4 * g + 2] * il - v.z, y3 = O[d][4 * g + 3] * il - v.w;
        O[d][4 * g] = y0; O[d][4 * g + 1] = y1; O[d][4 * g + 2] = y2; O[d][4 * g + 3] = y3;
        ss += y0 * y0 + y1 * y1 + y2 * y2 + y3 * y3;
      }
    ss += __shfl_xor(ss, 32);
    const float sc = rsqrtf(ss * (1.f / 128.f) + EPS) * (1.f - lam_init);
    const float* sg = p.subln + layer * 128;
    u16* yr = p.ydf + (size_t)(b * TP + tq) * 512 + head * 128;
#pragma unroll
    for (int d = 0; d < 4; ++d)
#pragma unroll
      for (int g = 0; g < 4; ++g) {
        const int dv = 32 * d + 8 * g + 4 * h;
        const float4 g4 = *(const float4*)(sg + dv);
        u32x2 pk = {pack2bf(O[d][4 * g] * sc * g4.x, O[d][4 * g + 1] * sc * g4.y),
                    pack2bf(O[d][4 * g + 2] * sc * g4.z, O[d][4 * g + 3] * sc * g4.w)};
        *(u32x2*)(yr + dv) = pk;
      }
  }
  __syncthreads();
}

DI void sparse_job(const Params& p, int layer, int b, int head, int qb, unsigned char* smem) {
  int tid_ = threadIdx.x & 255; asm volatile("" : "+v"(tid_));
  const int tid = tid_, lane = tid & 63, wave = tid >> 6, h = lane >> 5, lq = lane & 31;
  const int t0 = qb * 128, tw0 = t0 + 32 * wave, tq = tw0 + lq;
  const float* lut = (const float*)(smem + LUT_OFF);
  build_lut(p, head, smem, tid);
  bf16x8 qf[4];
  {
    const u16* qr = p.qsp + (size_t)(b * TP + tq) * 256 + head * 64 + 8 * h;
#pragma unroll
    for (int s = 0; s < 4; ++s) qf[s] = *(const bf16x8*)(qr + 16 * s);
  }
  f32x16 O[2] = {zero16(), zero16()};
  float m = -1e30f, l = 0.f;
  const u16* Kp = p.ksp + (size_t)b * TP * 256 + head * 64;
  const u16* VT = p.vtsp + (size_t)(b * 256 + head * 64) * TP;
  const u32* mrow = p.mask + (size_t)(b * TP + tq) * MW;
  const int ntile = 2 * (qb + 1);
  const float csc = 0.125f * LOG2E;
  u32x4 rk[2], rv[2];
  ld_tile_g<2>(rk, Kp, 256, 0, false, tid); ld_tile_g<2>(rv, VT, TP, 0, true, tid);
  u32x2 mnext = *(const u32x2*)(mrow);
  st_tile_s<2>(rk, smem, true, tid); st_tile_s<2>(rv, smem + 9216, false, tid);
  if (ntile > 1) { ld_tile_g<2>(rk, Kp, 256, 64, false, tid); ld_tile_g<2>(rv, VT, TP, 64, true, tid); }
  for (int j = 0; j < ntile; ++j) {
    const bool more = j + 1 < ntile;
    const u32x2 mcur = mnext;
    __syncthreads();
    if (more) {
      unsigned char* d = smem + ((j + 1) & 1) * 18432; st_tile_s<2>(rk, d, true, tid); st_tile_s<2>(rv, d + 9216, false, tid);
      mnext = *(const u32x2*)(mrow + 2 * (j + 1));
      if (j + 2 < ntile) { const int k0 = (j + 2) * 64; ld_tile_g<2>(rk, Kp, 256, k0, false, tid); ld_tile_g<2>(rv, VT, TP, k0, true, tid); }
    }
    const unsigned char* sb = smem + (j & 1) * 18432;
    if (tw0 - (j * 64 + 63) >= 113) {
      const float cbias = lut[128];
      f32x16 S0 = zero16(), S1 = zero16();
#pragma unroll
      for (int s = 0; s < 4; ++s) {
        bf16x8 k0 = *(const bf16x8*)(sb + lq * 144 + (16 * s + 8 * h) * 2);
        bf16x8 k1 = *(const bf16x8*)(sb + (32 + lq) * 144 + (16 * s + 8 * h) * 2);
        S0 = mfma32(k0, qf[s], S0);
        S1 = mfma32(k1, qf[s], S1);
      }
      const u32 sa = ((mcur[0] >> (8 * h)) & 0xffu) | (((mcur[0] >> (16 + 8 * h)) & 0xffu) << 8);
      const u32 sb2 = ((mcur[1] >> (8 * h)) & 0xffu) | (((mcur[1] >> (16 + 8 * h)) & 0xffu) << 8);
      float mx = -1e30f;
#pragma unroll
      for (int i = 0; i < 16; ++i) {
        mx = fmaxf(mx, (sa & (1u << i)) ? S0[i] : -1e30f);
        mx = fmaxf(mx, (sb2 & (1u << i)) ? S1[i] : -1e30f);
      }
      mx = fmaxf(mx, __shfl_xor(mx, 32));
      const float mn = mx > -1e29f ? fmaxf(m, mx * csc + cbias) : m;
      if (__any(mn > m + 8.f)) {
        const float a = __builtin_amdgcn_exp2f(m - mn);
        l *= a; O[0] *= a; O[1] *= a;
        m = mn;
      }
      const float off = cbias - m;
      float la = 0.f, lb = 0.f;
#pragma unroll
      for (int i = 0; i < 16; ++i) {
        const float pa = (sa & (1u << i)) ? __builtin_amdgcn_exp2f(S0[i] * csc + off) : 0.f;
        const float pb = (sb2 & (1u << i)) ? __builtin_amdgcn_exp2f(S1[i] * csc + off) : 0.f;
        la += pa; lb += pb; S0[i] = pa; S1[i] = pb;
      }
      l += la + lb;
      const bf16x8 p0 = pack8(S0, 0), p1 = pack8(S0, 1), p2 = pack8(S1, 0), p3 = pack8(S1, 1);
#pragma unroll
      for (int d = 0; d < 2; ++d) {
        const unsigned char* vr = sb + 9216 + (d * 32 + lq) * 144 + 16 * h;
        bf16x8 v0 = *(const bf16x8*)(vr), v1 = *(const bf16x8*)(vr + 32), v2 = *(const bf16x8*)(vr + 64), v3 = *(const bf16x8*)(vr + 96);
        O[d] = mfma32(v0, p0, O[d]);
        O[d] = mfma32(v1, p1, O[d]);
        O[d] = mfma32(v2, p2, O[d]);
        O[d] = mfma32(v3, p3, O[d]);
      }
    } else
#pragma unroll 1
    for (int sub = 0; sub < 2; ++sub) {
      const int ks0 = j * 64 + sub * 32;
      if (ks0 > tw0 + 31) break;
      const u32 mw = sub ? mcur[1] : mcur[0];
      if (!__any(mw != 0u)) continue;
      f32x16 S = zero16();
#pragma unroll
      for (int s = 0; s < 4; ++s) {
        bf16x8 k1 = *(const bf16x8*)(sb + (sub * 32 + lq) * 144 + (16 * s + 8 * h) * 2);
        S = mfma32(k1, qf[s], S);
      }
      const bool far = (tw0 - (ks0 + 31)) >= 113;
      const float cbias = lut[128];
      const u32 sel16 = ((mw >> (8 * h)) & 0xffu) | (((mw >> (16 + 8 * h)) & 0xffu) << 8);
      if (far) {
        float mx = -1e30f;
#pragma unroll
        for (int i = 0; i < 16; ++i) mx = fmaxf(mx, (sel16 & (1u << i)) ? S[i] : -1e30f);
        mx = fmaxf(mx, __shfl_xor(mx, 32));
        const float mn = mx > -1e29f ? fmaxf(m, mx * csc + cbias) : m;
        if (__any(mn > m + 8.f)) {
          const float a = __builtin_amdgcn_exp2f(m - mn);
          l *= a; O[0] *= a; O[1] *= a;
          m = mn;
        }
        const float off = cbias - m;
#pragma unroll
        for (int i = 0; i < 16; ++i) {
          float pv = (sel16 & (1u << i)) ? __builtin_amdgcn_exp2f(S[i] * csc + off) : 0.f;
          l += pv;
          S[i] = pv;
        }
      } else {
        float mx = -1e30f;
#pragma unroll
        for (int i = 0; i < 16; ++i) {
          const int ko = 16 * (i >> 3) + 8 * h + (i & 7);
          int d = tq - (ks0 + ko); d = d < 0 ? 0 : (d > 128 ? 128 : d);
          float x = S[i] * csc + lut[d];
          if (!(sel16 & (1u << i))) x = -1e30f;
          S[i] = x;
          mx = fmaxf(mx, x);
        }
        mx = fmaxf(mx, __shfl_xor(mx, 32));
        const float mn = fmaxf(m, mx);
        if (__any(mn > m + 8.f)) {
          const float a = __builtin_amdgcn_exp2f(m - mn);
          l *= a; O[0] *= a; O[1] *= a;
          m = mn;
        }
#pragma unroll
        for (int i = 0; i < 16; ++i) {
          float pv = S[i] > -1e29f ? __builtin_amdgcn_exp2f(S[i] - m) : 0.f;
          l += pv;
          S[i] = pv;
        }
      }
      bf16x8 pa0 = pack8(S, 0), pa1 = pack8(S, 1);
#pragma unroll
      for (int d = 0; d < 2; ++d) {
        bf16x8 v0 = *(const bf16x8*)(sb + 9216 + (d * 32 + lq) * 144 + (sub * 32 + 8 * h) * 2);
        bf16x8 v1 = *(const bf16x8*)(sb + 9216 + (d * 32 + lq) * 144 + (sub * 32 + 16 + 8 * h) * 2);
        O[d] = mfma32(v0, pa0, O[d]);
        O[d] = mfma32(v1, pa1, O[d]);
      }
    }
  }
  __syncthreads();
  l += __shfl_xor(l, 32);
  const float il = 1.f / l;
  u16* yr = p.ysp + (size_t)(b * TP + tq) * 256 + head * 64;
#pragma unroll
  for (int d = 0; d < 2; ++d)
#pragma unroll
    for (int g = 0; g < 4; ++g) {
      u32x2 pk = {pack2bf(O[d][4 * g] * il, O[d][4 * g + 1] * il), pack2bf(O[d][4 * g + 2] * il, O[d][4 * g + 3] * il)};
      *(u32x2*)(yr + 32 * d + 8 * g + 4 * h) = pk;
    }
  __syncthreads();
}

DI void sb_job(const Params& p, int b, int head, int qb, unsigned char* smem) {
  int tid_ = threadIdx.x & 255; asm volatile("" : "+v"(tid_));
  const int tid = tid_, lane = tid & 63, wave = tid >> 6, h = lane >> 5, lq = lane & 31;
  const int t0 = qb * 128, tw0 = t0 + 32 * wave, tq = tw0 + lq;
  bf16x8 qf[4];
  {
    const u16* qr = p.qsb + (size_t)(b * TP + tq) * 256 + head * 64 + 8 * h;
#pragma unroll
    for (int s = 0; s < 4; ++s) qf[s] = *(const bf16x8*)(qr + 16 * s);
  }
  f32x16 O[2] = {zero16(), zero16()};
  float carry = 0.f;
  const u16* Kp = p.ksb + (size_t)b * TP * 256 + head * 64;
  const u16* VT = p.vtsb + (size_t)(b * 256 + head * 64) * TP;
  const int ntile = 2 * (qb + 1);
  u32x4 rk[2], rv[2];
  ld_tile_g<2>(rk, Kp, 256, (ntile - 1) * 64, false, tid); ld_tile_g<2>(rv, VT, TP, (ntile - 1) * 64, true, tid);
  st_tile_s<2>(rk, smem, true, tid); st_tile_s<2>(rv, smem + 9216, false, tid);
  __syncthreads();
  for (int jj = 0; jj < ntile; ++jj) {
    const int j = ntile - 1 - jj;
    const bool more = jj + 1 < ntile;
    if (more) { const int k0 = (j - 1) * 64; ld_tile_g<2>(rk, Kp, 256, k0, false, tid); ld_tile_g<2>(rv, VT, TP, k0, true, tid); }
    __builtin_amdgcn_sched_barrier(0);
    const unsigned char* sb = smem + (jj & 1) * 18432;
    const bool wdone = !__any(carry >= -104.f);
    if (!wdone) {
#pragma unroll 1
      for (int sub = 1; sub >= 0; --sub) {
        const int ks0 = j * 64 + sub * 32;
        if (ks0 > tw0) continue;
        f32x16 S = zero16();
#pragma unroll
        for (int s = 0; s < 4; ++s) {
          bf16x8 k1 = *(const bf16x8*)(sb + (sub * 32 + lq) * 144 + (16 * s + 8 * h) * 2);
          S = mfma32(k1, qf[s], S);
        }
        const bool diag = (ks0 + 31) >= tw0;
        float lsm[16];
        float sA = 0.f, sB = 0.f;
#pragma unroll
        for (int i = 0; i < 16; ++i) {
          const int key = ks0 + 16 * (i >> 3) + 8 * h + (i & 7);
          const float z = S[i] * 0.125f;
          const float sp = fmaxf(z, 0.f) + __logf(1.f + __expf(-fabsf(z)));
          const bool valid = !diag || key < tq;
          lsm[i] = valid ? -sp : 0.f;
          S[i] = valid ? z - sp : -1e30f;
          if (i < 8) sA += lsm[i]; else sB += lsm[i];
        }
        const float oA = __shfl_xor(sA, 32), oB = __shfl_xor(sB, 32);
        const float aboveB = h == 0 ? oB : 0.f;
        const float aboveA = h == 0 ? (oA + sB + oB) : (oB + sB);
        float run = carry + aboveB;
#pragma unroll
        for (int i = 15; i >= 8; --i) { float lw = S[i] + run; run += lsm[i]; S[i] = lw > -1e29f ? __expf(lw) : 0.f; }
        run = carry + aboveA;
#pragma unroll
        for (int i = 7; i >= 0; --i) { float lw = S[i] + run; run += lsm[i]; S[i] = lw > -1e29f ? __expf(lw) : 0.f; }
        carry += sA + sB + oA + oB;
        bf16x8 pa0 = pack8(S, 0), pa1 = pack8(S, 1);
#pragma unroll
        for (int d = 0; d < 2; ++d) {
          bf16x8 v0 = *(const bf16x8*)(sb + 9216 + (d * 32 + lq) * 144 + (sub * 32 + 8 * h) * 2);
          bf16x8 v1 = *(const bf16x8*)(sb + 9216 + (d * 32 + lq) * 144 + (sub * 32 + 16 + 8 * h) * 2);
          O[d] = mfma32(v0, pa0, O[d]);
          O[d] = mfma32(v1, pa1, O[d]);
        }
      }
    }
    if (more) { unsigned char* d = smem + ((jj + 1) & 1) * 18432; st_tile_s<2>(rk, d, true, tid); st_tile_s<2>(rv, d + 9216, false, tid); }
    const int alldone = __syncthreads_and((int)(!__any(carry >= -104.f)));
    if (alldone) break;
  }
  u16* yr = p.ysb + (size_t)(b * TP + tq) * 256 + head * 64;
#pragma unroll
  for (int d = 0; d < 2; ++d)
#pragma unroll
    for (int g = 0; g < 4; ++g) {
      u32x2 pk = {pack2bf(O[d][4 * g], O[d][4 * g + 1]), pack2bf(O[d][4 * g + 2], O[d][4 * g + 3])};
      *(u32x2*)(yr + 32 * d + 8 * g + 4 * h) = pk;
    }
  __syncthreads();
}

DI void idx_scan(const u32* hq, int need, u32* outbin, u32* outneed, int q, int lane) {
  u32 c = 0;
#pragma unroll
  for (int w = 0; w < 8; ++w) { u32 v = hq[8 * lane + w]; c += (v & 0xffffu) + (v >> 16); }
  u32 incl = c;
#pragma unroll
  for (int o = 1; o < 64; o <<= 1) { u32 v = __shfl_down(incl, o); if (lane + o < 64) incl += v; }
  const u32 above = incl - c;
  if ((int)above < need && need <= (int)incl) {
    u32 cum = above;
    for (int bin = 16 * lane + 15; bin >= 16 * lane; --bin) {
      u32 cnt = (hq[bin >> 1] >> ((bin & 1) * 16)) & 0xffffu;
      if ((int)(cum + cnt) >= need) { outbin[q] = (u32)bin; outneed[q] = (u32)need - cum; break; }
      cum += cnt;
    }
  }
}

template <int PASS, bool DIAG>
DI void idx_tile(const bf16x8 kf, const bf16x8 (&qf)[8], const float (&wq)[8], int kt, int lm, int lg, int tq, bool selall, u32 bA, u32 pfx,
                 u32* hist, u32* maskw, u32* cand, u32* ccnt) {
  const f32x4 z4 = {0.f, 0.f, 0.f, 0.f};
  f32x4 sc = z4;
#pragma unroll
  for (int j = 0; j < 8; ++j) {
    f32x4 d = mfma16(kf, qf[j], z4);
#pragma unroll
    for (int r = 0; r < 4; ++r) sc[r] += wq[j] * fmaxf(d[r], 0.f);
  }
  u32 selbits = 0u;
#pragma unroll
  for (int r = 0; r < 4; ++r) {
    const int key = kt * 16 + lg * 4 + r;
    const bool valid = !DIAG || key <= tq;
    const u32 bits = __float_as_uint(sc[r]);
    const u32 u = bits ^ ((u32)((int)bits >> 31) | 0x80000000u);
    if (PASS == 0) {
      if (valid) { const u32 bin = u >> 22; atomicAdd(&hist[lm * 512 + (bin >> 1)], 1u << ((bin & 1) * 16)); }
    } else if (PASS == 1) {
      if (valid && (u >> 22) == bA) { const u32 bin = (u >> 12) & 1023u; atomicAdd(&hist[lm * 512 + (bin >> 1)], 1u << ((bin & 1) * 16)); }
    } else {
      const u32 pp = u >> 12;
      if (valid && (selall || pp > pfx)) selbits |= 1u << r;
      if (valid && !selall && pp == pfx) {
        const u32 ix = atomicAdd(&ccnt[lm], 1u);
        if (ix < 64u) { cand[(lm * 64 + ix) * 2] = u; cand[(lm * 64 + ix) * 2 + 1] = (u32)key; }
      }
    }
  }
  if (PASS == 2 && selbits) {
    const int kb = kt * 16 + lg * 4;
    atomicOr(&maskw[lm * MW + (kb >> 5)], selbits << (kb & 31));
  }
}
template <int PASS>
DI void idx_pass(const u16* kp, const bf16x8 (&qf)[8], const float (&wq)[8], int wave, int ntile, int lm, int lg, int tq, bool selall,
                 u32 bA, u32 pfx, u32* hist, u32* maskw, u32* cand, u32* ccnt) {
  auto ldk = [&](int t) { return *(const bf16x8*)(kp + (size_t)(t < ntile ? t : 0) * 512); };
  int kt = wave;
  bf16x8 ka = ldk(kt), kb = ldk(kt + 4);
  for (; kt + 4 < ntile - 1; kt += 8) {
    const bf16x8 kc = ldk(kt + 8), kd = ldk(kt + 12);
    idx_tile<PASS, false>(ka, qf, wq, kt, lm, lg, tq, selall, bA, pfx, hist, maskw, cand, ccnt);
    idx_tile<PASS, false>(kb, qf, wq, kt + 4, lm, lg, tq, selall, bA, pfx, hist, maskw, cand, ccnt);
    ka = kc; kb = kd;
  }
  if (kt < ntile - 1) { idx_tile<PASS, false>(ka, qf, wq, kt, lm, lg, tq, selall, bA, pfx, hist, maskw, cand, ccnt); kt += 4; ka = kb; }
  if (kt == ntile - 1) idx_tile<PASS, true>(ka, qf, wq, kt, lm, lg, tq, selall, bA, pfx, hist, maskw, cand, ccnt);
}

DI void idx_job(const Params& p, int b, int qg, unsigned char* smem) {
  int tid_ = threadIdx.x & 255; asm volatile("" : "+v"(tid_));
  const int tid = tid_, lane = tid & 63, wave = tid >> 6, lm = lane & 15, lg = lane >> 4;
  u32* hist = (u32*)smem;
  u32* maskw = (u32*)(smem + 32768);
  u32* cand = (u32*)(smem + 41216);
  u32* ccnt = (u32*)(smem + 49408);
  u32* binA = ccnt + 16; u32* needB = ccnt + 32; u32* binB = ccnt + 48; u32* needC = ccnt + 64;
  const int t0 = qg * 16, ntile = qg + 1, tq = t0 + lm;
  const bool selall = tq + 1 <= 256;
  bf16x8 qf[8];
  float wq[8];
  {
    const u16* qr = p.qix + (size_t)(b * TP + tq) * 256 + lg * 8;
    const float* wr = p.wix + (size_t)(b * TP + tq) * 8;
#pragma unroll
    for (int j = 0; j < 8; ++j) { qf[j] = *(const bf16x8*)(qr + j * 32); wq[j] = wr[j]; }
  }
  for (int i = tid; i < 8192 + 2112; i += 256) hist[i] = 0u;
  if (tid < 80) ccnt[tid] = 0u;
  __syncthreads();
  const u16* kbase = p.kix + (size_t)b * TP * 32;
  const f32x4 z4 = {0.f, 0.f, 0.f, 0.f};
  const u16* kp = kbase + (size_t)lm * 32 + lg * 8;
  idx_pass<0>(kp, qf, wq, wave, ntile, lm, lg, tq, selall, 0u, 0u, hist, maskw, cand, ccnt);
  __syncthreads();
  for (int qq = 0; qq < 4; ++qq) idx_scan(hist + (wave * 4 + qq) * 512, 256, binA, needB, wave * 4 + qq, lane);
  __syncthreads();
  for (int i = tid; i < 8192; i += 256) hist[i] = 0u;
  __syncthreads();
  idx_pass<1>(kp, qf, wq, wave, ntile, lm, lg, tq, selall, binA[lm], 0u, hist, maskw, cand, ccnt);
  __syncthreads();
  for (int qq = 0; qq < 4; ++qq) idx_scan(hist + (wave * 4 + qq) * 512, (int)needB[wave * 4 + qq], binB, needC, wave * 4 + qq, lane);
  __syncthreads();
  idx_pass<2>(kp, qf, wq, wave, ntile, lm, lg, tq, selall, binA[lm], (binA[lm] << 10) | binB[lm], hist, maskw, cand, ccnt);
  __syncthreads();
  {
    const int q = tid >> 4, i0 = tid & 15;
    u32 cnt = ccnt[q]; if (cnt > 64u) cnt = 64u;
    const u32 need = needC[q];
    for (u32 c = i0; c < cnt; c += 16) {
      const u32 u = cand[(q * 64 + c) * 2], key = cand[(q * 64 + c) * 2 + 1];
      u32 rank = 0;
      for (u32 e = 0; e < cnt; ++e) {
        const u32 u2 = cand[(q * 64 + e) * 2], k2 = cand[(q * 64 + e) * 2 + 1];
        rank += (u2 > u || (u2 == u && k2 < key)) ? 1u : 0u;
      }
      if (rank < need) atomicOr(&maskw[q * MW + (key >> 5)], 1u << (key & 31));
    }
  }
  __syncthreads();
  for (int i = tid; i < 16 * MW; i += 256) p.mask[(size_t)(b * TP + t0) * MW + i] = maskw[i];
  __syncthreads();
}

DI int next_job(u32* ctr, unsigned char* smem) {
  int* sj = (int*)(smem + SJOB_OFF);
  __syncthreads();
  if (threadIdx.x == 0) *sj = (int)atomicAdd(ctr, 1u);
  __syncthreads();
  return *sj;
}

DI void phase_attn(const Params& p, int layer, int phase, unsigned char* smem) {
  u32* ctr = p.ctr + phase;
  for (;;) {
    const int jp = next_job(ctr, smem);
    if (jp >= 2640) break;
    if (jp < 1056) { const int qb = 32 - jp / 32, r = jp & 31; diff_job8(p, layer, r >> 2, r & 3, qb, smem); continue; }
    int half = threadIdx.x >> 8; asm volatile("" : "+v"(half));
    unsigned char* sm = smem + half * HALF_BYTES;
    const int job = 2 * (jp - 1056) + half;
    if (job < 2112) { idx_job(p, job & 7, 263 - (job >> 3), sm); }
    else { const int i = job - 2112; const int qb = 32 - i / 32, r = i & 31; sb_job(p, r >> 2, r & 3, qb, sm); }
  }
}
DI void phase_sparse(const Params& p, int layer, int phase, unsigned char* smem) {
  u32* ctr = p.ctr + phase;
  for (;;) {
    const int jp = next_job(ctr, smem);
    if (jp >= 528) break;
    int half = threadIdx.x >> 8; asm volatile("" : "+v"(half));
    unsigned char* sm = smem + half * HALF_BYTES;
    const int job = 2 * jp + half;
    const int qb = 32 - job / 32, r = job & 31;
    sparse_job(p, layer, r >> 2, r & 3, qb, sm);
  }
}

DI void run_phase(const Params& p, int ph, unsigned char* smem, int rep = 0) {
  if (ph == 0) { phase_prep(p, smem); return; }
  const int layer = (ph - 1) / 7, s = (ph - 1) % 7;
  const u16* WL = p.wts + (size_t)layer * LAYER_W;
  switch (s) {
    case 0: phase_g1(p, layer, smem); break;
    case 1: phase_attn(p, layer, ph + 16 * rep, smem); break;
    case 2: phase_sparse(p, layer, ph + 16 * rep, smem); break;
    case 3: phase_merge(p, layer, smem); break;
    case 4: phase_resid(p, layer == 0 ? 1 : 3, p.merged, DM, WL + OFF_OUT, p.rowss + (size_t)(2 * layer + 1) * R, false, smem); break;
    case 5: phase_ffnup(p, layer, smem); break;
    default: phase_resid(p, 2, p.act, DFF, WL + OFF_DOWN, p.rowss + (size_t)(2 * layer + 2) * R, layer == 1, smem); break;
  }
}


#define XB_TMO      128
#define XB_XCNT(j)  (256  + 64 * (j))
#define XB_XSUB(j)  (1280 + 64 * (j))
#define XB_XGEN(j)  (2304 + 64 * (j))
#define XB_TOP      3328
#define XB_TOPGEN   3392
#define XCD_BAR_WORDS 3456
#define XB_SPIN_CAP (1u << 20)
#define LAS __attribute__((address_space(3)))
DI unsigned xb_ld(unsigned* p) { return __hip_atomic_load(p, __ATOMIC_RELAXED, __HIP_MEMORY_SCOPE_AGENT); }
DI unsigned xb_add(unsigned* p, unsigned v) { return __hip_atomic_fetch_add(p, v, __ATOMIC_RELAXED, __HIP_MEMORY_SCOPE_AGENT); }
DI unsigned xb_xcc_id() { return (unsigned)__builtin_amdgcn_s_getreg((3 << 11) | 20) & 0xFu; }
#define XB_SPIN(cond, bar) do { unsigned _sp = 0; while (cond) { __builtin_amdgcn_s_sleep(1); \
    if ((++_sp & 255u) == 0u) { if (xb_ld(&(bar)[XB_TMO])) break; if (_sp > XB_SPIN_CAP) { atomicAdd(&(bar)[XB_TMO], 1u); break; } } } } while (0)
struct XcdBarrier { unsigned* bar; unsigned x; volatile LAS unsigned* st; };
DI XcdBarrier xcd_barrier_post(unsigned* bar, volatile LAS unsigned* st) {
  XcdBarrier b; b.bar = bar; b.x = xb_xcc_id(); b.st = st;
  if (threadIdx.x == 0) (void)xb_add(&bar[XB_XCNT(b.x)], 1u);
  return b;
}
DI void xcd_barrier_complete(unsigned* bar, unsigned x, unsigned& nloc, unsigned& nx) {
  const unsigned G = gridDim.x * gridDim.y * gridDim.z;
  unsigned sum, cnt, mine, sp = 0u;
  for (;;) {
    sum = 0u; cnt = 0u; mine = 0u;
#pragma unroll
    for (unsigned j = 0; j < 16; ++j) { const unsigned c = xb_ld(&bar[XB_XCNT(j)]); sum += c; cnt += (c > 0u) ? 1u : 0u; mine = (j == x) ? c : mine; }
    if (sum == G) break;
    __builtin_amdgcn_s_sleep(1);
    if ((++sp & 255u) == 0u) { if (xb_ld(&bar[XB_TMO])) break; if (sp > XB_SPIN_CAP) { atomicAdd(&bar[XB_TMO], 1u); break; } }
  }
  nloc = mine > 0u ? mine : 1u; nx = cnt > 0u ? cnt : 1u;
}
DI void xcd_barrier(const XcdBarrier& b) {
  asm volatile("s_waitcnt vmcnt(0)" ::: "memory");
  __syncthreads();
  if (threadIdx.x == 0) {
    unsigned* bar = b.bar;
    __builtin_amdgcn_s_waitcnt(0);
    unsigned nloc = b.st[0], nx = b.st[1];
    if (nloc == 0u) { xcd_barrier_complete(bar, b.x, nloc, nx); b.st[0] = nloc; b.st[1] = nx; }
    const unsigned old = xb_add(&bar[XB_XSUB(b.x)], 1u);
    const unsigned gen = old / nloc;
    if (old + 1u == (gen + 1u) * nloc) {
      __builtin_amdgcn_fence(__ATOMIC_RELEASE, "agent");
      asm volatile("s_waitcnt vmcnt(0)" ::: "memory");
      const unsigned og = xb_add(&bar[XB_TOP], 1u);
      const unsigned tg = og / nx;
      if (og + 1u == (tg + 1u) * nx) xb_add(&bar[XB_TOPGEN], 1u);
      else XB_SPIN(xb_ld(&bar[XB_TOPGEN]) == tg, bar);
      __builtin_amdgcn_fence(__ATOMIC_ACQUIRE, "agent");
      xb_add(&bar[XB_XGEN(b.x)], 1u);
      asm volatile("s_waitcnt vmcnt(0)" ::: "memory");
    } else {
      XB_SPIN(xb_ld(&bar[XB_XGEN(b.x)]) == gen, bar);
      __builtin_amdgcn_fence(__ATOMIC_ACQUIRE, "agent");
      asm volatile("s_waitcnt vmcnt(0)" ::: "memory");
    }
  }
  __syncthreads();
}

constexpr int NPHASE = 15;

__global__ void __launch_bounds__(512) mega(Params p, int ph_lo, int ph_hi) {
  __shared__ __attribute__((aligned(16))) unsigned char smem[SMEM_BYTES];
  volatile LAS unsigned* xst = (volatile LAS unsigned*)(smem + (SMEM_BYTES - 16));
  if (threadIdx.x == 0) { xst[0] = 0u; xst[1] = 0u; }
  __syncthreads();
  const XcdBarrier xb = xcd_barrier_post(p.bar, xst);
  for (int ph = ph_lo; ph < ph_hi; ++ph) {
    run_phase(p, ph, smem);
#ifdef PROBE_MASK
    if (ph > 0 && ((PROBE_MASK >> ((ph - 1) % 7)) & 1)) { cg::this_grid().sync(); run_phase(p, ph, smem, 1); }
#endif
    if (ph + 1 < ph_hi) { if (ph_hi > 1000) cg::this_grid().sync(); else xcd_barrier(xb); }
  }
}

extern "C" void kernel_launch(void* const* d_in, const int* in_sizes, int n_in, void* d_out, int out_size, void* d_ws,
                              size_t ws_size, hipStream_t stream) {
  Params p{};
  const float* const* in = (const float* const*)d_in;
  p.x = in[0]; p.meta = in[1]; p.rel_bias = in[2]; p.attn_norm = in[3]; p.w_in = in[4]; p.b_gate = in[5];
  p.qn_sp = in[6]; p.kn_sp = in[7]; p.qn_df = in[8]; p.kn_df = in[9]; p.lq1 = in[10]; p.lk1 = in[11]; p.lq2 = in[12];
  p.lk2 = in[13]; p.subln = in[14]; p.w_br_sb = in[15]; p.w_br_sp = in[16]; p.w_br_df = in[17]; p.w_out = in[18];
  p.ffn_norm = in[19]; p.w_up = in[20]; p.conv_w = in[21]; p.conv_b = in[22]; p.w_down = in[23];
  p.out = (float*)d_out;
  unsigned char* w = (unsigned char*)d_ws;
  size_t off = 0;
  auto take = [&](size_t bytes) { unsigned char* r = w + off; off += (bytes + 255) & ~(size_t)255; return r; };
  p.ctr = (u32*)take(256);
  p.bar = (u32*)take((size_t)XCD_BAR_WORDS * 4);
  p.hb = (u16*)take((size_t)(R + 512) * DM * 2) + (size_t)256 * DM;
  p.rowss = (float*)take((size_t)4 * R * 4);
  p.side = (float*)take((size_t)NB * 128 * DM * 4);
  p.wts = (u16*)take((size_t)2 * LAYER_W * 2);
  p.mask = (u32*)take((size_t)R * MW * 4);
  unsigned char* region = w + off;
  p.qsb = (u16*)take((size_t)R * 256 * 2); p.ksb = (u16*)take((size_t)R * 256 * 2);
  p.qsp = (u16*)take((size_t)R * 256 * 2); p.ksp = (u16*)take((size_t)R * 256 * 2);
  p.qdf = (u16*)take((size_t)R * 512 * 2); p.kdf = (u16*)take((size_t)R * 512 * 2);
  p.vtsb = (u16*)take((size_t)R * 256 * 2); p.vtsp = (u16*)take((size_t)R * 256 * 2); p.vtdf = (u16*)take((size_t)R * 512 * 2);
  p.qix = (u16*)take((size_t)R * 256 * 2); p.kix = (u16*)take((size_t)R * 32 * 2); p.wix = (float*)take((size_t)R * 8 * 4);
  p.ysb = (u16*)take((size_t)R * 256 * 2); p.ysp = (u16*)take((size_t)R * 256 * 2); p.ydf = (u16*)take((size_t)R * 512 * 2);
  p.merged = (u16*)region;
  p.act = (u16*)region;
  if (off > ws_size) { fprintf(stderr, "workspace too small: need %zu have %zu\n", off, ws_size); return; }
#if FUSED
  static int grid_blocks = 0;
  if (!grid_blocks) {
    int dev = 0, cus = 0, per_cu = 0;
    hipGetDevice(&dev);
    hipDeviceGetAttribute(&cus, hipDeviceAttributeMultiprocessorCount, dev);
    hipOccupancyMaxActiveBlocksPerMultiprocessor(&per_cu, mega, 512, 0);
    if (per_cu > 1) per_cu = 1;
    grid_blocks = cus * per_cu;
  }
  int lo = 0, hi = NPHASE;
  (void)hipMemsetAsync(p.bar, 0, (size_t)XCD_BAR_WORDS * 4, stream);
  void* args[] = {&p, &lo, &hi};
  hipError_t e = hipLaunchCooperativeKernel((void*)mega, dim3(grid_blocks), dim3(512), args, 0, stream);
  if (e != hipSuccess) fprintf(stderr, "cooperative launch failed: %s (grid %d)\n", hipGetErrorString(e), grid_blocks);
#else
  for (int ph = 0; ph < NPHASE; ++ph) mega<<<256, 512, 0, stream>>>(p, ph, ph + 1);
#endif
}
```
